# Optimizing an MI355X kernel written in HIP

```python
import jax, jax.numpy as jnp
from jax import lax
import numpy as np

D_MODEL = 1024
BATCH = 16
SEQ = 2048
DEPTH = 2
DEC_BATCH = 2
DEC_SEQ = 16384
PAST_LEN = 128

GRID_W = 64
HEAD_DIM = 64
EPS = 1e-6
A_Q_HEADS = 8
A_KV_HEADS = 2
ROPE_THETA = 10000.0
Q_BLOCK = 128
B_PATTERNS = ((128, 1), (512, 4), (2048, 16))
B_BRANCHES = len(B_PATTERNS)
B_HEADS = 4
C_HEADS = 16
C_WIN_ROWS = 8
C_WIN_COLS = 16
C_COL_BLOCK = 16
C_SLAB = 32
X_HEADS = 4
X_HEAD_DIM = D_MODEL // X_HEADS
MEM_TOKENS = 256
D_FF = ((8 * D_MODEL + 3 * 256 - 1) // (3 * 256)) * 256
A_Q_W = A_Q_HEADS * HEAD_DIM
A_KV_W = A_KV_HEADS * HEAD_DIM
B_QKV_W = 3 * B_BRANCHES * B_HEADS * HEAD_DIM
IN_AB = A_Q_W + 2 * A_KV_W + B_QKV_W
OUT_AB = A_Q_W + B_HEADS * HEAD_DIM
IN_C = 3 * C_HEADS * HEAD_DIM
OUT_C = C_HEADS * HEAD_DIM

kernel_name = "hybrid_bidir_encoder_gqa_dilated_natten"


def _rms_norm(x, g):
    xf = x.astype(jnp.float32)
    y = xf * lax.rsqrt(jnp.mean(xf * xf, axis=-1, keepdims=True) + EPS)
    return (y * g.astype(jnp.float32)).astype(x.dtype)


def _alibi_slopes(n):
    return jnp.exp2(-8.0 * jnp.arange(1, n + 1, dtype=jnp.float32) / n)


def _axial_rope_tables(n_tok):
    t = jnp.arange(n_tok, dtype=jnp.int32)
    row = (t // GRID_W).astype(jnp.float32)
    col = (t % GRID_W).astype(jnp.float32)
    axis_dim = HEAD_DIM // 2
    inv_freq = ROPE_THETA ** (-jnp.arange(0, axis_dim, 2, dtype=jnp.float32) / axis_dim)
    ang = jnp.concatenate([row[:, None] * inv_freq, col[:, None] * inv_freq], axis=-1)
    return jnp.cos(ang), jnp.sin(ang)


def _apply_rope(x, cos, sin):
    x2 = x.reshape(*x.shape[:-1], HEAD_DIM // 2, 2)
    xr, xi = x2[..., 0], x2[..., 1]
    c = cos[None, :, None, :].astype(x.dtype)
    s = sin[None, :, None, :].astype(x.dtype)
    return jnp.stack([xr * c - xi * s, xr * s + xi * c], axis=-1).reshape(x.shape)


def _gqa_block_attention(q, k, v):
    bn, s_len = q.shape[:2]
    grp = A_Q_HEADS // A_KV_HEADS
    nb = s_len // Q_BLOCK
    qb = q.reshape(bn, nb, Q_BLOCK, A_KV_HEADS, grp, HEAD_DIM).transpose(1, 0, 2, 3, 4, 5)
    scale = HEAD_DIM ** -0.5

    def one_block(qi):
        s = jnp.einsum('bqkgd,bskd->bkgqs', qi, k, preferred_element_type=jnp.float32) * scale
        p = jax.nn.softmax(s, axis=-1).astype(v.dtype)
        return jnp.einsum('bkgqs,bskd->bqkgd', p, v)

    o = lax.map(one_block, qb)
    return o.transpose(1, 0, 2, 3, 4, 5).reshape(bn, s_len, A_Q_HEADS * HEAD_DIM)


def _dilated_branch(q, k, v, dil, half, slopes):
    bn, s_len, nh, dh = q.shape
    L = s_len // dil
    nb = -(-L // half)
    Lp = nb * half

    def to_strided(x):
        return x.reshape(bn, L, dil, nh, dh).transpose(0, 2, 1, 3, 4).reshape(bn * dil, L, nh, dh)

    qs, ks, vs = to_strided(q), to_strided(k), to_strided(v)
    qb = jnp.pad(qs, ((0, 0), (0, Lp - L), (0, 0), (0, 0))).reshape(bn * dil, nb, half, nh, dh)

    def bands(x):
        xp = jnp.pad(x, ((0, 0), (half, Lp - L + half), (0, 0), (0, 0)))
        return jnp.concatenate(
            [xp[:, o:o + Lp].reshape(bn * dil, nb, half, nh, dh) for o in (0, half, 2 * half)], axis=2)

    kb, vb = bands(ks), bands(vs)
    qi = np.arange(nb)[:, None, None] * half + np.arange(half)[None, :, None]
    kj = np.arange(nb)[:, None, None] * half + np.arange(3 * half)[None, None, :] - half
    rel = kj - qi
    valid = (np.abs(rel) <= half) & (kj >= 0) & (kj < L)
    dist = (np.abs(rel) * dil).astype(np.float32)
    s = jnp.einsum('znqhd,znkhd->znhqk', qb, kb, preferred_element_type=jnp.float32) * (dh ** -0.5)
    s = s - slopes[None, :, None, None] * dist[:, None]
    s = jnp.where(valid[:, None], s, -jnp.inf)
    lse = jax.nn.logsumexp(s, axis=-1, keepdims=True)
    p = jnp.exp(s - lse).astype(vb.dtype)
    o = jnp.einsum('znhqk,znkhd->znqhd', p, vb)
    lse = jnp.moveaxis(lse[..., 0], 2, 3)

    def from_strided(y):
        rest = y.shape[3:]
        y = y.reshape(bn, dil, Lp, *rest)[:, :, :L]
        return jnp.moveaxis(y, 1, 2).reshape(bn, s_len, *rest)

    return from_strided(o), from_strided(lse)


def _dilated_mixture(zb):
    bn, s_len = zb.shape[:2]
    slopes = _alibi_slopes(B_BRANCHES * B_HEADS).reshape(B_BRANCHES, B_HEADS)
    outs, lses = [], []
    for g, (window, dil) in enumerate(B_PATTERNS):
        o, lse = _dilated_branch(zb[:, :, 0, g], zb[:, :, 1, g], zb[:, :, 2, g],
                                 dil, window // (2 * dil), slopes[g])
        outs.append(o)
        lses.append(lse)
    wts = jax.nn.softmax(jnp.stack(lses), axis=0)
    out = jnp.sum(wts[..., None].astype(outs[0].dtype) * jnp.stack(outs), axis=0)
    return out.reshape(bn, s_len, B_HEADS * HEAD_DIM)


def _neighbourhood_attention(q, k, v, rpb):
    bn, s_len, nh, dh = q.shape
    rows = s_len // GRID_W
    kh = min(C_WIN_ROWS, rows)
    qg = q.reshape(bn, rows, GRID_W, nh, dh)
    kg = k.reshape(bn, rows, GRID_W, nh, dh)
    vg = v.reshape(bn, rows, GRID_W, nh, dh)
    n_cb = GRID_W // C_COL_BLOCK
    slab_start = np.clip(np.arange(n_cb) * C_COL_BLOCK - C_WIN_COLS // 2, 0, GRID_W - C_SLAB)
    qcol = np.arange(n_cb)[:, None] * C_COL_BLOCK + np.arange(C_COL_BLOCK)[None, :]
    cstart = np.clip(qcol - C_WIN_COLS // 2, 0, GRID_W - C_WIN_COLS)
    kcol = slab_start[:, None] + np.arange(C_SLAB)[None, :]
    col_valid = (kcol[:, None, :] >= cstart[:, :, None]) & (kcol[:, None, :] < cstart[:, :, None] + C_WIN_COLS)
    col_idx = np.clip(kcol[:, None, :] - qcol[:, :, None] + C_WIN_COLS - 1, 0, 2 * C_WIN_COLS - 2)
    col_bias = rpb[:, :, col_idx]
    scale = dh ** -0.5

    def row_fn(r):
        rs = jnp.clip(r - kh // 2, 0, rows - kh)
        kr = lax.dynamic_slice_in_dim(kg, rs, kh, axis=1)
        vr = lax.dynamic_slice_in_dim(vg, rs, kh, axis=1)
        ks = jnp.stack([kr[:, :, s0:s0 + C_SLAB] for s0 in slab_start], axis=2)
        vs = jnp.stack([vr[:, :, s0:s0 + C_SLAB] for s0 in slab_start], axis=2)
        qr = lax.dynamic_index_in_dim(qg, r, axis=1, keepdims=False).reshape(bn, n_cb, C_COL_BLOCK, nh, dh)
        s = jnp.einsum('bnqhd,binchd->bhnqic', qr, ks, preferred_element_type=jnp.float32) * scale
        ridx = rs + jnp.arange(kh) - r + (C_WIN_ROWS - 1)
        bias = jnp.take(col_bias, ridx, axis=1).transpose(0, 2, 3, 1, 4)
        s = s + bias[None].astype(jnp.float32)
        s = jnp.where(col_valid[:, :, None, :], s, -jnp.inf)
        shp = s.shape
        p = jax.nn.softmax(s.reshape(*shp[:-2], kh * C_SLAB), axis=-1).reshape(shp).astype(vs.dtype)
        o = jnp.einsum('bhnqic,binchd->bnqhd', p, vs)
        return o.reshape(bn, GRID_W, nh, dh)

    out = lax.map(row_fn, jnp.arange(rows, dtype=jnp.int32))
    return out.transpose(1, 0, 2, 3, 4).reshape(bn, s_len, nh * dh)


def _mixer_ab(h, w_in, g_qn, g_kn, w_out):
    bn, s_len, _ = h.shape
    z = h @ w_in
    qa, ka, va, zb = jnp.split(z, [A_Q_W, A_Q_W + A_KV_W, A_Q_W + 2 * A_KV_W], axis=-1)
    qa = _rms_norm(qa.reshape(bn, s_len, A_Q_HEADS, HEAD_DIM), g_qn)
    ka = _rms_norm(ka.reshape(bn, s_len, A_KV_HEADS, HEAD_DIM), g_kn)
    cos, sin = _axial_rope_tables(s_len)
    qa = _apply_rope(qa, cos, sin)
    ka = _apply_rope(ka, cos, sin)
    va = va.reshape(bn, s_len, A_KV_HEADS, HEAD_DIM)
    oa = _gqa_block_attention(qa, ka, va)
    ob = _dilated_mixture(zb.reshape(bn, s_len, 3, B_BRANCHES, B_HEADS, HEAD_DIM))
    return jnp.concatenate([oa, ob], axis=-1) @ w_out


def _mixer_c(h, w_in, rpb, w_out):
    bn, s_len, _ = h.shape
    z = (h @ w_in).reshape(bn, s_len, 3, C_HEADS, HEAD_DIM)
    return _neighbourhood_attention(z[:, :, 0], z[:, :, 1], z[:, :, 2], rpb) @ w_out


def _memory_cross_attention(h, mem, g_mem, wq, wkv, wo):
    bn, s_len, _ = h.shape
    n_mem = mem.shape[1]
    m = _rms_norm(mem, g_mem)
    q = (h @ wq).reshape(bn, s_len, X_HEADS, X_HEAD_DIM)
    kv = (m @ wkv).reshape(bn, n_mem, 2, X_HEADS, X_HEAD_DIM)
    s = jnp.einsum('bshd,bmhd->bhsm', q, kv[:, :, 0], preferred_element_type=jnp.float32) * (X_HEAD_DIM ** -0.5)
    p = jax.nn.softmax(s, axis=-1).astype(kv.dtype)
    o = jnp.einsum('bhsm,bmhd->bshd', p, kv[:, :, 1]).reshape(bn, s_len, D_MODEL)
    return o @ wo


def _swiglu(h, w_gu, w_down):
    g, u = jnp.split(h @ w_gu, 2, axis=-1)
    return (jax.nn.silu(g) * u) @ w_down


def _encoder_trunk(x, mem, g_mix, w_in_ab, g_qn, g_kn, w_out_ab, w_in_c, rpb_c, w_out_c,
                   g_xattn, g_mem, wq_x, wkv_x, wo_x, g_ffn, w_gu, w_down, g_final):
    for l in range(DEPTH):
        h = _rms_norm(x, g_mix[l])
        if l % 2 == 0:
            e = l // 2
            x = x + _mixer_ab(h, w_in_ab[e], g_qn[e], g_kn[e], w_out_ab[e])
        else:
            o = l // 2
            x = x + _mixer_c(h, w_in_c[o], rpb_c[o], w_out_c[o])
        x = x + _memory_cross_attention(_rms_norm(x, g_xattn[l]), mem, g_mem[l], wq_x[l], wkv_x[l], wo_x[l])
        x = x + _swiglu(_rms_norm(x, g_ffn[l]), w_gu[l], w_down[l])
    return _rms_norm(x, g_final)


def setup_inputs(seed: int = 0) -> dict:
    key = jax.random.key(seed)
    ks = jax.random.split(key, 24)
    f32 = jnp.float32
    n_even = (DEPTH + 1) // 2
    n_odd = DEPTH // 2

    def nrm(k, shape, scale):
        return jax.random.normal(k, shape, f32) * scale

    def gain(k, shape):
        return 1.0 + 0.05 * jax.random.normal(k, shape, f32)

    return {
        "x_prompt": nrm(ks[0], (BATCH, SEQ, D_MODEL), 1.0),
        "x_sample": nrm(ks[1], (DEC_BATCH, DEC_SEQ, D_MODEL), 1.0),
        "mem_prompt": nrm(ks[2], (BATCH, MEM_TOKENS, D_MODEL), 1.0),
        "mem_sample": nrm(ks[3], (DEC_BATCH, MEM_TOKENS, D_MODEL), 1.0),
        "g_mix": gain(ks[4], (DEPTH, D_MODEL)),
        "w_in_ab": nrm(ks[5], (n_even, D_MODEL, IN_AB), D_MODEL ** -0.5),
        "g_qn": gain(ks[6], (n_even, HEAD_DIM)),
        "g_kn": gain(ks[7], (n_even, HEAD_DIM)),
        "w_out_ab": nrm(ks[8], (n_even, OUT_AB, D_MODEL), OUT_AB ** -0.5),
        "w_in_c": nrm(ks[9], (n_odd, D_MODEL, IN_C), D_MODEL ** -0.5),
        "rpb_c": nrm(ks[10], (n_odd, C_HEADS, 2 * C_WIN_ROWS - 1, 2 * C_WIN_COLS - 1), 0.1),
        "w_out_c": nrm(ks[11], (n_odd, OUT_C, D_MODEL), OUT_C ** -0.5),
        "g_xattn": gain(ks[12], (DEPTH, D_MODEL)),
        "g_mem": gain(ks[13], (DEPTH, D_MODEL)),
        "wq_x": nrm(ks[14], (DEPTH, D_MODEL, D_MODEL), D_MODEL ** -0.5),
        "wkv_x": nrm(ks[15], (DEPTH, D_MODEL, 2 * D_MODEL), D_MODEL ** -0.5),
        "wo_x": nrm(ks[16], (DEPTH, D_MODEL, D_MODEL), D_MODEL ** -0.5),
        "g_ffn": gain(ks[17], (DEPTH, D_MODEL)),
        "w_gu": nrm(ks[18], (DEPTH, D_MODEL, 2 * D_FF), D_MODEL ** -0.5),
        "w_down": nrm(ks[19], (DEPTH, D_FF, D_MODEL), D_FF ** -0.5),
        "g_final": gain(ks[20], (D_MODEL,)),
    }


def reference(x_prompt, x_sample, mem_prompt, mem_sample, g_mix, w_in_ab, g_qn, g_kn, w_out_ab,
              w_in_c, rpb_c, w_out_c, g_xattn, g_mem, wq_x, wkv_x, wo_x, g_ffn, w_gu, w_down, g_final):
    y_prompt = _encoder_trunk(x_prompt, mem_prompt, g_mix, w_in_ab, g_qn, g_kn, w_out_ab, w_in_c, rpb_c,
                              w_out_c, g_xattn, g_mem, wq_x, wkv_x, wo_x, g_ffn, w_gu, w_down, g_final)
    y_sample = _encoder_trunk(x_sample, mem_sample, g_mix, w_in_ab, g_qn, g_kn, w_out_ab, w_in_c, rpb_c,
                              w_out_c, g_xattn, g_mem, wq_x, wkv_x, wo_x, g_ffn, w_gu, w_down, g_final)
    return (y_prompt, y_sample)
```

```cpp
#include <hip/hip_runtime.h>
#include <hip/hip_cooperative_groups.h>
#include <cstdint>
#include <cstdio>
namespace cg = cooperative_groups;

#ifndef MULTI_LAUNCH
#define MULTI_LAUNCH 0
#endif

typedef unsigned short bf16_t;
typedef short bf16x8 __attribute__((ext_vector_type(8)));
typedef short s16x4 __attribute__((ext_vector_type(4)));
typedef short v4i16_t __attribute__((ext_vector_type(4)));
typedef float f32x4 __attribute__((ext_vector_type(4)));
typedef float f32x2_t __attribute__((ext_vector_type(2)));
typedef __bf16 bf16x2_t __attribute__((ext_vector_type(2)));
typedef unsigned u32x4 __attribute__((ext_vector_type(4)));
typedef unsigned u32x2 __attribute__((ext_vector_type(2)));

#define LOG2E 1.4426950408889634f
constexpr int NTOK = 65536;
constexpr int NPROMPT = 32768;
constexpr int ZW = 3072;
constexpr int DFF = 2816;
constexpr float EPS = 1e-6f;

constexpr size_t WS_WT_IN_AB = 0;
constexpr size_t WS_WT_OUT_AB = WS_WT_IN_AB + (size_t)3072 * 1024 * 2;
constexpr size_t WS_WT_IN_C = WS_WT_OUT_AB + (size_t)1024 * 768 * 2;
constexpr size_t WS_WT_OUT_C = WS_WT_IN_C + (size_t)3072 * 1024 * 2;
constexpr size_t WS_WT_Q = WS_WT_OUT_C + (size_t)1024 * 1024 * 2;
constexpr size_t WS_WT_KV = WS_WT_Q + (size_t)2 * 1024 * 1024 * 2;
constexpr size_t WS_WT_O = WS_WT_KV + (size_t)2 * 2048 * 1024 * 2;
constexpr size_t WS_WT_GU = WS_WT_O + (size_t)2 * 1024 * 1024 * 2;
constexpr size_t WS_WT_DOWN = WS_WT_GU + (size_t)2 * 5632 * 1024 * 2;
constexpr size_t WS_KVMEM = WS_WT_DOWN + (size_t)2 * 1024 * 2816 * 2;
constexpr size_t WS_LSE = WS_KVMEM + (size_t)2 * 4608 * 2048 * 2;
constexpr size_t WS_ROPE = WS_LSE + (size_t)3 * 65536 * 4 * 4;
constexpr size_t WS_Z = WS_ROPE + (size_t)256 * 16 * 8;
constexpr size_t WS_END = WS_Z + (size_t)NTOK * ZW * 2;

constexpr int SMEM_BYTES = 2 * 128 * 72 * 2 + 512;

struct Params {
  const float* x_prompt; const float* x_sample; const float* mem_prompt; const float* mem_sample;
  const float* g_mix; const float* w_in_ab; const float* g_qn; const float* g_kn; const float* w_out_ab;
  const float* w_in_c; const float* rpb_c; const float* w_out_c; const float* g_xattn; const float* g_mem;
  const float* wq_x; const float* wkv_x; const float* wo_x; const float* g_ffn; const float* w_gu; const float* w_down;
  const float* g_final;
  float* out; unsigned char* ws;
  int phase_lo, phase_hi;
};

__device__ __forceinline__ int get_tid() { int t = threadIdx.x; asm volatile("" : "+v"(t)); return t; }
__device__ __forceinline__ unsigned cvtpk(float lo, float hi) { f32x2_t v = {lo, hi}; bf16x2_t b = __builtin_convertvector(v, bf16x2_t); return __builtin_bit_cast(unsigned, b); }
__device__ __forceinline__ float bf2f(unsigned short h) { return __uint_as_float(((unsigned)h) << 16); }
__device__ __forceinline__ s16x4 tr_read(const bf16_t* p) {
  return __builtin_bit_cast(s16x4, __builtin_amdgcn_ds_read_tr16_b64_v4i16((__attribute__((address_space(3))) v4i16_t*)p));
}
__device__ __forceinline__ const float* xin_row(const Params& p, int row) {
  return row < NPROMPT ? p.x_prompt + (size_t)row * 1024 : p.x_sample + (size_t)(row - NPROMPT) * 1024;
}
__device__ __forceinline__ const float* mem_row(const Params& p, int row) {
  return row < 4096 ? p.mem_prompt + (size_t)row * 1024 : p.mem_sample + (size_t)(row - 4096) * 1024;
}


__device__ __forceinline__ void ld16_sc1(u32x4& v, const void* p) { asm volatile("global_load_dwordx4 %0, %1, off sc1" : "=v"(v) : "v"(p) : "memory"); }
__device__ __forceinline__ void ld16_sc1(f32x4& v, const float* p) { asm volatile("global_load_dwordx4 %0, %1, off sc1" : "=v"(v) : "v"(p) : "memory"); }

__device__ __forceinline__ u32x4 ld_agent_u32x4(const void* p) {
  const unsigned long long a = __hip_atomic_load((const unsigned long long*)p, __ATOMIC_RELAXED, __HIP_MEMORY_SCOPE_AGENT);
  const unsigned long long b = __hip_atomic_load((const unsigned long long*)p + 1, __ATOMIC_RELAXED, __HIP_MEMORY_SCOPE_AGENT);
  return (u32x4){(unsigned)a, (unsigned)(a >> 32), (unsigned)b, (unsigned)(b >> 32)};
}
__device__ __forceinline__ float ld_agent_f32(const float* p) { return __uint_as_float(__hip_atomic_load((const unsigned*)p, __ATOMIC_RELAXED, __HIP_MEMORY_SCOPE_AGENT)); }
__device__ __forceinline__ f32x4 ld_agent_f32x4(const float* p) {
  const unsigned long long a = __hip_atomic_load((const unsigned long long*)p, __ATOMIC_RELAXED, __HIP_MEMORY_SCOPE_AGENT);
  const unsigned long long b = __hip_atomic_load((const unsigned long long*)p + 1, __ATOMIC_RELAXED, __HIP_MEMORY_SCOPE_AGENT);
  f32x4 v; v[0] = __uint_as_float((unsigned)a); v[1] = __uint_as_float((unsigned)(a >> 32)); v[2] = __uint_as_float((unsigned)b); v[3] = __uint_as_float((unsigned)(b >> 32)); return v;
}
template <bool AF32, class Epi>
__device__ __forceinline__ void gemm_tile(unsigned char* smem, const void* Ap, int lda, const bf16_t* Bt, int K, const Epi& epi, int m0, int n0) {
  const int tid = get_tid(), lane = tid & 63;
  const int wid = __builtin_amdgcn_readfirstlane(tid >> 6);
  const int wr = wid >> 1, wc = wid & 1, l15 = lane & 15, quad = lane >> 4;
  bf16_t* sA = (bf16_t*)smem; bf16_t* sB = sA + 128 * 72; float* sR = (float*)(smem + 2 * 128 * 72 * 2);
  f32x4 acc[4][4];
#pragma unroll
  for (int m = 0; m < 4; ++m)
#pragma unroll
    for (int n = 0; n < 4; ++n) acc[m][n] = (f32x4){0.f, 0.f, 0.f, 0.f};
  float ss[8];
#pragma unroll
  for (int i = 0; i < 8; ++i) ss[i] = 0.f;
  f32x4 ra[8]; u32x4 rab[4]; u32x4 rb[4];
  const int nk = K >> 6;
  const float* Af = (const float*)Ap + (size_t)(tid >> 4) * lda + (tid & 15) * 4;
  const bf16_t* Ab = (const bf16_t*)Ap + (size_t)(tid >> 3) * lda + (tid & 7) * 8;
  const bf16_t* Bp = Bt + (size_t)(tid >> 3) * K + (tid & 7) * 8;
  if constexpr (AF32) {
#pragma unroll
    for (int i = 0; i < 8; ++i) ld16_sc1(ra[i], Af + (size_t)i * 16 * lda);
  } else {
#pragma unroll
    for (int i = 0; i < 4; ++i) ld16_sc1(rab[i], Ab + (size_t)i * 32 * lda);
  }
#pragma unroll
  for (int i = 0; i < 4; ++i) ld16_sc1(rb[i], Bp + (size_t)i * 32 * K);

  for (int kt = 0; kt < nk; ++kt) {
    __syncthreads();
    if constexpr (AF32) {
      asm volatile("s_waitcnt vmcnt(0)" : "+v"(ra[0]), "+v"(ra[1]), "+v"(ra[2]), "+v"(ra[3]), "+v"(ra[4]), "+v"(ra[5]), "+v"(ra[6]), "+v"(ra[7]), "+v"(rb[0]), "+v"(rb[1]), "+v"(rb[2]), "+v"(rb[3]) :: "memory");
#pragma unroll
      for (int i = 0; i < 8; ++i) {
        const f32x4 v = ra[i];
        ss[i] += v[0] * v[0] + v[1] * v[1] + v[2] * v[2] + v[3] * v[3];
        u32x2 w; w.x = cvtpk(v[0], v[1]); w.y = cvtpk(v[2], v[3]);
        *(u32x2*)(sA + ((tid >> 4) + 16 * i) * 72 + (tid & 15) * 4) = w;
      }
    } else {
      asm volatile("s_waitcnt vmcnt(0)" : "+v"(rab[0]), "+v"(rab[1]), "+v"(rab[2]), "+v"(rab[3]), "+v"(rb[0]), "+v"(rb[1]), "+v"(rb[2]), "+v"(rb[3]) :: "memory");
#pragma unroll
      for (int i = 0; i < 4; ++i) *(u32x4*)(sA + ((tid >> 3) + 32 * i) * 72 + (tid & 7) * 8) = rab[i];
    }
#pragma unroll
    for (int i = 0; i < 4; ++i) *(u32x4*)(sB + ((tid >> 3) + 32 * i) * 72 + (tid & 7) * 8) = rb[i];
    if (kt + 1 < nk) {
      const int ko = (kt + 1) * 64;
      if constexpr (AF32) {
#pragma unroll
        for (int i = 0; i < 8; ++i) ld16_sc1(ra[i], Af + (size_t)i * 16 * lda + ko);
      } else {
#pragma unroll
        for (int i = 0; i < 4; ++i) ld16_sc1(rab[i], Ab + (size_t)i * 32 * lda + ko);
      }
#pragma unroll
      for (int i = 0; i < 4; ++i) ld16_sc1(rb[i], Bp + (size_t)i * 32 * K + ko);
    }
    __syncthreads();
    __builtin_amdgcn_s_setprio(1);
#pragma unroll
    for (int ks = 0; ks < 2; ++ks) {
      bf16x8 af[4], bfr[4];
#pragma unroll
      for (int m = 0; m < 4; ++m) af[m] = *(const bf16x8*)(sA + (wr * 64 + 16 * m + l15) * 72 + ks * 32 + quad * 8);
#pragma unroll
      for (int n = 0; n < 4; ++n) bfr[n] = *(const bf16x8*)(sB + (wc * 64 + 16 * n + l15) * 72 + ks * 32 + quad * 8);
#pragma unroll
      for (int m = 0; m < 4; ++m)
#pragma unroll
        for (int n = 0; n < 4; ++n) acc[m][n] = __builtin_amdgcn_mfma_f32_16x16x32_bf16(bfr[n], af[m], acc[m][n], 0, 0, 0);
    }
    __builtin_amdgcn_s_setprio(0);
  }
  if constexpr (AF32) {
    const float invK = 1.0f / (float)K;
#pragma unroll
    for (int i = 0; i < 8; ++i) {
      float s = ss[i];
      s += __shfl_xor(s, 1); s += __shfl_xor(s, 2); s += __shfl_xor(s, 4); s += __shfl_xor(s, 8);
      if ((tid & 15) == 0) sR[(tid >> 4) + 16 * i] = rsqrtf(s * invK + EPS);
    }
    __syncthreads();
  }
  epi(acc, m0, wr * 64, n0 + wc * 64, l15, quad, sR);
}

template <bool RS> struct EpiStore {
  bf16_t* C; int ldc;
  __device__ __forceinline__ void operator()(f32x4 (&acc)[4][4], int m0, int rl0, int cb, int l15, int quad, const float* sR) const {
#pragma unroll
    for (int m = 0; m < 4; ++m) {
      const int rl = rl0 + 16 * m + l15; const float rs = RS ? sR[rl] : 1.f;
      bf16_t* rp = C + (size_t)(m0 + rl) * ldc + cb + 4 * quad;
#pragma unroll
      for (int n = 0; n < 4; ++n) { const f32x4 v = acc[m][n] * rs; u32x2 w; w.x = cvtpk(v[0], v[1]); w.y = cvtpk(v[2], v[3]); *(u32x2*)(rp + 16 * n) = w; }
    }
  }
};
struct EpiInAB {
  bf16_t* Z; const float* gq; const float* gk; const float2* rope;
  __device__ __forceinline__ void operator()(f32x4 (&acc)[4][4], int m0, int rl0, int cb, int l15, int quad, const float* sR) const {
    if (cb >= 640) {
#pragma unroll
      for (int m = 0; m < 4; ++m) {
        const int rl = rl0 + 16 * m + l15; const float rs = sR[rl];
        bf16_t* rp = Z + (size_t)(m0 + rl) * ZW + cb + 4 * quad;
#pragma unroll
        for (int n = 0; n < 4; ++n) { const f32x4 v = acc[m][n] * rs; u32x2 w; w.x = cvtpk(v[0], v[1]); w.y = cvtpk(v[2], v[3]); *(u32x2*)(rp + 16 * n) = w; }
      }
    } else {
      const float* g = cb < 512 ? gq : gk;
      f32x4 gv[4];
#pragma unroll
      for (int n = 0; n < 4; ++n) gv[n] = *(const f32x4*)(g + 16 * n + 4 * quad);
#pragma unroll
      for (int m = 0; m < 4; ++m) {
        const int rl = rl0 + 16 * m + l15; const int row = m0 + rl; const float rs = sR[rl];
        f32x4 z[4]; float s2 = 0.f;
#pragma unroll
        for (int n = 0; n < 4; ++n) { z[n] = acc[m][n] * rs; s2 += z[n][0] * z[n][0] + z[n][1] * z[n][1] + z[n][2] * z[n][2] + z[n][3] * z[n][3]; }
        s2 += __shfl_xor(s2, 16); s2 += __shfl_xor(s2, 32);
        const float r = rsqrtf(s2 * (1.0f / 64.0f) + EPS);
        const int pos = row < NPROMPT ? (row & 2047) : (row & 16383);
        const int gr = pos >> 6, gc = pos & 63;
        bf16_t* rp = Z + (size_t)row * ZW + cb + 4 * quad;
#pragma unroll
        for (int n = 0; n < 4; ++n) {
          const int ap = (n < 2) ? gr : gc;
          const f32x4 zn = z[n] * r * gv[n];
          float2 c0, c1; { const unsigned long long w0 = __hip_atomic_load((const unsigned long long*)(rope + ap * 16 + ((8 * n + 2 * quad) & 15)), __ATOMIC_RELAXED, __HIP_MEMORY_SCOPE_AGENT), w1 = __hip_atomic_load((const unsigned long long*)(rope + ap * 16 + ((8 * n + 2 * quad + 1) & 15)), __ATOMIC_RELAXED, __HIP_MEMORY_SCOPE_AGENT); c0.x = __uint_as_float((unsigned)w0); c0.y = __uint_as_float((unsigned)(w0 >> 32)); c1.x = __uint_as_float((unsigned)w1); c1.y = __uint_as_float((unsigned)(w1 >> 32)); }
          const float o0 = zn[0] * c0.x - zn[1] * c0.y, o1 = zn[0] * c0.y + zn[1] * c0.x;
          const float o2 = zn[2] * c1.x - zn[3] * c1.y, o3 = zn[2] * c1.y + zn[3] * c1.x;
          u32x2 w; w.x = cvtpk(o0, o1); w.y = cvtpk(o2, o3); *(u32x2*)(rp + 16 * n) = w;
        }
      }
    }
  }
};
struct EpiResid {
  const float* src_tile; float* dst;
  __device__ __forceinline__ void operator()(f32x4 (&acc)[4][4], int m0, int rl0, int cb, int l15, int quad, const float* sR) const {
#pragma unroll
    for (int m = 0; m < 4; ++m) {
      const int rl = rl0 + 16 * m + l15;
      const float* sp = src_tile + (size_t)rl * 1024 + cb + 4 * quad; float* dp = dst + (size_t)(m0 + rl) * 1024 + cb + 4 * quad;
#pragma unroll
      for (int n = 0; n < 4; ++n) { const f32x4 x = ld_agent_f32x4(sp + 16 * n); *(f32x4*)(dp + 16 * n) = x + acc[m][n]; }
    }
  }
};
struct EpiSwiGLU {
  bf16_t* H;
  __device__ __forceinline__ void operator()(f32x4 (&acc)[4][4], int m0, int rl0, int cb, int l15, int quad, const float* sR) const {
    const int hc0 = (cb >> 7) * 64 + ((cb >> 6) & 1) * 32 + 4 * quad;
#pragma unroll
    for (int m = 0; m < 4; ++m) {
      const int rl = rl0 + 16 * m + l15; const float rs = sR[rl];
      bf16_t* rp = H + (size_t)(m0 + rl) * DFF + hc0;
#pragma unroll
      for (int pp = 0; pp < 2; ++pp) {
        const f32x4 g = acc[m][2 * pp] * rs, u = acc[m][2 * pp + 1] * rs; float h[4];
#pragma unroll
        for (int j = 0; j < 4; ++j) h[j] = g[j] / (1.0f + __expf(-g[j])) * u[j];
        u32x2 w; w.x = cvtpk(h[0], h[1]); w.y = cvtpk(h[2], h[3]); *(u32x2*)(rp + 16 * pp) = w;
      }
    }
  }
};

template <int DH, int KT, int NQT, bool PF, class Ctx>
__device__ __forceinline__ void attn_item(unsigned char* smem, const Ctx& c) {
  constexpr int LDK = DH + 8, CH = DH / 8, NCH = KT * CH / 256, NKS = DH / 32, NK4 = KT / 16, NKK = KT / 32, NDT = DH / 16;
  bf16_t* sK = (bf16_t*)smem; bf16_t* sV = sK + KT * LDK;
  const int tid = get_tid(), lane = tid & 63;
  const int wid = __builtin_amdgcn_readfirstlane(tid >> 6);
  const int l15 = lane & 15, quad = lane >> 4;
  bf16x8 qf[NQT][NKS];
#pragma unroll
  for (int qt = 0; qt < NQT; ++qt) {
    const bf16_t* qp = c.qptr(wid, qt * 16 + l15);
#pragma unroll
    for (int ks = 0; ks < NKS; ++ks) qf[qt][ks] = __builtin_bit_cast(bf16x8, ld_agent_u32x4(qp + ks * 32 + quad * 8));
  }
  f32x4 o[NQT][NDT];
  float mrow[NQT], lrow[NQT];
#pragma unroll
  for (int qt = 0; qt < NQT; ++qt) {
    mrow[qt] = -1e30f; lrow[qt] = 0.f;
#pragma unroll
    for (int dt = 0; dt < NDT; ++dt) o[qt][dt] = (f32x4){0.f, 0.f, 0.f, 0.f};
  }
  const int nt = c.ntiles();
  u32x4 rk[NCH], rv[NCH];
  if constexpr (PF) {
#pragma unroll
    for (int i = 0; i < NCH; ++i) {
      const int ci = tid + 256 * i, row = ci / CH, ch = ci % CH;
      ld16_sc1(rk[i], c.kptr(0, row) + ch * 8); ld16_sc1(rv[i], c.vptr(0, row) + ch * 8);
    }
  }
  for (int t = 0; t < nt; ++t) {
    __syncthreads();
    if constexpr (PF) {
      static_assert(!PF || NCH == 2, "wait list below is written for two chunks per matrix");
      asm volatile("s_waitcnt vmcnt(0)" : "+v"(rk[0]), "+v"(rk[NCH - 1]), "+v"(rv[0]), "+v"(rv[NCH - 1]) :: "memory");
#pragma unroll
      for (int i = 0; i < NCH; ++i) {
        const int ci = tid + 256 * i, row = ci / CH, ch = ci % CH;
        *(u32x4*)(sK + row * LDK + ch * 8) = rk[i]; *(u32x4*)(sV + row * LDK + ch * 8) = rv[i];
      }
    } else {
#pragma unroll
      for (int i = 0; i < NCH; ++i) {
        const int ci = tid + 256 * i, row = ci / CH, ch = ci % CH;
        *(u32x4*)(sK + row * LDK + ch * 8) = ld_agent_u32x4(c.kptr(t, row) + ch * 8);
      }
#pragma unroll
      for (int i = 0; i < NCH; ++i) {
        const int ci = tid + 256 * i, row = ci / CH, ch = ci % CH;
        *(u32x4*)(sV + row * LDK + ch * 8) = ld_agent_u32x4(c.vptr(t, row) + ch * 8);
      }
    }
    __syncthreads();
    if constexpr (PF) {
      if (t + 1 < nt) {
#pragma unroll
        for (int i = 0; i < NCH; ++i) {
          const int ci = tid + 256 * i, row = ci / CH, ch = ci % CH;
          ld16_sc1(rk[i], c.kptr(t + 1, row) + ch * 8); ld16_sc1(rv[i], c.vptr(t + 1, row) + ch * 8);
        }
      }
    }
    if (c.active(t, wid)) {
      f32x4 s[NQT][NK4];
#pragma unroll
      for (int qt = 0; qt < NQT; ++qt)
#pragma unroll
        for (int k4 = 0; k4 < NK4; ++k4) s[qt][k4] = (f32x4){0.f, 0.f, 0.f, 0.f};
#pragma unroll
      for (int k4 = 0; k4 < NK4; ++k4)
#pragma unroll
        for (int ks = 0; ks < NKS; ++ks) {
          const bf16x8 kf = *(const bf16x8*)(sK + (16 * k4 + l15) * LDK + ks * 32 + quad * 8);
#pragma unroll
          for (int qt = 0; qt < NQT; ++qt) s[qt][k4] = __builtin_amdgcn_mfma_f32_16x16x32_bf16(kf, qf[qt][ks], s[qt][k4], 0, 0, 0);
        }
#pragma unroll
      for (int qt = 0; qt < NQT; ++qt) {
        float mx = -1e30f;
#pragma unroll
        for (int k4 = 0; k4 < NK4; ++k4)
#pragma unroll
          for (int j = 0; j < 4; ++j) { const float v = c.score(t, wid, qt * 16 + l15, 16 * k4 + 4 * quad + j, s[qt][k4][j]); s[qt][k4][j] = v; mx = fmaxf(mx, v); }
        mx = fmaxf(mx, __shfl_xor(mx, 16)); mx = fmaxf(mx, __shfl_xor(mx, 32));
        const float mnew = fmaxf(mrow[qt], mx);
        const float alpha = __builtin_amdgcn_exp2f(mrow[qt] - mnew);
        mrow[qt] = mnew;
        float psum = 0.f;
#pragma unroll
        for (int k4 = 0; k4 < NK4; ++k4)
#pragma unroll
          for (int j = 0; j < 4; ++j) { const float pv = __builtin_amdgcn_exp2f(s[qt][k4][j] - mnew); s[qt][k4][j] = pv; psum += pv; }
        lrow[qt] = lrow[qt] * alpha + psum;
#pragma unroll
        for (int dt = 0; dt < NDT; ++dt) o[qt][dt] *= alpha;
      }
#pragma unroll
      for (int kk = 0; kk < NKK; ++kk) {
        bf16x8 pf[NQT];
#pragma unroll
        for (int qt = 0; qt < NQT; ++qt) {
          u32x4 w;
          w.x = cvtpk(s[qt][2 * kk][0], s[qt][2 * kk][1]); w.y = cvtpk(s[qt][2 * kk][2], s[qt][2 * kk][3]);
          w.z = cvtpk(s[qt][2 * kk + 1][0], s[qt][2 * kk + 1][1]); w.w = cvtpk(s[qt][2 * kk + 1][2], s[qt][2 * kk + 1][3]);
          pf[qt] = __builtin_bit_cast(bf16x8, w);
        }
        const bf16_t* vb = sV + (32 * kk + 4 * quad + (l15 >> 2)) * LDK + 4 * (l15 & 3);
#pragma unroll
        for (int dt = 0; dt < NDT; ++dt) {
          const s16x4 lo = tr_read(vb + 16 * dt);
          const s16x4 hi = tr_read(vb + 16 * LDK + 16 * dt);
          const bf16x8 vf = (bf16x8){lo[0], lo[1], lo[2], lo[3], hi[0], hi[1], hi[2], hi[3]};
#pragma unroll
          for (int qt = 0; qt < NQT; ++qt) o[qt][dt] = __builtin_amdgcn_mfma_f32_16x16x32_bf16(vf, pf[qt], o[qt][dt], 0, 0, 0);
        }
      }
    }
  }
#pragma unroll
  for (int qt = 0; qt < NQT; ++qt) {
    float l = lrow[qt];
    l += __shfl_xor(l, 16); l += __shfl_xor(l, 32);
    const float inv = 1.0f / l;
    bf16_t* op = c.optr(wid, qt * 16 + l15) + 4 * quad;
#pragma unroll
    for (int dt = 0; dt < NDT; ++dt) { const f32x4 v = o[qt][dt] * inv; u32x2 w; w.x = cvtpk(v[0], v[1]); w.y = cvtpk(v[2], v[3]); *(u32x2*)(op + 16 * dt) = w; }
    if (quad == 0) c.store_lse(wid, qt * 16 + l15, mrow[qt] + __builtin_amdgcn_logf(l));
  }
}

struct CtxA {
  bf16_t* qbase; const bf16_t* kbase; int nt;
  __device__ __forceinline__ const bf16_t* qptr(int w, int ql) const { return qbase + (size_t)(32 * w + ql) * ZW; }
  __device__ __forceinline__ bf16_t* optr(int w, int ql) const { return qbase + (size_t)(32 * w + ql) * ZW; }
  __device__ __forceinline__ const bf16_t* kptr(int t, int r) const { return kbase + (size_t)(64 * t + r) * ZW; }
  __device__ __forceinline__ const bf16_t* vptr(int t, int r) const { return kbase + (size_t)(64 * t + r) * ZW + 128; }
  __device__ __forceinline__ int ntiles() const { return nt; }
  __device__ __forceinline__ bool active(int, int) const { return true; }
  __device__ __forceinline__ float score(int, int, int, int, float s) const { return s * (0.125f * LOG2E); }
  __device__ __forceinline__ void store_lse(int, int, float) const {}
};
struct CtxB {
  bf16_t* zs; float* lse; int d, r, L, i0, qcol, kcol, vcol; float slope_l2;
  __device__ __forceinline__ const bf16_t* qptr(int w, int ql) const { return zs + (size_t)((i0 + 32 * w + ql) * d + r) * ZW + qcol; }
  __device__ __forceinline__ bf16_t* optr(int w, int ql) const { return zs + (size_t)((i0 + 32 * w + ql) * d + r) * ZW + qcol; }
  __device__ __forceinline__ int kidx(int t, int row) const { int i = i0 - 64 + 64 * t + row; i = i < 0 ? 0 : i; return i > L - 1 ? L - 1 : i; }
  __device__ __forceinline__ const bf16_t* kptr(int t, int row) const { return zs + (size_t)(kidx(t, row) * d + r) * ZW + kcol; }
  __device__ __forceinline__ const bf16_t* vptr(int t, int row) const { return zs + (size_t)(kidx(t, row) * d + r) * ZW + vcol; }
  __device__ __forceinline__ int ntiles() const { return 4; }
  __device__ __forceinline__ bool active(int t, int w) const { return w < 2 ? (t < 3) : (t >= 1); }
  __device__ __forceinline__ float score(int t, int w, int ql, int kl, float s) const {
    const int qi = i0 + 32 * w + ql, ki = i0 - 64 + 64 * t + kl; int rel = ki - qi; rel = rel < 0 ? -rel : rel;
    const bool valid = (rel <= 64) && (ki >= 0) && (ki < L);
    return valid ? s * (0.125f * LOG2E) - slope_l2 * (float)rel : -1e30f;
  }
  __device__ __forceinline__ void store_lse(int w, int ql, float v) const { lse[(size_t)((i0 + 32 * w + ql) * d + r) * 4] = v; }
};
struct CtxC {
  bf16_t* zs; const float* rpb; int R, r0, rb, hc;
  __device__ __forceinline__ const bf16_t* qptr(int w, int ql) const { return zs + (size_t)((r0 + (w >> 1)) * 64 + 32 * (w & 1) + ql) * ZW + hc; }
  __device__ __forceinline__ bf16_t* optr(int w, int ql) const { return zs + (size_t)((r0 + (w >> 1)) * 64 + 32 * (w & 1) + ql) * ZW + hc; }
  __device__ __forceinline__ int krow(int t) const { const int kr = rb + t; return kr > R - 1 ? R - 1 : kr; }
  __device__ __forceinline__ const bf16_t* kptr(int t, int row) const { return zs + (size_t)(krow(t) * 64 + row) * ZW + 1024 + hc; }
  __device__ __forceinline__ const bf16_t* vptr(int t, int row) const { return zs + (size_t)(krow(t) * 64 + row) * ZW + 2048 + hc; }
  __device__ __forceinline__ int ntiles() const { return 9; }
  __device__ __forceinline__ int rstart(int r) const { int rs = r - 4; rs = rs < 0 ? 0 : rs; return rs > R - 8 ? R - 8 : rs; }
  __device__ __forceinline__ bool active(int t, int w) const { const int r = r0 + (w >> 1), rs = rstart(r), kr = rb + t; return kr >= rs && kr < rs + 8; }
  __device__ __forceinline__ float score(int t, int w, int ql, int kl, float s) const {
    const int r = r0 + (w >> 1), cq = 32 * (w & 1) + ql, kr = rb + t;
    int cs = cq - 8; cs = cs < 0 ? 0 : cs; cs = cs > 48 ? 48 : cs;
    const bool valid = (kl >= cs) && (kl < cs + 16);
    const int idx = valid ? (kr - r + 7) * 31 + (kl - cq + 15) : 0;
    const float b = rpb[idx];
    return valid ? (s * 0.125f + b) * LOG2E : -1e30f;
  }
  __device__ __forceinline__ void store_lse(int, int, float) const {}
};
struct CtxX {
  bf16_t* qbase; const bf16_t* kv;
  __device__ __forceinline__ const bf16_t* qptr(int w, int ql) const { return qbase + (size_t)(16 * w + ql) * 1024; }
  __device__ __forceinline__ bf16_t* optr(int w, int ql) const { return qbase + (size_t)(16 * w + ql) * 1024; }
  __device__ __forceinline__ const bf16_t* kptr(int t, int row) const { return kv + (size_t)(32 * t + row) * 2048; }
  __device__ __forceinline__ const bf16_t* vptr(int t, int row) const { return kv + (size_t)(32 * t + row) * 2048 + 1024; }
  __device__ __forceinline__ int ntiles() const { return 8; }
  __device__ __forceinline__ bool active(int, int) const { return true; }
  __device__ __forceinline__ float score(int, int, int, int, float s) const { return s * (0.0625f * LOG2E); }
  __device__ __forceinline__ void store_lse(int, int, float) const {}
};

__device__ __forceinline__ void wt_tile(unsigned char* smem, const float* src, int K, int N, const float* gain, bf16_t* dst, int perm, int t) {
  float* tl = (float*)smem;
  const int nkt = K >> 6; const int rt = t / nkt, kt = t - rt * nkt; const int R0 = rt * 64, k0 = kt * 64;
  const int tid = get_tid(); const int rr = tid & 63;
  const int R = R0 + rr; int sc = R;
  if (perm) { const int T = R >> 7, within = R & 127, wc = within >> 6, n = (within & 63) >> 4, i = within & 15; sc = (n & 1) * DFF + 64 * T + 32 * wc + 16 * (n >> 1) + i; }
  __syncthreads();
#pragma unroll 4
  for (int i = 0; i < 16; ++i) {
    const int kk = (tid >> 6) + 4 * i;
    float v = src[(size_t)(k0 + kk) * N + sc];
    if (gain) v *= gain[k0 + kk];
    tl[kk * 65 + rr] = v;
  }
  __syncthreads();
  const int r2 = tid >> 2, kq = tid & 3;
  u32x4 w0, w1;
  w0.x = cvtpk(tl[(16 * kq + 0) * 65 + r2], tl[(16 * kq + 1) * 65 + r2]); w0.y = cvtpk(tl[(16 * kq + 2) * 65 + r2], tl[(16 * kq + 3) * 65 + r2]);
  w0.z = cvtpk(tl[(16 * kq + 4) * 65 + r2], tl[(16 * kq + 5) * 65 + r2]); w0.w = cvtpk(tl[(16 * kq + 6) * 65 + r2], tl[(16 * kq + 7) * 65 + r2]);
  w1.x = cvtpk(tl[(16 * kq + 8) * 65 + r2], tl[(16 * kq + 9) * 65 + r2]); w1.y = cvtpk(tl[(16 * kq + 10) * 65 + r2], tl[(16 * kq + 11) * 65 + r2]);
  w1.z = cvtpk(tl[(16 * kq + 12) * 65 + r2], tl[(16 * kq + 13) * 65 + r2]); w1.w = cvtpk(tl[(16 * kq + 14) * 65 + r2], tl[(16 * kq + 15) * 65 + r2]);
  bf16_t* dp = dst + (size_t)(R0 + r2) * K + k0 + 16 * kq;
  *(u32x4*)dp = w0; *(u32x4*)(dp + 8) = w1;
}
__device__ __forceinline__ void wt_matrix(unsigned char* smem, const float* src, int K, int N, const float* gain, bf16_t* dst, int perm) {
  const int ntile = (K >> 6) * (N >> 6);
  for (int t = blockIdx.x; t < ntile; t += gridDim.x) wt_tile(smem, src, K, N, gain, dst, perm, t);
}


__device__ __forceinline__ void tile_map(int t, int NT, int gdim, int& mt, int& nt) {
  if ((gdim & 7) == 0) { const int i = t / gdim, b = t - i * gdim; const int lt = (b >> 3) + (gdim >> 3) * i; const int ml = lt / NT; nt = lt - ml * NT; mt = (b & 7) + 8 * ml; }
  else { mt = t / NT; nt = t - mt * NT; }
}
__device__ __forceinline__ void tile_seq(int tt, int& seqbase, int& qb, int& S) {
  if (tt < 256) { seqbase = (tt >> 4) * 2048; qb = tt & 15; S = 2048; }
  else { const int u = tt - 256; seqbase = NPROMPT + (u >> 7) * 16384; qb = u & 127; S = 16384; }
}

__device__ __forceinline__ void run_phase(int ph, const Params& p, unsigned char* smem) {
  unsigned char* ws = p.ws;
  bf16_t* Z = (bf16_t*)(ws + WS_Z);
  const int tid = get_tid();
  const int L = ph >= 10 ? 1 : 0;
  switch (ph) {
    case 0: {
      wt_matrix(smem, p.w_in_ab, 1024, 3072, p.g_mix, (bf16_t*)(ws + WS_WT_IN_AB), 0);
      wt_matrix(smem, p.w_out_ab, 768, 1024, nullptr, (bf16_t*)(ws + WS_WT_OUT_AB), 0);
      wt_matrix(smem, p.w_in_c, 1024, 3072, p.g_mix + 1024, (bf16_t*)(ws + WS_WT_IN_C), 0);
      wt_matrix(smem, p.w_out_c, 1024, 1024, nullptr, (bf16_t*)(ws + WS_WT_OUT_C), 0);
      for (int l = 0; l < 2; ++l) {
        wt_matrix(smem, p.wq_x + (size_t)l * 1024 * 1024, 1024, 1024, p.g_xattn + l * 1024, (bf16_t*)(ws + WS_WT_Q) + (size_t)l * 1024 * 1024, 0);
        wt_matrix(smem, p.wkv_x + (size_t)l * 1024 * 2048, 1024, 2048, p.g_mem + l * 1024, (bf16_t*)(ws + WS_WT_KV) + (size_t)l * 2048 * 1024, 0);
        wt_matrix(smem, p.wo_x + (size_t)l * 1024 * 1024, 1024, 1024, nullptr, (bf16_t*)(ws + WS_WT_O) + (size_t)l * 1024 * 1024, 0);
        wt_matrix(smem, p.w_gu + (size_t)l * 1024 * 5632, 1024, 5632, p.g_ffn + l * 1024, (bf16_t*)(ws + WS_WT_GU) + (size_t)l * 5632 * 1024, 1);
        wt_matrix(smem, p.w_down + (size_t)l * DFF * 1024, DFF, 1024, nullptr, (bf16_t*)(ws + WS_WT_DOWN) + (size_t)l * 1024 * DFF, 0);
      }
      const int gi = blockIdx.x * 256 + tid;
      if (gi < 4096) {
        const int pos = gi >> 4, f = gi & 15;
        const float inv_freq = exp2f(-(float)f * 0.83048202372184058696f);
        const float ang = (float)pos * inv_freq;
        float2 cs; cs.x = cosf(ang); cs.y = sinf(ang);
        ((float2*)(ws + WS_ROPE))[gi] = cs;
      }
    } break;
    case 1: {
      const int n_ab = 512 * 24, n_kv = 36 * 16;
      for (int t = blockIdx.x; t < n_ab + 2 * n_kv; t += gridDim.x) {
        if (t < n_ab) {
          int mt, nt; tile_map(t, 24, gridDim.x, mt, nt);
          EpiInAB e{Z, p.g_qn, p.g_kn, (const float2*)(ws + WS_ROPE)};
          gemm_tile<true>(smem, xin_row(p, mt * 128), 1024, (const bf16_t*)(ws + WS_WT_IN_AB) + (size_t)nt * 128 * 1024, 1024, e, mt * 128, nt * 128);
        } else {
          int u = t - n_ab; const int l = u / n_kv; u -= l * n_kv; const int mt = u >> 4, nt = u & 15;
          EpiStore<true> e{(bf16_t*)(ws + WS_KVMEM) + (size_t)l * 4608 * 2048, 2048};
          gemm_tile<true>(smem, mem_row(p, mt * 128), 1024, (const bf16_t*)(ws + WS_WT_KV) + (size_t)l * 2048 * 1024 + (size_t)nt * 128 * 1024, 1024, e, mt * 128, nt * 128);
        }
      }
    } break;
    case 2: {
      for (int it = blockIdx.x; it < 4096 + 6144; it += gridDim.x) {
        if (it < 4096) {
          int seqbase, qi, h, nt;
          if (gridDim.x == 512) {
            const int bid = blockIdx.x, i = it >> 9, xcd = bid & 7, l = (bid >> 3) + 64 * (i & 3);
            if (it < 2048) { const int g = xcd >> 1, id = l * 2 + (xcd & 1); qi = id >> 2; h = (g & 1) * 4 + (id & 3); seqbase = NPROMPT + (g >> 1) * 16384; nt = 256; }
            else { const int grp = xcd + 8 * (l >> 6), id = l & 63; qi = id >> 2; h = (grp & 1) * 4 + (id & 3); seqbase = (grp >> 1) * 2048; nt = 32; }
          } else if (it < 2048) { const int s = it >> 10, rem = it & 1023; qi = rem >> 3; h = rem & 7; seqbase = NPROMPT + s * 16384; nt = 256; }
          else { const int a = it - 2048; const int s = a >> 7, rem = a & 127; qi = rem >> 3; h = rem & 7; seqbase = s * 2048; nt = 32; }
          CtxA c{Z + (size_t)(seqbase + 128 * qi) * ZW + h * 64, Z + (size_t)seqbase * ZW + 512 + (h >> 2) * 64, nt};
          attn_item<64, 64, 2, true>(smem, c);
        } else {
          const int b = it - 4096; const int h = b & 3, g = (b >> 2) % 3, tt = b / 12;
          int seqbase, qb, S; tile_seq(tt, seqbase, qb, S);
          const int d = g == 0 ? 1 : (g == 1 ? 4 : 16);
          const int Ls = S / d, nb = Ls >> 7; const int r = qb / nb, mblk = qb - r * nb;
          const float slope = exp2f(-8.0f * (float)(4 * g + h + 1) / 12.0f);
          CtxB c{Z + (size_t)seqbase * ZW, (float*)(ws + WS_LSE) + ((size_t)g * NTOK + seqbase) * 4 + h, d, r, Ls, mblk * 128,
                 768 + ((0 * 3 + g) * 4 + h) * 64, 768 + ((1 * 3 + g) * 4 + h) * 64, 768 + ((2 * 3 + g) * 4 + h) * 64, slope * (float)d * LOG2E};
          attn_item<64, 64, 2, true>(smem, c);
        }
      }
    } break;
    case 3: {
      const float* lse = (const float*)(ws + WS_LSE);
      for (int i = blockIdx.x * 256 + tid; i < NTOK * 32; i += gridDim.x * 256) {
        const int T = i >> 5, h = (i >> 3) & 3, c8 = i & 7;
        const float l0 = ld_agent_f32(lse + ((size_t)0 * NTOK + T) * 4 + h), l1 = ld_agent_f32(lse + ((size_t)1 * NTOK + T) * 4 + h), l2 = ld_agent_f32(lse + ((size_t)2 * NTOK + T) * 4 + h);
        const float mx = fmaxf(l0, fmaxf(l1, l2));
        float w0 = __builtin_amdgcn_exp2f(l0 - mx), w1 = __builtin_amdgcn_exp2f(l1 - mx), w2 = __builtin_amdgcn_exp2f(l2 - mx);
        const float inv = 1.0f / (w0 + w1 + w2); w0 *= inv; w1 *= inv; w2 *= inv;
        const bf16_t* zr = Z + (size_t)T * ZW;
        const u32x4 a = ld_agent_u32x4(zr + 768 + (0 * 4 + h) * 64 + c8 * 8), b = ld_agent_u32x4(zr + 768 + (1 * 4 + h) * 64 + c8 * 8), cc = ld_agent_u32x4(zr + 768 + (2 * 4 + h) * 64 + c8 * 8);
        u32x4 o;
#pragma unroll
        for (int k = 0; k < 4; ++k) {
          const float lo = w0 * bf2f((unsigned short)(a[k] & 0xffff)) + w1 * bf2f((unsigned short)(b[k] & 0xffff)) + w2 * bf2f((unsigned short)(cc[k] & 0xffff));
          const float hi = w0 * bf2f((unsigned short)(a[k] >> 16)) + w1 * bf2f((unsigned short)(b[k] >> 16)) + w2 * bf2f((unsigned short)(cc[k] >> 16));
          o[k] = cvtpk(lo, hi);
        }
        *(u32x4*)(Z + (size_t)T * ZW + 512 + h * 64 + c8 * 8) = o;
      }
    } break;
    case 4: case 7: case 9: case 12: case 15: case 17: {
      const bf16_t* A; int lda, K; const bf16_t* Bt;
      if (ph == 4) { A = Z; lda = ZW; K = 768; Bt = (const bf16_t*)(ws + WS_WT_OUT_AB); }
      else if (ph == 12) { A = Z; lda = ZW; K = 1024; Bt = (const bf16_t*)(ws + WS_WT_OUT_C); }
      else if (ph == 7 || ph == 15) { A = Z; lda = 1024; K = 1024; Bt = (const bf16_t*)(ws + WS_WT_O) + (size_t)L * 1024 * 1024; }
      else { A = Z; lda = DFF; K = DFF; Bt = (const bf16_t*)(ws + WS_WT_DOWN) + (size_t)L * 1024 * DFF; }
      for (int t = blockIdx.x; t < 512 * 8; t += gridDim.x) {
        int mt, nt; tile_map(t, 8, gridDim.x, mt, nt);
        EpiResid e{ph == 4 ? xin_row(p, mt * 128) : p.out + (size_t)mt * 128 * 1024, p.out};
        gemm_tile<false>(smem, A + (size_t)mt * 128 * lda, lda, Bt + (size_t)nt * 128 * K, K, e, mt * 128, nt * 128);
      }
    } break;
    case 5: case 10: case 13: {
      const bf16_t* Bt; int NT, ldc;
      if (ph == 10) { Bt = (const bf16_t*)(ws + WS_WT_IN_C); NT = 24; ldc = ZW; }
      else { Bt = (const bf16_t*)(ws + WS_WT_Q) + (size_t)L * 1024 * 1024; NT = 8; ldc = 1024; }
      for (int t = blockIdx.x; t < 512 * NT; t += gridDim.x) {
        int mt, nt; tile_map(t, NT, gridDim.x, mt, nt);
        EpiStore<true> e{Z, ldc};
        gemm_tile<true>(smem, p.out + (size_t)mt * 128 * 1024, 1024, Bt + (size_t)nt * 128 * 1024, 1024, e, mt * 128, nt * 128);
      }
    } break;
    case 6: case 14: {
      const bf16_t* kvm = (const bf16_t*)(ws + WS_KVMEM) + (size_t)L * 4608 * 2048;
      for (int it = blockIdx.x; it < 4096; it += gridDim.x) {
        int idx = it; if (gridDim.x == 512) idx = (blockIdx.x & 7) * 512 + (blockIdx.x >> 3) + 64 * (it >> 9);
        const int h = idx & 3, tile = idx >> 2, T0 = tile * 64;
        const int bidx = T0 < NPROMPT ? (T0 >> 11) : 16 + ((T0 - NPROMPT) >> 14);
        CtxX c{Z + (size_t)T0 * 1024 + h * 256, kvm + (size_t)bidx * 256 * 2048 + h * 256};
        attn_item<256, 32, 1, false>(smem, c);
      }
    } break;
    case 8: case 16: {
      const bf16_t* Bt = (const bf16_t*)(ws + WS_WT_GU) + (size_t)L * 5632 * 1024;
      for (int t = blockIdx.x; t < 512 * 44; t += gridDim.x) {
        int mt, nt; tile_map(t, 44, gridDim.x, mt, nt);
        EpiSwiGLU e{Z};
        gemm_tile<true>(smem, p.out + (size_t)mt * 128 * 1024, 1024, Bt + (size_t)nt * 128 * 1024, 1024, e, mt * 128, nt * 128);
      }
    } break;
    case 11: {
      float* srpb = (float*)(smem + 2 * 64 * 72 * 2);
      for (int it = blockIdx.x; it < 8192; it += gridDim.x) {
        int h = it & 15, tt = it >> 4;
        if (gridDim.x == 512) { const int l = (blockIdx.x >> 3) + 64 * (it >> 9); h = 2 * (blockIdx.x & 7) + (l & 1); tt = l >> 1; }
        int seqbase, rp, S; tile_seq(tt, seqbase, rp, S);
        const int R = S >> 6, r0 = 2 * rp;
        int rb = r0 - 4; rb = rb < 0 ? 0 : rb; rb = rb > R - 8 ? R - 8 : rb;
        __syncthreads();
        for (int i = tid; i < 15 * 31; i += 256) srpb[i] = p.rpb_c[h * 15 * 31 + i];
        CtxC c{Z + (size_t)seqbase * ZW, srpb, R, r0, rb, h * 64};
        attn_item<64, 64, 2, true>(smem, c);
      }
    } break;
    case 18: {
      const int lane = tid & 63, wv = blockIdx.x * 4 + (tid >> 6), nwv = gridDim.x * 4;
      for (int row = wv; row < NTOK; row += nwv) {
        float* xr = p.out + (size_t)row * 1024;
        f32x4 v[4]; float s = 0.f;
#pragma unroll
        for (int i = 0; i < 4; ++i) { v[i] = ld_agent_f32x4(xr + i * 256 + lane * 4); s += v[i][0] * v[i][0] + v[i][1] * v[i][1] + v[i][2] * v[i][2] + v[i][3] * v[i][3]; }
        s += __shfl_xor(s, 1); s += __shfl_xor(s, 2); s += __shfl_xor(s, 4); s += __shfl_xor(s, 8); s += __shfl_xor(s, 16); s += __shfl_xor(s, 32);
        const float r = rsqrtf(s * (1.0f / 1024.0f) + EPS);
#pragma unroll
        for (int i = 0; i < 4; ++i) { const f32x4 g = *(const f32x4*)(p.g_final + i * 256 + lane * 4); *(f32x4*)(xr + i * 256 + lane * 4) = v[i] * r * g; }
      }
    } break;
    default: break;
  }
}

constexpr int NPHASE = 19;

template <bool COOP>
__global__ void __launch_bounds__(256, 2) mega(Params p) {
  __shared__ __attribute__((aligned(16))) unsigned char smem[SMEM_BYTES];
#ifdef DIAG_FILL
  if constexpr (COOP) {
    u32x4 zz = (u32x4){0u, 0u, 0u, 0u};
    for (size_t i = (size_t)blockIdx.x * 256 + threadIdx.x; i < (WS_END - WS_Z) / 16; i += (size_t)gridDim.x * 256) ((u32x4*)(p.ws + WS_Z))[i] = zz;
    cg::this_grid().sync();
  }
#endif
  for (int ph = p.phase_lo; ph < p.phase_hi; ++ph) {
    run_phase(ph, p, smem);
    if constexpr (COOP) { if (ph + 1 < p.phase_hi) cg::this_grid().sync(); }
  }
}

extern "C" void kernel_launch(void* const* d_in, const int* in_sizes, int n_in, void* d_out, int out_size, void* d_ws, size_t ws_size, hipStream_t stream) {
  static int grid = 0;
  if (grid == 0) {
    if (n_in != 21 || ws_size < WS_END) { fprintf(stderr, "kernel_launch: n_in %d ws %zu (need %zu)\n", n_in, ws_size, (size_t)WS_END); grid = -1; return; }
    int dev = 0, cus = 0, per_cu = 0;
    hipGetDevice(&dev);
    hipDeviceGetAttribute(&cus, hipDeviceAttributeMultiprocessorCount, dev);
#if MULTI_LAUNCH
    hipOccupancyMaxActiveBlocksPerMultiprocessor(&per_cu, (const void*)mega<false>, 256, 0);
#else
    hipOccupancyMaxActiveBlocksPerMultiprocessor(&per_cu, (const void*)mega<true>, 256, 0);
#endif
    if (per_cu < 1) per_cu = 1;
    if (per_cu > 2) per_cu = 2;
    grid = cus * per_cu;
  }
  if (grid < 0) return;
  Params p{};
  p.x_prompt = (const float*)d_in[0]; p.x_sample = (const float*)d_in[1]; p.mem_prompt = (const float*)d_in[2]; p.mem_sample = (const float*)d_in[3];
  p.g_mix = (const float*)d_in[4]; p.w_in_ab = (const float*)d_in[5]; p.g_qn = (const float*)d_in[6]; p.g_kn = (const float*)d_in[7]; p.w_out_ab = (const float*)d_in[8];
  p.w_in_c = (const float*)d_in[9]; p.rpb_c = (const float*)d_in[10]; p.w_out_c = (const float*)d_in[11]; p.g_xattn = (const float*)d_in[12]; p.g_mem = (const float*)d_in[13];
  p.wq_x = (const float*)d_in[14]; p.wkv_x = (const float*)d_in[15]; p.wo_x = (const float*)d_in[16]; p.g_ffn = (const float*)d_in[17]; p.w_gu = (const float*)d_in[18]; p.w_down = (const float*)d_in[19];
  p.g_final = (const float*)d_in[20];
  p.out = (float*)d_out; p.ws = (unsigned char*)d_ws;
#if MULTI_LAUNCH
  for (int ph = 0; ph < NPHASE; ++ph) {
    p.phase_lo = ph; p.phase_hi = ph + 1;
    hipLaunchKernelGGL(mega<false>, dim3(grid), dim3(256), 0, stream, p);
  }
#else
  p.phase_lo = 0; p.phase_hi = NPHASE;
  void* args[] = {&p};
  hipError_t e = hipLaunchCooperativeKernel((const void*)mega<true>, dim3(grid), dim3(256), args, 0, stream);
  if (e != hipSuccess) fprintf(stderr, "cooperative launch failed: %s (grid %d)\n", hipGetErrorString(e), grid);
#endif
}
#ifdef DBG_RES
template <int PH> __global__ void __launch_bounds__(256, 2) mega_one(Params p) {
  __shared__ __attribute__((aligned(16))) unsigned char smem[SMEM_BYTES];
  run_phase(PH, p, smem);
}
template __global__ void mega_one<0>(Params); template __global__ void mega_one<1>(Params); template __global__ void mega_one<2>(Params);
template __global__ void mega_one<3>(Params); template __global__ void mega_one<4>(Params); template __global__ void mega_one<5>(Params);
template __global__ void mega_one<6>(Params); template __global__ void mega_one<8>(Params); template __global__ void mega_one<11>(Params);
template __global__ void mega_one<18>(Params);
#endif
```

```cpp
#include <hip/hip_runtime.h>
#include <hip/hip_cooperative_groups.h>
#include <cstdint>
#include <cstdio>
namespace cg = cooperative_groups;

#ifndef MULTI_LAUNCH
#define MULTI_LAUNCH 0
#endif

typedef unsigned short bf16_t;
typedef short bf16x8 __attribute__((ext_vector_type(8)));
typedef short s16x4 __attribute__((ext_vector_type(4)));
typedef short v4i16_t __attribute__((ext_vector_type(4)));
typedef float f32x4 __attribute__((ext_vector_type(4)));
typedef float f32x2_t __attribute__((ext_vector_type(2)));
typedef __bf16 bf16x2_t __attribute__((ext_vector_type(2)));
typedef unsigned u32x4 __attribute__((ext_vector_type(4)));
typedef unsigned u32x2 __attribute__((ext_vector_type(2)));

#define LOG2E 1.4426950408889634f
constexpr int NTOK = 65536;
constexpr int NPROMPT = 32768;
constexpr int ZW = 3072;
constexpr int DFF = 2816;
constexpr float EPS = 1e-6f;

constexpr size_t WS_WT_IN_AB = 0;
constexpr size_t WS_WT_OUT_AB = WS_WT_IN_AB + (size_t)3072 * 1024 * 2;
constexpr size_t WS_WT_IN_C = WS_WT_OUT_AB + (size_t)1024 * 768 * 2;
constexpr size_t WS_WT_OUT_C = WS_WT_IN_C + (size_t)3072 * 1024 * 2;
constexpr size_t WS_WT_Q = WS_WT_OUT_C + (size_t)1024 * 1024 * 2;
constexpr size_t WS_WT_KV = WS_WT_Q + (size_t)2 * 1024 * 1024 * 2;
constexpr size_t WS_WT_O = WS_WT_KV + (size_t)2 * 2048 * 1024 * 2;
constexpr size_t WS_WT_GU = WS_WT_O + (size_t)2 * 1024 * 1024 * 2;
constexpr size_t WS_WT_DOWN = WS_WT_GU + (size_t)2 * 5632 * 1024 * 2;
constexpr size_t WS_KVMEM = WS_WT_DOWN + (size_t)2 * 1024 * 2816 * 2;
constexpr size_t WS_LSE = WS_KVMEM + (size_t)2 * 4608 * 2048 * 2;
constexpr size_t WS_ROPE = WS_LSE + (size_t)3 * 65536 * 4 * 4;
constexpr size_t WS_Z = WS_ROPE + (size_t)256 * 16 * 8;
constexpr size_t WS_END = WS_Z + (size_t)NTOK * ZW * 2;

constexpr int SMEM_BYTES = 2 * (128 + 256) * 40 * 2 + 512;

struct Params {
  const float* x_prompt; const float* x_sample; const float* mem_prompt; const float* mem_sample;
  const float* g_mix; const float* w_in_ab; const float* g_qn; const float* g_kn; const float* w_out_ab;
  const float* w_in_c; const float* rpb_c; const float* w_out_c; const float* g_xattn; const float* g_mem;
  const float* wq_x; const float* wkv_x; const float* wo_x; const float* g_ffn; const float* w_gu; const float* w_down;
  const float* g_final;
  float* out; unsigned char* ws;
  int phase_lo, phase_hi;
};

__device__ __forceinline__ int get_tid() { int t = threadIdx.x; asm volatile("" : "+v"(t)); return t; }
__device__ __forceinline__ unsigned cvtpk(float lo, float hi) { f32x2_t v = {lo, hi}; bf16x2_t b = __builtin_convertvector(v, bf16x2_t); return __builtin_bit_cast(unsigned, b); }
__device__ __forceinline__ float bf2f(unsigned short h) { return __uint_as_float(((unsigned)h) << 16); }
__device__ __forceinline__ s16x4 tr_read(const bf16_t* p) {
  return __builtin_bit_cast(s16x4, __builtin_amdgcn_ds_read_tr16_b64_v4i16((__attribute__((address_space(3))) v4i16_t*)p));
}
__device__ __forceinline__ const float* xin_row(const float* xp, const float* xs, int row) {
  return row < NPROMPT ? xp + (size_t)row * 1024 : xs + (size_t)(row - NPROMPT) * 1024;
}
__device__ __forceinline__ const float* mem_row(const float* mp, const float* ms, int row) {
  return row < 4096 ? mp + (size_t)row * 1024 : ms + (size_t)(row - 4096) * 1024;
}


__device__ __forceinline__ void ld16_sc1(u32x4& v, const void* p) { asm volatile("global_load_dwordx4 %0, %1, off sc1" : "=v"(v) : "v"(p) : "memory"); }
__device__ __forceinline__ void ld16_sc1(f32x4& v, const float* p) { asm volatile("global_load_dwordx4 %0, %1, off sc1" : "=v"(v) : "v"(p) : "memory"); }
__device__ __forceinline__ u32x4 ld_agent_u32x4(const void* p) {
  const unsigned long long a = __hip_atomic_load((const unsigned long long*)p, __ATOMIC_RELAXED, __HIP_MEMORY_SCOPE_AGENT);
  const unsigned long long b = __hip_atomic_load((const unsigned long long*)p + 1, __ATOMIC_RELAXED, __HIP_MEMORY_SCOPE_AGENT);
  return (u32x4){(unsigned)a, (unsigned)(a >> 32), (unsigned)b, (unsigned)(b >> 32)};
}
__device__ __forceinline__ float ld_agent_f32(const float* p) { return __uint_as_float(__hip_atomic_load((const unsigned*)p, __ATOMIC_RELAXED, __HIP_MEMORY_SCOPE_AGENT)); }
__device__ __forceinline__ f32x4 ld_agent_f32x4(const float* p) {
  const unsigned long long a = __hip_atomic_load((const unsigned long long*)p, __ATOMIC_RELAXED, __HIP_MEMORY_SCOPE_AGENT);
  const unsigned long long b = __hip_atomic_load((const unsigned long long*)p + 1, __ATOMIC_RELAXED, __HIP_MEMORY_SCOPE_AGENT);
  f32x4 v; v[0] = __uint_as_float((unsigned)a); v[1] = __uint_as_float((unsigned)(a >> 32)); v[2] = __uint_as_float((unsigned)b); v[3] = __uint_as_float((unsigned)(b >> 32)); return v;
}
__device__ __forceinline__ void tile_map(int t, int NT, int gdim, int& mt, int& nt) {
  if ((gdim & 7) == 0) { const int i = t / gdim, b = t - i * gdim; const int lt = (b >> 3) + (gdim >> 3) * i; const int ml = lt / NT; nt = lt - ml * NT; mt = (b & 7) + 8 * ml; }
  else { mt = t / NT; nt = t - mt * NT; }
}
constexpr int GLD = 40;
constexpr int G_STAGE = (128 + 256) * GLD;
template <bool AF32, class Epi>
__device__ __forceinline__ void gemm_tile(unsigned char* smem, const void* Ap, int lda, const bf16_t* WT, int N, int K, const Epi& epi, int m0, int n0) {
  const int tid = get_tid(), lane = tid & 63;
  const int wid = __builtin_amdgcn_readfirstlane(tid >> 6);
  const int wr = wid >> 1, wc = wid & 1, l15 = lane & 15, quad = lane >> 4;
  bf16_t* sbase = (bf16_t*)smem; float* sR = (float*)(smem + 2 * G_STAGE * 2);
  f32x4 acc[4][8];
#pragma unroll
  for (int m = 0; m < 4; ++m)
#pragma unroll
    for (int n = 0; n < 8; ++n) acc[m][n] = (f32x4){0.f, 0.f, 0.f, 0.f};
  float ss[4];
#pragma unroll
  for (int i = 0; i < 4; ++i) ss[i] = 0.f;
  f32x4 ra[4]; u32x4 rab[2]; u32x4 rb[4];
  const int nk = K >> 5;
  const float* Af = (const float*)Ap + (size_t)(tid >> 3) * lda + (tid & 7) * 4;
  const bf16_t* Ab = (const bf16_t*)Ap + (size_t)(tid >> 2) * lda + (tid & 3) * 8;
  const bf16_t* Bp = WT + (size_t)n0 * 32 + tid * 8;
  const size_t bstep = (size_t)N * 32;
  const int awf = (tid >> 3) * GLD + (tid & 7) * 4;
  const int awb = (tid >> 2) * GLD + (tid & 3) * 8;
#define G_LOAD(kt_) do { \
    if constexpr (AF32) { _Pragma("unroll") for (int i = 0; i < 4; ++i) ld16_sc1(ra[i], Af + (size_t)i * 32 * lda + (kt_) * 32); } \
    else { _Pragma("unroll") for (int i = 0; i < 2; ++i) ld16_sc1(rab[i], Ab + (size_t)i * 64 * lda + (kt_) * 32); } \
    _Pragma("unroll") for (int i = 0; i < 4; ++i) ld16_sc1(rb[i], Bp + (size_t)(kt_) * bstep + i * 2048); } while (0)
#define G_STORE(st_) do { bf16_t* sa_ = sbase + (st_) * G_STAGE; bf16_t* sb_ = sa_ + 128 * GLD; \
    if constexpr (AF32) { asm volatile("s_waitcnt vmcnt(0)" : "+v"(ra[0]), "+v"(ra[1]), "+v"(ra[2]), "+v"(ra[3]), "+v"(rb[0]), "+v"(rb[1]), "+v"(rb[2]), "+v"(rb[3]) :: "memory"); \
      _Pragma("unroll") for (int i = 0; i < 4; ++i) { const f32x4 v = ra[i]; \
        ss[i] += v[0] * v[0] + v[1] * v[1] + v[2] * v[2] + v[3] * v[3]; \
        u32x2 w; w.x = cvtpk(v[0], v[1]); w.y = cvtpk(v[2], v[3]); *(u32x2*)(sa_ + awf + i * 32 * GLD) = w; } } \
    else { asm volatile("s_waitcnt vmcnt(0)" : "+v"(rab[0]), "+v"(rab[1]), "+v"(rb[0]), "+v"(rb[1]), "+v"(rb[2]), "+v"(rb[3]) :: "memory"); \
      _Pragma("unroll") for (int i = 0; i < 2; ++i) *(u32x4*)(sa_ + awb + i * 64 * GLD) = rab[i]; } \
    _Pragma("unroll") for (int i = 0; i < 4; ++i) *(u32x4*)(sb_ + awb + i * 64 * GLD) = rb[i]; } while (0)
  G_LOAD(0);
  G_STORE(0);
  if (nk > 1) G_LOAD(1);
  __syncthreads();
  for (int kt = 0; kt < nk; ++kt) {
    const int cur = kt & 1;
    if (kt + 1 < nk) G_STORE(cur ^ 1);
    if (kt + 2 < nk) G_LOAD(kt + 2);
    const bf16_t* a_s = sbase + cur * G_STAGE + (wr * 64 + l15) * GLD + quad * 8;
    const bf16_t* b_s = sbase + cur * G_STAGE + 128 * GLD + (wc * 128 + l15) * GLD + quad * 8;
    bf16x8 af[4];
#pragma unroll
    for (int m = 0; m < 4; ++m) af[m] = *(const bf16x8*)(a_s + m * 16 * GLD);
#pragma unroll
    for (int nh = 0; nh < 4; ++nh) {
      bf16x8 bfr[2];
#pragma unroll
      for (int n2 = 0; n2 < 2; ++n2) bfr[n2] = *(const bf16x8*)(b_s + (nh * 2 + n2) * 16 * GLD);
#pragma unroll
      for (int m = 0; m < 4; ++m)
#pragma unroll
        for (int n2 = 0; n2 < 2; ++n2) acc[m][nh * 2 + n2] = __builtin_amdgcn_mfma_f32_16x16x32_bf16(bfr[n2], af[m], acc[m][nh * 2 + n2], 0, 0, 0);
    }
    __syncthreads();
  }
#undef G_LOAD
#undef G_STORE
  if constexpr (AF32) {
    const float invK = 1.0f / (float)K;
#pragma unroll
    for (int i = 0; i < 4; ++i) {
      float s = ss[i];
      s += __shfl_xor(s, 1); s += __shfl_xor(s, 2); s += __shfl_xor(s, 4);
      if ((tid & 7) == 0) sR[(tid >> 3) + 32 * i] = rsqrtf(s * invK + EPS);
    }
    __syncthreads();
  }
  epi(acc, m0, wr * 64, n0 + wc * 128, l15, quad, sR);
}

template <bool RS> struct EpiStore {
  bf16_t* C; int ldc;
  __device__ __forceinline__ void operator()(f32x4 (&acc)[4][8], int m0, int rl0, int cb, int l15, int quad, const float* sR) const {
#pragma unroll
    for (int m = 0; m < 4; ++m) {
      const int rl = rl0 + 16 * m + l15; const float rs = RS ? sR[rl] : 1.f;
      bf16_t* rp = C + (size_t)(m0 + rl) * ldc + cb + 4 * quad;
#pragma unroll
      for (int n = 0; n < 8; ++n) { const f32x4 v = acc[m][n] * rs; u32x2 w; w.x = cvtpk(v[0], v[1]); w.y = cvtpk(v[2], v[3]); *(u32x2*)(rp + 16 * n) = w; }
    }
  }
};
struct EpiInAB {
  bf16_t* Z; const float* gq; const float* gk; const float2* rope;
  __device__ __forceinline__ void operator()(f32x4 (&acc)[4][8], int m0, int rl0, int cb0, int l15, int quad, const float* sR) const {
#pragma unroll
    for (int hh = 0; hh < 2; ++hh) {
      const int cb = cb0 + 64 * hh;
      if (cb >= 640) {
#pragma unroll
        for (int m = 0; m < 4; ++m) {
          const int rl = rl0 + 16 * m + l15; const float rs = sR[rl];
          bf16_t* rp = Z + (size_t)(m0 + rl) * ZW + cb + 4 * quad;
#pragma unroll
          for (int n = 0; n < 4; ++n) { const f32x4 v = acc[m][4 * hh + n] * rs; u32x2 w; w.x = cvtpk(v[0], v[1]); w.y = cvtpk(v[2], v[3]); *(u32x2*)(rp + 16 * n) = w; }
        }
      } else {
        const float* g = cb < 512 ? gq : gk;
        f32x4 gv[4];
#pragma unroll
        for (int n = 0; n < 4; ++n) gv[n] = *(const f32x4*)(g + 16 * n + 4 * quad);
#pragma unroll
        for (int m = 0; m < 4; ++m) {
          const int rl = rl0 + 16 * m + l15; const int row = m0 + rl; const float rs = sR[rl];
          f32x4 z[4]; float s2 = 0.f;
#pragma unroll
          for (int n = 0; n < 4; ++n) { z[n] = acc[m][4 * hh + n] * rs; s2 += z[n][0] * z[n][0] + z[n][1] * z[n][1] + z[n][2] * z[n][2] + z[n][3] * z[n][3]; }
          s2 += __shfl_xor(s2, 16); s2 += __shfl_xor(s2, 32);
          const float r = rsqrtf(s2 * (1.0f / 64.0f) + EPS);
          const int pos = row < NPROMPT ? (row & 2047) : (row & 16383);
          const int gr = pos >> 6, gc = pos & 63;
          bf16_t* rp = Z + (size_t)row * ZW + cb + 4 * quad;
#pragma unroll
          for (int n = 0; n < 4; ++n) {
            const int ap = (n < 2) ? gr : gc;
            const f32x4 zn = z[n] * r * gv[n];
            float2 c0, c1; { const unsigned long long w0 = __hip_atomic_load((const unsigned long long*)(rope + ap * 16 + ((8 * n + 2 * quad) & 15)), __ATOMIC_RELAXED, __HIP_MEMORY_SCOPE_AGENT), w1 = __hip_atomic_load((const unsigned long long*)(rope + ap * 16 + ((8 * n + 2 * quad + 1) & 15)), __ATOMIC_RELAXED, __HIP_MEMORY_SCOPE_AGENT); c0.x = __uint_as_float((unsigned)w0); c0.y = __uint_as_float((unsigned)(w0 >> 32)); c1.x = __uint_as_float((unsigned)w1); c1.y = __uint_as_float((unsigned)(w1 >> 32)); }
            const float o0 = zn[0] * c0.x - zn[1] * c0.y, o1 = zn[0] * c0.y + zn[1] * c0.x;
            const float o2 = zn[2] * c1.x - zn[3] * c1.y, o3 = zn[2] * c1.y + zn[3] * c1.x;
            u32x2 w; w.x = cvtpk(o0, o1); w.y = cvtpk(o2, o3); *(u32x2*)(rp + 16 * n) = w;
          }
        }
      }
    }
  }
};
struct EpiResid {
  const float* src_tile; float* dst;
  __device__ __forceinline__ void operator()(f32x4 (&acc)[4][8], int m0, int rl0, int cb, int l15, int quad, const float* sR) const {
#pragma unroll
    for (int m = 0; m < 4; ++m) {
      const int rl = rl0 + 16 * m + l15;
      const float* sp = src_tile + (size_t)rl * 1024 + cb + 4 * quad; float* dp = dst + (size_t)(m0 + rl) * 1024 + cb + 4 * quad;
#pragma unroll
      for (int n = 0; n < 8; ++n) { const f32x4 x = ld_agent_f32x4(sp + 16 * n); *(f32x4*)(dp + 16 * n) = x + acc[m][n]; }
    }
  }
};
struct EpiSwiGLU {
  bf16_t* H;
  __device__ __forceinline__ void operator()(f32x4 (&acc)[4][8], int m0, int rl0, int cb, int l15, int quad, const float* sR) const {
    const int hc0 = (cb >> 8) * 128 + ((cb >> 7) & 1) * 64 + 4 * quad;
#pragma unroll
    for (int m = 0; m < 4; ++m) {
      const int rl = rl0 + 16 * m + l15; const float rs = sR[rl];
      bf16_t* rp = H + (size_t)(m0 + rl) * DFF + hc0;
#pragma unroll
      for (int pp = 0; pp < 4; ++pp) {
        const f32x4 g = acc[m][2 * pp] * rs, u = acc[m][2 * pp + 1] * rs; float h[4];
#pragma unroll
        for (int j = 0; j < 4; ++j) h[j] = g[j] / (1.0f + __expf(-g[j])) * u[j];
        u32x2 w; w.x = cvtpk(h[0], h[1]); w.y = cvtpk(h[2], h[3]); *(u32x2*)(rp + 16 * pp) = w;
      }
    }
  }
};

template <int DH, int KT, int NQT, bool PF, class Ctx>
__device__ __forceinline__ void attn_item(unsigned char* smem, const Ctx& c) {
  constexpr int LDK = DH + 8, CH = DH / 8, NCH = KT * CH / 256, NKS = DH / 32, NK4 = KT / 16, NKK = KT / 32, NDT = DH / 16;
  bf16_t* sK = (bf16_t*)smem; bf16_t* sV = sK + KT * LDK;
  const int tid = get_tid(), lane = tid & 63;
  const int wid = __builtin_amdgcn_readfirstlane(tid >> 6);
  const int l15 = lane & 15, quad = lane >> 4;
  bf16x8 qf[NQT][NKS];
#pragma unroll
  for (int qt = 0; qt < NQT; ++qt) {
    const bf16_t* qp = c.qptr(wid, qt * 16 + l15);
#pragma unroll
    for (int ks = 0; ks < NKS; ++ks) qf[qt][ks] = __builtin_bit_cast(bf16x8, ld_agent_u32x4(qp + ks * 32 + quad * 8));
  }
  f32x4 o[NQT][NDT];
  float mrow[NQT], lrow[NQT];
#pragma unroll
  for (int qt = 0; qt < NQT; ++qt) {
    mrow[qt] = -1e30f; lrow[qt] = 0.f;
#pragma unroll
    for (int dt = 0; dt < NDT; ++dt) o[qt][dt] = (f32x4){0.f, 0.f, 0.f, 0.f};
  }
  const int nt = c.ntiles();
  u32x4 rk[NCH], rv[NCH];
  if constexpr (PF) {
#pragma unroll
    for (int i = 0; i < NCH; ++i) {
      const int ci = tid + 256 * i, row = ci / CH, ch = ci % CH;
      ld16_sc1(rk[i], c.kptr(0, row) + ch * 8); ld16_sc1(rv[i], c.vptr(0, row) + ch * 8);
    }
  }
  for (int t = 0; t < nt; ++t) {
    __syncthreads();
    if constexpr (PF) {
      static_assert(!PF || NCH == 2, "wait list below is written for two chunks per matrix");
      asm volatile("s_waitcnt vmcnt(0)" : "+v"(rk[0]), "+v"(rk[NCH - 1]), "+v"(rv[0]), "+v"(rv[NCH - 1]) :: "memory");
#pragma unroll
      for (int i = 0; i < NCH; ++i) {
        const int ci = tid + 256 * i, row = ci / CH, ch = ci % CH;
        *(u32x4*)(sK + row * LDK + ch * 8) = rk[i]; *(u32x4*)(sV + row * LDK + ch * 8) = rv[i];
      }
    } else {
#pragma unroll
      for (int i = 0; i < NCH; ++i) {
        const int ci = tid + 256 * i, row = ci / CH, ch = ci % CH;
        *(u32x4*)(sK + row * LDK + ch * 8) = ld_agent_u32x4(c.kptr(t, row) + ch * 8);
      }
#pragma unroll
      for (int i = 0; i < NCH; ++i) {
        const int ci = tid + 256 * i, row = ci / CH, ch = ci % CH;
        *(u32x4*)(sV + row * LDK + ch * 8) = ld_agent_u32x4(c.vptr(t, row) + ch * 8);
      }
    }
    __syncthreads();
    if constexpr (PF) {
      if (t + 1 < nt) {
#pragma unroll
        for (int i = 0; i < NCH; ++i) {
          const int ci = tid + 256 * i, row = ci / CH, ch = ci % CH;
          ld16_sc1(rk[i], c.kptr(t + 1, row) + ch * 8); ld16_sc1(rv[i], c.vptr(t + 1, row) + ch * 8);
        }
      }
    }
    if (c.active(t, wid)) {
      f32x4 s[NQT][NK4];
#pragma unroll
      for (int qt = 0; qt < NQT; ++qt)
#pragma unroll
        for (int k4 = 0; k4 < NK4; ++k4) s[qt][k4] = (f32x4){0.f, 0.f, 0.f, 0.f};
#pragma unroll
      for (int k4 = 0; k4 < NK4; ++k4)
#pragma unroll
        for (int ks = 0; ks < NKS; ++ks) {
          const bf16x8 kf = *(const bf16x8*)(sK + (16 * k4 + l15) * LDK + ks * 32 + quad * 8);
#pragma unroll
          for (int qt = 0; qt < NQT; ++qt) s[qt][k4] = __builtin_amdgcn_mfma_f32_16x16x32_bf16(kf, qf[qt][ks], s[qt][k4], 0, 0, 0);
        }
#pragma unroll
      for (int qt = 0; qt < NQT; ++qt) {
        float mx = -1e30f;
#pragma unroll
        for (int k4 = 0; k4 < NK4; ++k4)
#pragma unroll
          for (int j = 0; j < 4; ++j) { const float v = c.score(t, wid, qt * 16 + l15, 16 * k4 + 4 * quad + j, s[qt][k4][j]); s[qt][k4][j] = v; mx = fmaxf(mx, v); }
        mx = fmaxf(mx, __shfl_xor(mx, 16)); mx = fmaxf(mx, __shfl_xor(mx, 32));
        const float mnew = fmaxf(mrow[qt], mx);
        const float alpha = __builtin_amdgcn_exp2f(mrow[qt] - mnew);
        mrow[qt] = mnew;
        float psum = 0.f;
#pragma unroll
        for (int k4 = 0; k4 < NK4; ++k4)
#pragma unroll
          for (int j = 0; j < 4; ++j) { const float pv = __builtin_amdgcn_exp2f(s[qt][k4][j] - mnew); s[qt][k4][j] = pv; psum += pv; }
        lrow[qt] = lrow[qt] * alpha + psum;
#pragma unroll
        for (int dt = 0; dt < NDT; ++dt) o[qt][dt] *= alpha;
      }
#pragma unroll
      for (int kk = 0; kk < NKK; ++kk) {
        bf16x8 pf[NQT];
#pragma unroll
        for (int qt = 0; qt < NQT; ++qt) {
          u32x4 w;
          w.x = cvtpk(s[qt][2 * kk][0], s[qt][2 * kk][1]); w.y = cvtpk(s[qt][2 * kk][2], s[qt][2 * kk][3]);
          w.z = cvtpk(s[qt][2 * kk + 1][0], s[qt][2 * kk + 1][1]); w.w = cvtpk(s[qt][2 * kk + 1][2], s[qt][2 * kk + 1][3]);
          pf[qt] = __builtin_bit_cast(bf16x8, w);
        }
        const bf16_t* vb = sV + (32 * kk + 4 * quad + (l15 >> 2)) * LDK + 4 * (l15 & 3);
#pragma unroll
        for (int dt = 0; dt < NDT; ++dt) {
          const s16x4 lo = tr_read(vb + 16 * dt);
          const s16x4 hi = tr_read(vb + 16 * LDK + 16 * dt);
          const bf16x8 vf = (bf16x8){lo[0], lo[1], lo[2], lo[3], hi[0], hi[1], hi[2], hi[3]};
#pragma unroll
          for (int qt = 0; qt < NQT; ++qt) o[qt][dt] = __builtin_amdgcn_mfma_f32_16x16x32_bf16(vf, pf[qt], o[qt][dt], 0, 0, 0);
        }
      }
    }
  }
#pragma unroll
  for (int qt = 0; qt < NQT; ++qt) {
    float l = lrow[qt];
    l += __shfl_xor(l, 16); l += __shfl_xor(l, 32);
    const float inv = 1.0f / l;
    bf16_t* op = c.optr(wid, qt * 16 + l15) + 4 * quad;
#pragma unroll
    for (int dt = 0; dt < NDT; ++dt) { const f32x4 v = o[qt][dt] * inv; u32x2 w; w.x = cvtpk(v[0], v[1]); w.y = cvtpk(v[2], v[3]); *(u32x2*)(op + 16 * dt) = w; }
    if (quad == 0) c.store_lse(wid, qt * 16 + l15, mrow[qt] + __builtin_amdgcn_logf(l));
  }
}

struct CtxA {
  bf16_t* qbase; const bf16_t* kbase; int nt;
  __device__ __forceinline__ const bf16_t* qptr(int w, int ql) const { return qbase + (size_t)(32 * w + ql) * ZW; }
  __device__ __forceinline__ bf16_t* optr(int w, int ql) const { return qbase + (size_t)(32 * w + ql) * ZW; }
  __device__ __forceinline__ const bf16_t* kptr(int t, int r) const { return kbase + (size_t)(64 * t + r) * ZW; }
  __device__ __forceinline__ const bf16_t* vptr(int t, int r) const { return kbase + (size_t)(64 * t + r) * ZW + 128; }
  __device__ __forceinline__ int ntiles() const { return nt; }
  __device__ __forceinline__ bool active(int, int) const { return true; }
  __device__ __forceinline__ float score(int, int, int, int, float s) const { return s * (0.125f * LOG2E); }
  __device__ __forceinline__ void store_lse(int, int, float) const {}
};
struct CtxB {
  bf16_t* zs; float* lse; int d, r, L, i0, qcol, kcol, vcol; float slope_l2;
  __device__ __forceinline__ const bf16_t* qptr(int w, int ql) const { return zs + (size_t)((i0 + 32 * w + ql) * d + r) * ZW + qcol; }
  __device__ __forceinline__ bf16_t* optr(int w, int ql) const { return zs + (size_t)((i0 + 32 * w + ql) * d + r) * ZW + qcol; }
  __device__ __forceinline__ int kidx(int t, int row) const { int i = i0 - 64 + 64 * t + row; i = i < 0 ? 0 : i; return i > L - 1 ? L - 1 : i; }
  __device__ __forceinline__ const bf16_t* kptr(int t, int row) const { return zs + (size_t)(kidx(t, row) * d + r) * ZW + kcol; }
  __device__ __forceinline__ const bf16_t* vptr(int t, int row) const { return zs + (size_t)(kidx(t, row) * d + r) * ZW + vcol; }
  __device__ __forceinline__ int ntiles() const { return 4; }
  __device__ __forceinline__ bool active(int t, int w) const { return w < 2 ? (t < 3) : (t >= 1); }
  __device__ __forceinline__ float score(int t, int w, int ql, int kl, float s) const {
    const int qi = i0 + 32 * w + ql, ki = i0 - 64 + 64 * t + kl; int rel = ki - qi; rel = rel < 0 ? -rel : rel;
    const bool valid = (rel <= 64) && (ki >= 0) && (ki < L);
    return valid ? s * (0.125f * LOG2E) - slope_l2 * (float)rel : -1e30f;
  }
  __device__ __forceinline__ void store_lse(int w, int ql, float v) const { lse[i0 + 32 * w + ql] = v; }
};
struct CtxC {
  bf16_t* zs; const float* rpb; int R, r0, rb, hc;
  __device__ __forceinline__ const bf16_t* qptr(int w, int ql) const { return zs + (size_t)((r0 + (w >> 1)) * 64 + 32 * (w & 1) + ql) * ZW + hc; }
  __device__ __forceinline__ bf16_t* optr(int w, int ql) const { return zs + (size_t)((r0 + (w >> 1)) * 64 + 32 * (w & 1) + ql) * ZW + hc; }
  __device__ __forceinline__ int krow(int t) const { const int kr = rb + t; return kr > R - 1 ? R - 1 : kr; }
  __device__ __forceinline__ const bf16_t* kptr(int t, int row) const { return zs + (size_t)(krow(t) * 64 + row) * ZW + 1024 + hc; }
  __device__ __forceinline__ const bf16_t* vptr(int t, int row) const { return zs + (size_t)(krow(t) * 64 + row) * ZW + 2048 + hc; }
  __device__ __forceinline__ int ntiles() const { return 9; }
  __device__ __forceinline__ int rstart(int r) const { int rs = r - 4; rs = rs < 0 ? 0 : rs; return rs > R - 8 ? R - 8 : rs; }
  __device__ __forceinline__ bool active(int t, int w) const { const int r = r0 + (w >> 1), rs = rstart(r), kr = rb + t; return kr >= rs && kr < rs + 8; }
  __device__ __forceinline__ float score(int t, int w, int ql, int kl, float s) const {
    const int r = r0 + (w >> 1), cq = 32 * (w & 1) + ql, kr = rb + t;
    int cs = cq - 8; cs = cs < 0 ? 0 : cs; cs = cs > 48 ? 48 : cs;
    const bool valid = (kl >= cs) && (kl < cs + 16);
    const int idx = valid ? (kr - r + 7) * 31 + (kl - cq + 15) : 0;
    const float b = rpb[idx];
    return valid ? (s * 0.125f + b) * LOG2E : -1e30f;
  }
  __device__ __forceinline__ void store_lse(int, int, float) const {}
};
struct CtxX {
  bf16_t* qbase; const bf16_t* kv;
  __device__ __forceinline__ const bf16_t* qptr(int w, int ql) const { return qbase + (size_t)(16 * w + ql) * 1024; }
  __device__ __forceinline__ bf16_t* optr(int w, int ql) const { return qbase + (size_t)(16 * w + ql) * 1024; }
  __device__ __forceinline__ const bf16_t* kptr(int t, int row) const { return kv + (size_t)(32 * t + row) * 2048; }
  __device__ __forceinline__ const bf16_t* vptr(int t, int row) const { return kv + (size_t)(32 * t + row) * 2048 + 1024; }
  __device__ __forceinline__ int ntiles() const { return 8; }
  __device__ __forceinline__ bool active(int, int) const { return true; }
  __device__ __forceinline__ float score(int, int, int, int, float s) const { return s * (0.0625f * LOG2E); }
  __device__ __forceinline__ void store_lse(int, int, float) const {}
};

__device__ __forceinline__ void wt_tile(unsigned char* smem, const float* src, int K, int N, const float* gain, bf16_t* dst, int perm, int t) {
  float* tl = (float*)smem;
  const int nkt = K >> 6; const int rt = t / nkt, kt = t - rt * nkt; const int R0 = rt * 64, k0 = kt * 64;
  const int tid = get_tid(); const int rr = tid & 63;
  const int R = R0 + rr; int sc = R;
  if (perm) { const int T = R >> 8, within = R & 255, wc = within >> 7, n = (within & 127) >> 4, i = within & 15; sc = (n & 1) * DFF + 128 * T + 64 * wc + 16 * (n >> 1) + i; }
  __syncthreads();
#pragma unroll 4
  for (int i = 0; i < 16; ++i) {
    const int kk = (tid >> 6) + 4 * i;
    float v = src[(size_t)(k0 + kk) * N + sc];
    if (gain) v *= gain[k0 + kk];
    tl[kk * 65 + rr] = v;
  }
  __syncthreads();
  const int r2 = tid >> 2, kq = tid & 3;
  u32x4 w0, w1;
  w0.x = cvtpk(tl[(16 * kq + 0) * 65 + r2], tl[(16 * kq + 1) * 65 + r2]); w0.y = cvtpk(tl[(16 * kq + 2) * 65 + r2], tl[(16 * kq + 3) * 65 + r2]);
  w0.z = cvtpk(tl[(16 * kq + 4) * 65 + r2], tl[(16 * kq + 5) * 65 + r2]); w0.w = cvtpk(tl[(16 * kq + 6) * 65 + r2], tl[(16 * kq + 7) * 65 + r2]);
  w1.x = cvtpk(tl[(16 * kq + 8) * 65 + r2], tl[(16 * kq + 9) * 65 + r2]); w1.y = cvtpk(tl[(16 * kq + 10) * 65 + r2], tl[(16 * kq + 11) * 65 + r2]);
  w1.z = cvtpk(tl[(16 * kq + 12) * 65 + r2], tl[(16 * kq + 13) * 65 + r2]); w1.w = cvtpk(tl[(16 * kq + 14) * 65 + r2], tl[(16 * kq + 15) * 65 + r2]);
  bf16_t* dp = dst + ((size_t)((k0 + 16 * kq) >> 5) * N + (R0 + r2)) * 32 + ((16 * kq) & 31);
  *(u32x4*)dp = w0; *(u32x4*)(dp + 8) = w1;
}
__device__ __forceinline__ void wt_matrix(unsigned char* smem, const float* src, int K, int N, const float* gain, bf16_t* dst, int perm) {
  const int ntile = (K >> 6) * (N >> 6);
  for (int t = blockIdx.x; t < ntile; t += gridDim.x) wt_tile(smem, src, K, N, gain, dst, perm, t);
}

__device__ __forceinline__ void tile_seq(int tt, int& seqbase, int& qb, int& S) {
  if (tt < 256) { seqbase = (tt >> 4) * 2048; qb = tt & 15; S = 2048; }
  else { const int u = tt - 256; seqbase = NPROMPT + (u >> 7) * 16384; qb = u & 127; S = 16384; }
}

typedef const __attribute__((address_space(4))) Params* KParams;
__device__ __forceinline__ void run_phase(int ph, KParams kp, unsigned char* smem) {
  unsigned char* ws = kp->ws;
  bf16_t* Z = (bf16_t*)(ws + WS_Z);
  const int tid = get_tid();
  const int L = ph >= 10 ? 1 : 0;
  switch (ph) {
    case 0: {
      wt_matrix(smem, kp->w_in_ab, 1024, 3072, kp->g_mix, (bf16_t*)(ws + WS_WT_IN_AB), 0);
      wt_matrix(smem, kp->w_out_ab, 768, 1024, nullptr, (bf16_t*)(ws + WS_WT_OUT_AB), 0);
      wt_matrix(smem, kp->w_in_c, 1024, 3072, kp->g_mix + 1024, (bf16_t*)(ws + WS_WT_IN_C), 0);
      wt_matrix(smem, kp->w_out_c, 1024, 1024, nullptr, (bf16_t*)(ws + WS_WT_OUT_C), 0);
      for (int l = 0; l < 2; ++l) {
        wt_matrix(smem, kp->wq_x + (size_t)l * 1024 * 1024, 1024, 1024, kp->g_xattn + l * 1024, (bf16_t*)(ws + WS_WT_Q) + (size_t)l * 1024 * 1024, 0);
        wt_matrix(smem, kp->wkv_x + (size_t)l * 1024 * 2048, 1024, 2048, kp->g_mem + l * 1024, (bf16_t*)(ws + WS_WT_KV) + (size_t)l * 2048 * 1024, 0);
        wt_matrix(smem, kp->wo_x + (size_t)l * 1024 * 1024, 1024, 1024, nullptr, (bf16_t*)(ws + WS_WT_O) + (size_t)l * 1024 * 1024, 0);
        wt_matrix(smem, kp->w_gu + (size_t)l * 1024 * 5632, 1024, 5632, kp->g_ffn + l * 1024, (bf16_t*)(ws + WS_WT_GU) + (size_t)l * 5632 * 1024, 1);
        wt_matrix(smem, kp->w_down + (size_t)l * DFF * 1024, DFF, 1024, nullptr, (bf16_t*)(ws + WS_WT_DOWN) + (size_t)l * 1024 * DFF, 0);
      }
      const int gi = blockIdx.x * 256 + tid;
      if (gi < 4096) {
        const int pos = gi >> 4, f = gi & 15;
        const float inv_freq = exp2f(-(float)f * 0.83048202372184058696f);
        const float ang = (float)pos * inv_freq;
        float2 cs; cs.x = cosf(ang); cs.y = sinf(ang);
        ((float2*)(ws + WS_ROPE))[gi] = cs;
      }
    } break;
    case 1: {
      const int n_ab = 512 * 12, n_kv = 36 * 8;
      for (int t = blockIdx.x; t < n_ab + 2 * n_kv; t += gridDim.x) {
        if (t < n_ab) {
          int mt, nt; tile_map(t, 12, gridDim.x, mt, nt);
          EpiInAB e{Z, kp->g_qn, kp->g_kn, (const float2*)(ws + WS_ROPE)};
          gemm_tile<true>(smem, xin_row(kp->x_prompt, kp->x_sample, mt * 128), 1024, (const bf16_t*)(ws + WS_WT_IN_AB), 3072, 1024, e, mt * 128, nt * 256);
        } else {
          int u = t - n_ab; const int l = u / n_kv; u -= l * n_kv; const int mt = u >> 3, nt = u & 7;
          EpiStore<true> e{(bf16_t*)(ws + WS_KVMEM) + (size_t)l * 4608 * 2048, 2048};
          gemm_tile<true>(smem, mem_row(kp->mem_prompt, kp->mem_sample, mt * 128), 1024, (const bf16_t*)(ws + WS_WT_KV) + (size_t)l * 2048 * 1024, 2048, 1024, e, mt * 128, nt * 256);
        }
      }
    } break;
    case 2: {
      for (int it = blockIdx.x; it < 4096 + 6144; it += gridDim.x) {
        if (it < 4096) {
          int seqbase, qi, h, nt;
          if (gridDim.x == 512) {
            const int bid = blockIdx.x, i = it >> 9, xcd = bid & 7, l = (bid >> 3) + 64 * (i & 3);
            if (it < 2048) { const int g = xcd >> 1, id = l * 2 + (xcd & 1); qi = id >> 2; h = (g & 1) * 4 + (id & 3); seqbase = NPROMPT + (g >> 1) * 16384; nt = 256; }
            else { const int grp = xcd + 8 * (l >> 6), id = l & 63; qi = id >> 2; h = (grp & 1) * 4 + (id & 3); seqbase = (grp >> 1) * 2048; nt = 32; }
          } else if (it < 2048) { const int s = it >> 10, rem = it & 1023; qi = rem >> 3; h = rem & 7; seqbase = NPROMPT + s * 16384; nt = 256; }
          else { const int a = it - 2048; const int s = a >> 7, rem = a & 127; qi = rem >> 3; h = rem & 7; seqbase = s * 2048; nt = 32; }
          CtxA c{Z + (size_t)(seqbase + 128 * qi) * ZW + h * 64, Z + (size_t)seqbase * ZW + 512 + (h >> 2) * 64, nt};
          attn_item<64, 64, 2, true>(smem, c);
        } else {
          const int b = it - 4096; const int h = b & 3, g = (b >> 2) % 3, tt = b / 12;
          int seqbase, qb, S; tile_seq(tt, seqbase, qb, S);
          const int d = g == 0 ? 1 : (g == 1 ? 4 : 16);
          const int Ls = S / d, nb = Ls >> 7; const int r = qb / nb, mblk = qb - r * nb;
          const float slope = exp2f(-8.0f * (float)(4 * g + h + 1) / 12.0f);
          CtxB c{Z + (size_t)seqbase * ZW, (float*)(ws + WS_LSE) + (size_t)(g * 4 + h) * NTOK + seqbase + r * Ls, d, r, Ls, mblk * 128,
                 768 + ((0 * 3 + g) * 4 + h) * 64, 768 + ((1 * 3 + g) * 4 + h) * 64, 768 + ((2 * 3 + g) * 4 + h) * 64, slope * (float)d * LOG2E};
          attn_item<64, 64, 2, true>(smem, c);
        }
      }
    } break;
    case 3: {
      const float* lse = (const float*)(ws + WS_LSE);
      for (int i = blockIdx.x * 256 + tid; i < NTOK * 32; i += gridDim.x * 256) {
        const int T = i >> 5, h = (i >> 3) & 3, c8 = i & 7;
        int sb, pos, lg;
        if (T < NPROMPT) { sb = T & ~2047; pos = T & 2047; lg = 11; } else { sb = NPROMPT + ((T - NPROMPT) & ~16383); pos = (T - NPROMPT) & 16383; lg = 14; }
        const float l0 = ld_agent_f32(lse + (size_t)(0 * 4 + h) * NTOK + sb + pos);
        const float l1 = ld_agent_f32(lse + (size_t)(1 * 4 + h) * NTOK + sb + ((pos & 3) << (lg - 2)) + (pos >> 2));
        const float l2 = ld_agent_f32(lse + (size_t)(2 * 4 + h) * NTOK + sb + ((pos & 15) << (lg - 4)) + (pos >> 4));
        const float mx = fmaxf(l0, fmaxf(l1, l2));
        float w0 = __builtin_amdgcn_exp2f(l0 - mx), w1 = __builtin_amdgcn_exp2f(l1 - mx), w2 = __builtin_amdgcn_exp2f(l2 - mx);
        const float inv = 1.0f / (w0 + w1 + w2); w0 *= inv; w1 *= inv; w2 *= inv;
        const bf16_t* zr = Z + (size_t)T * ZW;
        const u32x4 a = ld_agent_u32x4(zr + 768 + (0 * 4 + h) * 64 + c8 * 8), b = ld_agent_u32x4(zr + 768 + (1 * 4 + h) * 64 + c8 * 8), cc = ld_agent_u32x4(zr + 768 + (2 * 4 + h) * 64 + c8 * 8);
        u32x4 o;
#pragma unroll
        for (int k = 0; k < 4; ++k) {
          const float lo = w0 * bf2f((unsigned short)(a[k] & 0xffff)) + w1 * bf2f((unsigned short)(b[k] & 0xffff)) + w2 * bf2f((unsigned short)(cc[k] & 0xffff));
          const float hi = w0 * bf2f((unsigned short)(a[k] >> 16)) + w1 * bf2f((unsigned short)(b[k] >> 16)) + w2 * bf2f((unsigned short)(cc[k] >> 16));
          o[k] = cvtpk(lo, hi);
        }
        *(u32x4*)(Z + (size_t)T * ZW + 512 + h * 64 + c8 * 8) = o;
      }
    } break;
    case 4: case 7: case 9: case 12: case 15: case 17: {
      const bf16_t* A; int lda, K; const bf16_t* Bt;
      if (ph == 4) { A = Z; lda = ZW; K = 768; Bt = (const bf16_t*)(ws + WS_WT_OUT_AB); }
      else if (ph == 12) { A = Z; lda = ZW; K = 1024; Bt = (const bf16_t*)(ws + WS_WT_OUT_C); }
      else if (ph == 7 || ph == 15) { A = Z; lda = 1024; K = 1024; Bt = (const bf16_t*)(ws + WS_WT_O) + (size_t)L * 1024 * 1024; }
      else { A = Z; lda = DFF; K = DFF; Bt = (const bf16_t*)(ws + WS_WT_DOWN) + (size_t)L * 1024 * DFF; }
      for (int t = blockIdx.x; t < 512 * 4; t += gridDim.x) {
        int mt, nt; tile_map(t, 4, gridDim.x, mt, nt);
        EpiResid e{ph == 4 ? xin_row(kp->x_prompt, kp->x_sample, mt * 128) : kp->out + (size_t)mt * 128 * 1024, kp->out};
        gemm_tile<false>(smem, A + (size_t)mt * 128 * lda, lda, Bt, 1024, K, e, mt * 128, nt * 256);
      }
    } break;
    case 5: case 10: case 13: {
      const bf16_t* Bt; int NT, ldc;
      if (ph == 10) { Bt = (const bf16_t*)(ws + WS_WT_IN_C); NT = 12; ldc = ZW; }
      else { Bt = (const bf16_t*)(ws + WS_WT_Q) + (size_t)L * 1024 * 1024; NT = 4; ldc = 1024; }
      for (int t = blockIdx.x; t < 512 * NT; t += gridDim.x) {
        int mt, nt; tile_map(t, NT, gridDim.x, mt, nt);
        EpiStore<true> e{Z, ldc};
        gemm_tile<true>(smem, kp->out + (size_t)mt * 128 * 1024, 1024, Bt, NT * 256, 1024, e, mt * 128, nt * 256);
      }
    } break;
    case 6: case 14: {
      const bf16_t* kvm = (const bf16_t*)(ws + WS_KVMEM) + (size_t)L * 4608 * 2048;
      for (int it = blockIdx.x; it < 4096; it += gridDim.x) {
        int idx = it; if (gridDim.x == 512) idx = (blockIdx.x & 7) * 512 + (blockIdx.x >> 3) + 64 * (it >> 9);
        const int h = idx & 3, tile = idx >> 2, T0 = tile * 64;
        const int bidx = T0 < NPROMPT ? (T0 >> 11) : 16 + ((T0 - NPROMPT) >> 14);
        CtxX c{Z + (size_t)T0 * 1024 + h * 256, kvm + (size_t)bidx * 256 * 2048 + h * 256};
        attn_item<256, 32, 1, false>(smem, c);
      }
    } break;
    case 8: case 16: {
      const bf16_t* Bt = (const bf16_t*)(ws + WS_WT_GU) + (size_t)L * 5632 * 1024;
      for (int t = blockIdx.x; t < 512 * 22; t += gridDim.x) {
        int mt, nt; tile_map(t, 22, gridDim.x, mt, nt);
        EpiSwiGLU e{Z};
        gemm_tile<true>(smem, kp->out + (size_t)mt * 128 * 1024, 1024, Bt, 5632, 1024, e, mt * 128, nt * 256);
      }
    } break;
    case 11: {
      float* srpb = (float*)(smem + 2 * 64 * 72 * 2);
      for (int it = blockIdx.x; it < 8192; it += gridDim.x) {
        int h = it & 15, tt = it >> 4;
        if (gridDim.x == 512) { const int l = (blockIdx.x >> 3) + 64 * (it >> 9); h = 2 * (blockIdx.x & 7) + (l & 1); tt = l >> 1; }
        int seqbase, rp, S; tile_seq(tt, seqbase, rp, S);
        const int R = S >> 6, r0 = 2 * rp;
        int rb = r0 - 4; rb = rb < 0 ? 0 : rb; rb = rb > R - 8 ? R - 8 : rb;
        __syncthreads();
        for (int i = tid; i < 15 * 31; i += 256) srpb[i] = kp->rpb_c[h * 15 * 31 + i];
        CtxC c{Z + (size_t)seqbase * ZW, srpb, R, r0, rb, h * 64};
        attn_item<64, 64, 2, true>(smem, c);
      }
    } break;
    case 18: {
      const int lane = tid & 63, wv = blockIdx.x * 4 + (tid >> 6), nwv = gridDim.x * 4;
      for (int row = wv; row < NTOK; row += nwv) {
        float* xr = kp->out + (size_t)row * 1024;
        f32x4 v[4]; float s = 0.f;
#pragma unroll
        for (int i = 0; i < 4; ++i) { v[i] = ld_agent_f32x4(xr + i * 256 + lane * 4); s += v[i][0] * v[i][0] + v[i][1] * v[i][1] + v[i][2] * v[i][2] + v[i][3] * v[i][3]; }
        s += __shfl_xor(s, 1); s += __shfl_xor(s, 2); s += __shfl_xor(s, 4); s += __shfl_xor(s, 8); s += __shfl_xor(s, 16); s += __shfl_xor(s, 32);
        const float r = rsqrtf(s * (1.0f / 1024.0f) + EPS);
#pragma unroll
        for (int i = 0; i < 4; ++i) { const f32x4 g = *(const f32x4*)(kp->g_final + i * 256 + lane * 4); *(f32x4*)(xr + i * 256 + lane * 4) = v[i] * r * g; }
      }
    } break;
    default: break;
  }
}

constexpr int NPHASE = 19;

template <bool COOP>
__global__ void __launch_bounds__(256, 2) mega(Params p) {
  __shared__ __attribute__((aligned(16))) unsigned char smem[SMEM_BYTES];
  if constexpr (COOP) {
    cg::grid_group grid = cg::this_grid();
#define STEP(PH) { KParams kp = (KParams)__builtin_amdgcn_kernarg_segment_ptr(); asm volatile("" : "+s"(kp)); run_phase(PH, kp, smem); if (PH + 1 < NPHASE) grid.sync(); }
    STEP(0) STEP(1) STEP(2) STEP(3) STEP(4) STEP(5) STEP(6) STEP(7) STEP(8) STEP(9)
    STEP(10) STEP(11) STEP(12) STEP(13) STEP(14) STEP(15) STEP(16) STEP(17) STEP(18)
#undef STEP
  } else {
    for (int ph = p.phase_lo; ph < p.phase_hi; ++ph) {
      KParams kp = (KParams)__builtin_amdgcn_kernarg_segment_ptr();
      asm volatile("" : "+s"(kp));
      run_phase(ph, kp, smem);
    }
  }
}

extern "C" void kernel_launch(void* const* d_in, const int* in_sizes, int n_in, void* d_out, int out_size, void* d_ws, size_t ws_size, hipStream_t stream) {
  static int grid = 0;
  if (grid == 0) {
    if (n_in != 21 || ws_size < WS_END) { fprintf(stderr, "kernel_launch: n_in %d ws %zu (need %zu)\n", n_in, ws_size, (size_t)WS_END); grid = -1; return; }
    int dev = 0, cus = 0, per_cu = 0;
    hipGetDevice(&dev);
    hipDeviceGetAttribute(&cus, hipDeviceAttributeMultiprocessorCount, dev);
#if MULTI_LAUNCH
    hipOccupancyMaxActiveBlocksPerMultiprocessor(&per_cu, (const void*)mega<false>, 256, 0);
#else
    hipOccupancyMaxActiveBlocksPerMultiprocessor(&per_cu, (const void*)mega<true>, 256, 0);
#endif
    if (per_cu < 1) per_cu = 1;
    if (per_cu > 2) per_cu = 2;
    grid = cus * per_cu;
  }
  if (grid < 0) return;
  Params p{};
  p.x_prompt = (const float*)d_in[0]; p.x_sample = (const float*)d_in[1]; p.mem_prompt = (const float*)d_in[2]; p.mem_sample = (const float*)d_in[3];
  p.g_mix = (const float*)d_in[4]; p.w_in_ab = (const float*)d_in[5]; p.g_qn = (const float*)d_in[6]; p.g_kn = (const float*)d_in[7]; p.w_out_ab = (const float*)d_in[8];
  p.w_in_c = (const float*)d_in[9]; p.rpb_c = (const float*)d_in[10]; p.w_out_c = (const float*)d_in[11]; p.g_xattn = (const float*)d_in[12]; p.g_mem = (const float*)d_in[13];
  p.wq_x = (const float*)d_in[14]; p.wkv_x = (const float*)d_in[15]; p.wo_x = (const float*)d_in[16]; p.g_ffn = (const float*)d_in[17]; p.w_gu = (const float*)d_in[18]; p.w_down = (const float*)d_in[19];
  p.g_final = (const float*)d_in[20];
  p.out = (float*)d_out; p.ws = (unsigned char*)d_ws;
#if MULTI_LAUNCH
  for (int ph = 0; ph < NPHASE; ++ph) {
    p.phase_lo = ph; p.phase_hi = ph + 1;
    hipLaunchKernelGGL(mega<false>, dim3(grid), dim3(256), 0, stream, p);
  }
#else
  p.phase_lo = 0; p.phase_hi = NPHASE;
  void* args[] = {&p};
  hipError_t e = hipLaunchCooperativeKernel((const void*)mega<true>, dim3(grid), dim3(256), args, 0, stream);
  if (e != hipSuccess) fprintf(stderr, "cooperative launch failed: %s (grid %d)\n", hipGetErrorString(e), grid);
#endif
}
#ifdef DBG_RES
template <int PH> __global__ void __launch_bounds__(256, 2) mega_one(Params p) {
  __shared__ __attribute__((aligned(16))) unsigned char smem[SMEM_BYTES];
  run_phase(PH, (KParams)__builtin_amdgcn_kernarg_segment_ptr(), smem);
}
template __global__ void mega_one<0>(Params); template __global__ void mega_one<1>(Params); template __global__ void mega_one<2>(Params);
template __global__ void mega_one<3>(Params); template __global__ void mega_one<4>(Params); template __global__ void mega_one<5>(Params);
template __global__ void mega_one<6>(Params); template __global__ void mega_one<8>(Params); template __global__ void mega_one<11>(Params);
template __global__ void mega_one<18>(Params);
#endif
```

```cpp
#include <hip/hip_runtime.h>
#include <hip/hip_cooperative_groups.h>
#include <cstdint>
#include <cstdio>
namespace cg = cooperative_groups;

#ifndef MULTI_LAUNCH
#define MULTI_LAUNCH 0
#endif

typedef unsigned short bf16_t;
typedef short bf16x8 __attribute__((ext_vector_type(8)));
typedef short s16x4 __attribute__((ext_vector_type(4)));
typedef short v4i16_t __attribute__((ext_vector_type(4)));
typedef float f32x4 __attribute__((ext_vector_type(4)));
typedef float f32x2_t __attribute__((ext_vector_type(2)));
typedef __bf16 bf16x2_t __attribute__((ext_vector_type(2)));
typedef unsigned u32x4 __attribute__((ext_vector_type(4)));
typedef unsigned u32x2 __attribute__((ext_vector_type(2)));

#define LOG2E 1.4426950408889634f
constexpr int NTOK = 65536;
constexpr int NPROMPT = 32768;
constexpr int ZW = 3072;
constexpr int DFF = 2816;
constexpr float EPS = 1e-6f;

constexpr size_t WS_WT_IN_AB = 0;
constexpr size_t WS_WT_OUT_AB = WS_WT_IN_AB + (size_t)3072 * 1024 * 2;
constexpr size_t WS_WT_IN_C = WS_WT_OUT_AB + (size_t)1024 * 768 * 2;
constexpr size_t WS_WT_OUT_C = WS_WT_IN_C + (size_t)3072 * 1024 * 2;
constexpr size_t WS_WT_Q = WS_WT_OUT_C + (size_t)1024 * 1024 * 2;
constexpr size_t WS_WT_KV = WS_WT_Q + (size_t)2 * 1024 * 1024 * 2;
constexpr size_t WS_WT_O = WS_WT_KV + (size_t)2 * 2048 * 1024 * 2;
constexpr size_t WS_WT_GU = WS_WT_O + (size_t)2 * 1024 * 1024 * 2;
constexpr size_t WS_WT_DOWN = WS_WT_GU + (size_t)2 * 5632 * 1024 * 2;
constexpr size_t WS_KVMEM = WS_WT_DOWN + (size_t)2 * 1024 * 2816 * 2;
constexpr size_t WS_LSE = WS_KVMEM + (size_t)2 * 4608 * 2048 * 2;
constexpr size_t WS_ROPE = WS_LSE + (size_t)3 * 65536 * 4 * 4;
constexpr size_t WS_Z = WS_ROPE + (size_t)256 * 16 * 8;
constexpr size_t WS_END = WS_Z + (size_t)NTOK * ZW * 2;

constexpr int SMEM_BYTES = 2 * (128 + 256) * 40 * 2 + 512;

struct Params {
  const float* x_prompt; const float* x_sample; const float* mem_prompt; const float* mem_sample;
  const float* g_mix; const float* w_in_ab; const float* g_qn; const float* g_kn; const float* w_out_ab;
  const float* w_in_c; const float* rpb_c; const float* w_out_c; const float* g_xattn; const float* g_mem;
  const float* wq_x; const float* wkv_x; const float* wo_x; const float* g_ffn; const float* w_gu; const float* w_down;
  const float* g_final;
  float* out; unsigned char* ws;
  int phase_lo, phase_hi;
};

__device__ __forceinline__ int get_tid() { int t = threadIdx.x; asm volatile("" : "+v"(t)); return t; }
__device__ __forceinline__ unsigned cvtpk(float lo, float hi) { f32x2_t v = {lo, hi}; bf16x2_t b = __builtin_convertvector(v, bf16x2_t); return __builtin_bit_cast(unsigned, b); }
__device__ __forceinline__ float bf2f(unsigned short h) { return __uint_as_float(((unsigned)h) << 16); }
__device__ __forceinline__ s16x4 tr_read(const bf16_t* p) {
  return __builtin_bit_cast(s16x4, __builtin_amdgcn_ds_read_tr16_b64_v4i16((__attribute__((address_space(3))) v4i16_t*)p));
}
__device__ __forceinline__ const float* xin_row(const float* xp, const float* xs, int row) {
  return row < NPROMPT ? xp + (size_t)row * 1024 : xs + (size_t)(row - NPROMPT) * 1024;
}
__device__ __forceinline__ const float* mem_row(const float* mp, const float* ms, int row) {
  return row < 4096 ? mp + (size_t)row * 1024 : ms + (size_t)(row - 4096) * 1024;
}


__device__ __forceinline__ void ld16_sc1(u32x4& v, const void* p) { asm volatile("global_load_dwordx4 %0, %1, off sc1" : "=v"(v) : "v"(p) : "memory"); }
__device__ __forceinline__ void ld16_sc1(f32x4& v, const float* p) { asm volatile("global_load_dwordx4 %0, %1, off sc1" : "=v"(v) : "v"(p) : "memory"); }
__device__ __forceinline__ u32x4 ld_agent_u32x4(const void* p) {
  const unsigned long long a = __hip_atomic_load((const unsigned long long*)p, __ATOMIC_RELAXED, __HIP_MEMORY_SCOPE_AGENT);
  const unsigned long long b = __hip_atomic_load((const unsigned long long*)p + 1, __ATOMIC_RELAXED, __HIP_MEMORY_SCOPE_AGENT);
  return (u32x4){(unsigned)a, (unsigned)(a >> 32), (unsigned)b, (unsigned)(b >> 32)};
}
__device__ __forceinline__ float ld_agent_f32(const float* p) { return __uint_as_float(__hip_atomic_load((const unsigned*)p, __ATOMIC_RELAXED, __HIP_MEMORY_SCOPE_AGENT)); }
__device__ __forceinline__ f32x4 ld_agent_f32x4(const float* p) {
  const unsigned long long a = __hip_atomic_load((const unsigned long long*)p, __ATOMIC_RELAXED, __HIP_MEMORY_SCOPE_AGENT);
  const unsigned long long b = __hip_atomic_load((const unsigned long long*)p + 1, __ATOMIC_RELAXED, __HIP_MEMORY_SCOPE_AGENT);
  f32x4 v; v[0] = __uint_as_float((unsigned)a); v[1] = __uint_as_float((unsigned)(a >> 32)); v[2] = __uint_as_float((unsigned)b); v[3] = __uint_as_float((unsigned)(b >> 32)); return v;
}
__device__ __forceinline__ void tile_map(int t, int NT, int gdim, int& mt, int& nt) {
  if ((gdim & 7) == 0) { const int i = t / gdim, b = t - i * gdim; const int lt = (b >> 3) + (gdim >> 3) * i; const int ml = lt / NT; nt = lt - ml * NT; mt = (b & 7) + 8 * ml; }
  else { mt = t / NT; nt = t - mt * NT; }
}
constexpr int GLD = 40;
constexpr int G_STAGE = (128 + 256) * GLD;
template <bool AF32, class Epi>
__device__ __forceinline__ void gemm_tile(unsigned char* smem, const void* Ap, int lda, const bf16_t* WT, int N, int K, const Epi& epi, int m0, int n0) {
  const int tid = get_tid(), lane = tid & 63;
  const int wid = __builtin_amdgcn_readfirstlane(tid >> 6);
  const int wr = wid >> 1, wc = wid & 1, l15 = lane & 15, quad = lane >> 4;
  bf16_t* sbase = (bf16_t*)smem; float* sR = (float*)(smem + 2 * G_STAGE * 2);
  f32x4 acc[4][8];
#pragma unroll
  for (int m = 0; m < 4; ++m)
#pragma unroll
    for (int n = 0; n < 8; ++n) acc[m][n] = (f32x4){0.f, 0.f, 0.f, 0.f};
  float ss[4];
#pragma unroll
  for (int i = 0; i < 4; ++i) ss[i] = 0.f;
  f32x4 ra[4]; u32x4 rab[2]; u32x4 rb[4];
  const int nk = K >> 5;
  const float* Af = (const float*)Ap + (size_t)(tid >> 3) * lda + (tid & 7) * 4;
  const bf16_t* Ab = (const bf16_t*)Ap + (size_t)(tid >> 2) * lda + (tid & 3) * 8;
  const bf16_t* Bp = WT + (size_t)n0 * 32 + tid * 8;
  const size_t bstep = (size_t)N * 32;
  const int awf = (tid >> 3) * GLD + (tid & 7) * 4;
  const int awb = (tid >> 2) * GLD + (tid & 3) * 8;
#define G_LOAD(kt_) do { \
    if constexpr (AF32) { _Pragma("unroll") for (int i = 0; i < 4; ++i) ld16_sc1(ra[i], Af + (size_t)i * 32 * lda + (kt_) * 32); } \
    else { _Pragma("unroll") for (int i = 0; i < 2; ++i) ld16_sc1(rab[i], Ab + (size_t)i * 64 * lda + (kt_) * 32); } \
    _Pragma("unroll") for (int i = 0; i < 4; ++i) ld16_sc1(rb[i], Bp + (size_t)(kt_) * bstep + i * 2048); } while (0)
#define G_STORE(st_) do { bf16_t* sa_ = sbase + (st_) * G_STAGE; bf16_t* sb_ = sa_ + 128 * GLD; \
    if constexpr (AF32) { asm volatile("s_waitcnt vmcnt(0)" : "+v"(ra[0]), "+v"(ra[1]), "+v"(ra[2]), "+v"(ra[3]), "+v"(rb[0]), "+v"(rb[1]), "+v"(rb[2]), "+v"(rb[3]) :: "memory"); \
      _Pragma("unroll") for (int i = 0; i < 4; ++i) { const f32x4 v = ra[i]; \
        ss[i] += v[0] * v[0] + v[1] * v[1] + v[2] * v[2] + v[3] * v[3]; \
        u32x2 w; w.x = cvtpk(v[0], v[1]); w.y = cvtpk(v[2], v[3]); *(u32x2*)(sa_ + awf + i * 32 * GLD) = w; } } \
    else { asm volatile("s_waitcnt vmcnt(0)" : "+v"(rab[0]), "+v"(rab[1]), "+v"(rb[0]), "+v"(rb[1]), "+v"(rb[2]), "+v"(rb[3]) :: "memory"); \
      _Pragma("unroll") for (int i = 0; i < 2; ++i) *(u32x4*)(sa_ + awb + i * 64 * GLD) = rab[i]; } \
    _Pragma("unroll") for (int i = 0; i < 4; ++i) *(u32x4*)(sb_ + awb + i * 64 * GLD) = rb[i]; } while (0)
  G_LOAD(0);
  G_STORE(0);
  if (nk > 1) G_LOAD(1);
  __syncthreads();
  for (int kt = 0; kt < nk; ++kt) {
    const int cur = kt & 1;
    if (kt + 1 < nk) G_STORE(cur ^ 1);
    if (kt + 2 < nk) G_LOAD(kt + 2);
    const bf16_t* a_s = sbase + cur * G_STAGE + (wr * 64 + l15) * GLD + quad * 8;
    const bf16_t* b_s = sbase + cur * G_STAGE + 128 * GLD + (wc * 128 + l15) * GLD + quad * 8;
    bf16x8 af[4];
#pragma unroll
    for (int m = 0; m < 4; ++m) af[m] = *(const bf16x8*)(a_s + m * 16 * GLD);
#pragma unroll
    for (int nh = 0; nh < 4; ++nh) {
      bf16x8 bfr[2];
#pragma unroll
      for (int n2 = 0; n2 < 2; ++n2) bfr[n2] = *(const bf16x8*)(b_s + (nh * 2 + n2) * 16 * GLD);
#pragma unroll
      for (int m = 0; m < 4; ++m)
#pragma unroll
        for (int n2 = 0; n2 < 2; ++n2) acc[m][nh * 2 + n2] = __builtin_amdgcn_mfma_f32_16x16x32_bf16(bfr[n2], af[m], acc[m][nh * 2 + n2], 0, 0, 0);
    }
    __syncthreads();
  }
#undef G_LOAD
#undef G_STORE
  if constexpr (AF32) {
    const float invK = 1.0f / (float)K;
#pragma unroll
    for (int i = 0; i < 4; ++i) {
      float s = ss[i];
      s += __shfl_xor(s, 1); s += __shfl_xor(s, 2); s += __shfl_xor(s, 4);
      if ((tid & 7) == 0) sR[(tid >> 3) + 32 * i] = rsqrtf(s * invK + EPS);
    }
    __syncthreads();
  }
  epi(acc, m0, wr * 64, n0 + wc * 128, l15, quad, sR);
}

template <bool RS> struct EpiStore {
  bf16_t* C; int ldc;
  __device__ __forceinline__ void operator()(f32x4 (&acc)[4][8], int m0, int rl0, int cb, int l15, int quad, const float* sR) const {
#pragma unroll
    for (int m = 0; m < 4; ++m) {
      const int rl = rl0 + 16 * m + l15; const float rs = RS ? sR[rl] : 1.f;
      bf16_t* rp = C + (size_t)(m0 + rl) * ldc + cb + 4 * quad;
#pragma unroll
      for (int n = 0; n < 8; ++n) { const f32x4 v = acc[m][n] * rs; u32x2 w; w.x = cvtpk(v[0], v[1]); w.y = cvtpk(v[2], v[3]); *(u32x2*)(rp + 16 * n) = w; }
    }
  }
};
struct EpiInAB {
  bf16_t* Z; const float* gq; const float* gk; const float2* rope;
  __device__ __forceinline__ void operator()(f32x4 (&acc)[4][8], int m0, int rl0, int cb0, int l15, int quad, const float* sR) const {
#pragma unroll
    for (int hh = 0; hh < 2; ++hh) {
      const int cb = cb0 + 64 * hh;
      if (cb >= 640) {
#pragma unroll
        for (int m = 0; m < 4; ++m) {
          const int rl = rl0 + 16 * m + l15; const float rs = sR[rl];
          bf16_t* rp = Z + (size_t)(m0 + rl) * ZW + cb + 4 * quad;
#pragma unroll
          for (int n = 0; n < 4; ++n) { const f32x4 v = acc[m][4 * hh + n] * rs; u32x2 w; w.x = cvtpk(v[0], v[1]); w.y = cvtpk(v[2], v[3]); *(u32x2*)(rp + 16 * n) = w; }
        }
      } else {
        const float* g = cb < 512 ? gq : gk;
        f32x4 gv[4];
#pragma unroll
        for (int n = 0; n < 4; ++n) gv[n] = *(const f32x4*)(g + 16 * n + 4 * quad);
#pragma unroll
        for (int m = 0; m < 4; ++m) {
          const int rl = rl0 + 16 * m + l15; const int row = m0 + rl; const float rs = sR[rl];
          f32x4 z[4]; float s2 = 0.f;
#pragma unroll
          for (int n = 0; n < 4; ++n) { z[n] = acc[m][4 * hh + n] * rs; s2 += z[n][0] * z[n][0] + z[n][1] * z[n][1] + z[n][2] * z[n][2] + z[n][3] * z[n][3]; }
          s2 += __shfl_xor(s2, 16); s2 += __shfl_xor(s2, 32);
          const float r = rsqrtf(s2 * (1.0f / 64.0f) + EPS);
          const int pos = row < NPROMPT ? (row & 2047) : (row & 16383);
          const int gr = pos >> 6, gc = pos & 63;
          bf16_t* rp = Z + (size_t)row * ZW + cb + 4 * quad;
#pragma unroll
          for (int n = 0; n < 4; ++n) {
            const int ap = (n < 2) ? gr : gc;
            const f32x4 zn = z[n] * r * gv[n];
            float2 c0, c1; { const unsigned long long w0 = __hip_atomic_load((const unsigned long long*)(rope + ap * 16 + ((8 * n + 2 * quad) & 15)), __ATOMIC_RELAXED, __HIP_MEMORY_SCOPE_AGENT), w1 = __hip_atomic_load((const unsigned long long*)(rope + ap * 16 + ((8 * n + 2 * quad + 1) & 15)), __ATOMIC_RELAXED, __HIP_MEMORY_SCOPE_AGENT); c0.x = __uint_as_float((unsigned)w0); c0.y = __uint_as_float((unsigned)(w0 >> 32)); c1.x = __uint_as_float((unsigned)w1); c1.y = __uint_as_float((unsigned)(w1 >> 32)); }
            const float o0 = zn[0] * c0.x - zn[1] * c0.y, o1 = zn[0] * c0.y + zn[1] * c0.x;
            const float o2 = zn[2] * c1.x - zn[3] * c1.y, o3 = zn[2] * c1.y + zn[3] * c1.x;
            u32x2 w; w.x = cvtpk(o0, o1); w.y = cvtpk(o2, o3); *(u32x2*)(rp + 16 * n) = w;
          }
        }
      }
    }
  }
};
struct EpiResid {
  const float* src_tile; float* dst;
  __device__ __forceinline__ void operator()(f32x4 (&acc)[4][8], int m0, int rl0, int cb, int l15, int quad, const float* sR) const {
#pragma unroll
    for (int m = 0; m < 4; ++m) {
      const int rl = rl0 + 16 * m + l15;
      const float* sp = src_tile + (size_t)rl * 1024 + cb + 4 * quad; float* dp = dst + (size_t)(m0 + rl) * 1024 + cb + 4 * quad;
#pragma unroll
      for (int n = 0; n < 8; ++n) { const f32x4 x = ld_agent_f32x4(sp + 16 * n); *(f32x4*)(dp + 16 * n) = x + acc[m][n]; }
    }
  }
};
struct EpiSwiGLU {
  bf16_t* H;
  __device__ __forceinline__ void operator()(f32x4 (&acc)[4][8], int m0, int rl0, int cb, int l15, int quad, const float* sR) const {
    const int hc0 = (cb >> 8) * 128 + ((cb >> 7) & 1) * 64 + 4 * quad;
#pragma unroll
    for (int m = 0; m < 4; ++m) {
      const int rl = rl0 + 16 * m + l15; const float rs = sR[rl];
      bf16_t* rp = H + (size_t)(m0 + rl) * DFF + hc0;
#pragma unroll
      for (int pp = 0; pp < 4; ++pp) {
        const f32x4 g = acc[m][2 * pp] * rs, u = acc[m][2 * pp + 1] * rs; float h[4];
#pragma unroll
        for (int j = 0; j < 4; ++j) h[j] = g[j] / (1.0f + __expf(-g[j])) * u[j];
        u32x2 w; w.x = cvtpk(h[0], h[1]); w.y = cvtpk(h[2], h[3]); *(u32x2*)(rp + 16 * pp) = w;
      }
    }
  }
};

template <int DH, int KT, int NQT, bool PF, class Ctx>
__device__ __forceinline__ void attn_item(unsigned char* smem, const Ctx& c) {
  constexpr int LDK = DH + 8, CH = DH / 8, NCH = KT * CH / 256, NKS = DH / 32, NK4 = KT / 16, NKK = KT / 32, NDT = DH / 16;
  bf16_t* sK = (bf16_t*)smem; bf16_t* sV = sK + KT * LDK;
  const int tid = get_tid(), lane = tid & 63;
  const int wid = __builtin_amdgcn_readfirstlane(tid >> 6);
  const int l15 = lane & 15, quad = lane >> 4;
  bf16x8 qf[NQT][NKS];
#pragma unroll
  for (int qt = 0; qt < NQT; ++qt) {
    const bf16_t* qp = c.qptr(wid, qt * 16 + l15);
#pragma unroll
    for (int ks = 0; ks < NKS; ++ks) qf[qt][ks] = __builtin_bit_cast(bf16x8, ld_agent_u32x4(qp + ks * 32 + quad * 8));
  }
  f32x4 o[NQT][NDT];
  float mrow[NQT], lrow[NQT];
#pragma unroll
  for (int qt = 0; qt < NQT; ++qt) {
    mrow[qt] = -1e30f; lrow[qt] = 0.f;
#pragma unroll
    for (int dt = 0; dt < NDT; ++dt) o[qt][dt] = (f32x4){0.f, 0.f, 0.f, 0.f};
  }
  const int nt = c.ntiles();
  u32x4 rk[NCH], rv[NCH];
  if constexpr (PF) {
#pragma unroll
    for (int i = 0; i < NCH; ++i) {
      const int ci = tid + 256 * i, row = ci / CH, ch = ci % CH;
      ld16_sc1(rk[i], c.kptr(0, row) + ch * 8); ld16_sc1(rv[i], c.vptr(0, row) + ch * 8);
    }
  }
  for (int t = 0; t < nt; ++t) {
    __syncthreads();
    if constexpr (PF) {
      static_assert(!PF || NCH == 2, "wait list below is written for two chunks per matrix");
      asm volatile("s_waitcnt vmcnt(0)" : "+v"(rk[0]), "+v"(rk[NCH - 1]), "+v"(rv[0]), "+v"(rv[NCH - 1]) :: "memory");
#pragma unroll
      for (int i = 0; i < NCH; ++i) {
        const int ci = tid + 256 * i, row = ci / CH, ch = ci % CH;
        *(u32x4*)(sK + row * LDK + ch * 8) = rk[i]; *(u32x4*)(sV + row * LDK + ch * 8) = rv[i];
      }
    } else {
#pragma unroll
      for (int i = 0; i < NCH; ++i) {
        const int ci = tid + 256 * i, row = ci / CH, ch = ci % CH;
        *(u32x4*)(sK + row * LDK + ch * 8) = ld_agent_u32x4(c.kptr(t, row) + ch * 8);
      }
#pragma unroll
      for (int i = 0; i < NCH; ++i) {
        const int ci = tid + 256 * i, row = ci / CH, ch = ci % CH;
        *(u32x4*)(sV + row * LDK + ch * 8) = ld_agent_u32x4(c.vptr(t, row) + ch * 8);
      }
    }
    __syncthreads();
    if constexpr (PF) {
      if (t + 1 < nt) {
#pragma unroll
        for (int i = 0; i < NCH; ++i) {
          const int ci = tid + 256 * i, row = ci / CH, ch = ci % CH;
          ld16_sc1(rk[i], c.kptr(t + 1, row) + ch * 8); ld16_sc1(rv[i], c.vptr(t + 1, row) + ch * 8);
        }
      }
    }
    if (c.active(t, wid)) {
      constexpr int QG = NQT < 2 ? NQT : 2;
      bf16x8 pfa[NQT][NKK];
#pragma unroll
      for (int g = 0; g < NQT; g += QG) {
        f32x4 s[QG][NK4];
#pragma unroll
        for (int q = 0; q < QG; ++q)
#pragma unroll
          for (int k4 = 0; k4 < NK4; ++k4) s[q][k4] = (f32x4){0.f, 0.f, 0.f, 0.f};
#pragma unroll
        for (int k4 = 0; k4 < NK4; ++k4)
#pragma unroll
          for (int ks = 0; ks < NKS; ++ks) {
            const bf16x8 kf = *(const bf16x8*)(sK + (16 * k4 + l15) * LDK + ks * 32 + quad * 8);
#pragma unroll
            for (int q = 0; q < QG; ++q) s[q][k4] = __builtin_amdgcn_mfma_f32_16x16x32_bf16(kf, qf[g + q][ks], s[q][k4], 0, 0, 0);
          }
#pragma unroll
        for (int q = 0; q < QG; ++q) {
          const int qt = g + q;
          float mx = -1e30f;
#pragma unroll
          for (int k4 = 0; k4 < NK4; ++k4)
#pragma unroll
            for (int j = 0; j < 4; ++j) { const float v = c.score(t, wid, qt * 16 + l15, 16 * k4 + 4 * quad + j, s[q][k4][j]); s[q][k4][j] = v; mx = fmaxf(mx, v); }
          mx = fmaxf(mx, __shfl_xor(mx, 16)); mx = fmaxf(mx, __shfl_xor(mx, 32));
          const float mnew = fmaxf(mrow[qt], mx);
          const float alpha = __builtin_amdgcn_exp2f(mrow[qt] - mnew);
          mrow[qt] = mnew;
          float psum = 0.f;
#pragma unroll
          for (int k4 = 0; k4 < NK4; ++k4)
#pragma unroll
            for (int j = 0; j < 4; ++j) { const float pv = __builtin_amdgcn_exp2f(s[q][k4][j] - mnew); s[q][k4][j] = pv; psum += pv; }
          lrow[qt] = lrow[qt] * alpha + psum;
#pragma unroll
          for (int dt = 0; dt < NDT; ++dt) o[qt][dt] *= alpha;
#pragma unroll
          for (int kk = 0; kk < NKK; ++kk) {
            u32x4 w;
            w.x = cvtpk(s[q][2 * kk][0], s[q][2 * kk][1]); w.y = cvtpk(s[q][2 * kk][2], s[q][2 * kk][3]);
            w.z = cvtpk(s[q][2 * kk + 1][0], s[q][2 * kk + 1][1]); w.w = cvtpk(s[q][2 * kk + 1][2], s[q][2 * kk + 1][3]);
            pfa[qt][kk] = __builtin_bit_cast(bf16x8, w);
          }
        }
      }
#pragma unroll
      for (int kk = 0; kk < NKK; ++kk) {
        const bf16_t* vb = sV + (32 * kk + 4 * quad + (l15 >> 2)) * LDK + 4 * (l15 & 3);
#pragma unroll
        for (int dt = 0; dt < NDT; ++dt) {
          const s16x4 lo = tr_read(vb + 16 * dt);
          const s16x4 hi = tr_read(vb + 16 * LDK + 16 * dt);
          const bf16x8 vf = (bf16x8){lo[0], lo[1], lo[2], lo[3], hi[0], hi[1], hi[2], hi[3]};
#pragma unroll
          for (int qt = 0; qt < NQT; ++qt) o[qt][dt] = __builtin_amdgcn_mfma_f32_16x16x32_bf16(vf, pfa[qt][kk], o[qt][dt], 0, 0, 0);
        }
      }
    }
  }
#pragma unroll
  for (int qt = 0; qt < NQT; ++qt) {
    float l = lrow[qt];
    l += __shfl_xor(l, 16); l += __shfl_xor(l, 32);
    const float inv = 1.0f / l;
    bf16_t* op = c.optr(wid, qt * 16 + l15) + 4 * quad;
#pragma unroll
    for (int dt = 0; dt < NDT; ++dt) { const f32x4 v = o[qt][dt] * inv; u32x2 w; w.x = cvtpk(v[0], v[1]); w.y = cvtpk(v[2], v[3]); *(u32x2*)(op + 16 * dt) = w; }
    if (quad == 0) c.store_lse(wid, qt * 16 + l15, mrow[qt] + __builtin_amdgcn_logf(l));
  }
}

struct CtxA {
  bf16_t* qbase; const bf16_t* kbase; int nt;
  __device__ __forceinline__ const bf16_t* qptr(int w, int ql) const { return qbase + (size_t)(64 * w + ql) * ZW; }
  __device__ __forceinline__ bf16_t* optr(int w, int ql) const { return qbase + (size_t)(64 * w + ql) * ZW; }
  __device__ __forceinline__ const bf16_t* kptr(int t, int r) const { return kbase + (size_t)(64 * t + r) * ZW; }
  __device__ __forceinline__ const bf16_t* vptr(int t, int r) const { return kbase + (size_t)(64 * t + r) * ZW + 128; }
  __device__ __forceinline__ int ntiles() const { return nt; }
  __device__ __forceinline__ bool active(int, int) const { return true; }
  __device__ __forceinline__ float score(int, int, int, int, float s) const { return s * (0.125f * LOG2E); }
  __device__ __forceinline__ void store_lse(int, int, float) const {}
};
struct CtxB {
  bf16_t* zs; float* lse; int d, r, L, i0, qcol, kcol, vcol; float slope_l2;
  __device__ __forceinline__ const bf16_t* qptr(int w, int ql) const { return zs + (size_t)((i0 + 32 * w + ql) * d + r) * ZW + qcol; }
  __device__ __forceinline__ bf16_t* optr(int w, int ql) const { return zs + (size_t)((i0 + 32 * w + ql) * d + r) * ZW + qcol; }
  __device__ __forceinline__ int kidx(int t, int row) const { int i = i0 - 64 + 64 * t + row; i = i < 0 ? 0 : i; return i > L - 1 ? L - 1 : i; }
  __device__ __forceinline__ const bf16_t* kptr(int t, int row) const { return zs + (size_t)(kidx(t, row) * d + r) * ZW + kcol; }
  __device__ __forceinline__ const bf16_t* vptr(int t, int row) const { return zs + (size_t)(kidx(t, row) * d + r) * ZW + vcol; }
  __device__ __forceinline__ int ntiles() const { return 4; }
  __device__ __forceinline__ bool active(int t, int w) const { return w < 2 ? (t < 3) : (t >= 1); }
  __device__ __forceinline__ float score(int t, int w, int ql, int kl, float s) const {
    const int qi = i0 + 32 * w + ql, ki = i0 - 64 + 64 * t + kl; int rel = ki - qi; rel = rel < 0 ? -rel : rel;
    const bool valid = (rel <= 64) && (ki >= 0) && (ki < L);
    return valid ? s * (0.125f * LOG2E) - slope_l2 * (float)rel : -1e30f;
  }
  __device__ __forceinline__ void store_lse(int w, int ql, float v) const { lse[i0 + 32 * w + ql] = v; }
};
struct CtxC {
  bf16_t* zs; const float* rpb; int R, r0, rb, hc;
  __device__ __forceinline__ const bf16_t* qptr(int w, int ql) const { return zs + (size_t)((r0 + (w >> 1)) * 64 + 32 * (w & 1) + ql) * ZW + hc; }
  __device__ __forceinline__ bf16_t* optr(int w, int ql) const { return zs + (size_t)((r0 + (w >> 1)) * 64 + 32 * (w & 1) + ql) * ZW + hc; }
  __device__ __forceinline__ int krow(int t) const { const int kr = rb + t; return kr > R - 1 ? R - 1 : kr; }
  __device__ __forceinline__ const bf16_t* kptr(int t, int row) const { return zs + (size_t)(krow(t) * 64 + row) * ZW + 1024 + hc; }
  __device__ __forceinline__ const bf16_t* vptr(int t, int row) const { return zs + (size_t)(krow(t) * 64 + row) * ZW + 2048 + hc; }
  __device__ __forceinline__ int ntiles() const { return 9; }
  __device__ __forceinline__ int rstart(int r) const { int rs = r - 4; rs = rs < 0 ? 0 : rs; return rs > R - 8 ? R - 8 : rs; }
  __device__ __forceinline__ bool active(int t, int w) const { const int r = r0 + (w >> 1), rs = rstart(r), kr = rb + t; return kr >= rs && kr < rs + 8; }
  __device__ __forceinline__ float score(int t, int w, int ql, int kl, float s) const {
    const int r = r0 + (w >> 1), cq = 32 * (w & 1) + ql, kr = rb + t;
    int cs = cq - 8; cs = cs < 0 ? 0 : cs; cs = cs > 48 ? 48 : cs;
    const bool valid = (kl >= cs) && (kl < cs + 16);
    const int idx = valid ? (kr - r + 7) * 31 + (kl - cq + 15) : 0;
    const float b = rpb[idx];
    return valid ? (s * 0.125f + b) * LOG2E : -1e30f;
  }
  __device__ __forceinline__ void store_lse(int, int, float) const {}
};
struct CtxX {
  bf16_t* qbase; const bf16_t* kv;
  __device__ __forceinline__ const bf16_t* qptr(int w, int ql) const { return qbase + (size_t)(16 * w + ql) * 1024; }
  __device__ __forceinline__ bf16_t* optr(int w, int ql) const { return qbase + (size_t)(16 * w + ql) * 1024; }
  __device__ __forceinline__ const bf16_t* kptr(int t, int row) const { return kv + (size_t)(32 * t + row) * 2048; }
  __device__ __forceinline__ const bf16_t* vptr(int t, int row) const { return kv + (size_t)(32 * t + row) * 2048 + 1024; }
  __device__ __forceinline__ int ntiles() const { return 8; }
  __device__ __forceinline__ bool active(int, int) const { return true; }
  __device__ __forceinline__ float score(int, int, int, int, float s) const { return s * (0.0625f * LOG2E); }
  __device__ __forceinline__ void store_lse(int, int, float) const {}
};

__device__ __forceinline__ void wt_tile(unsigned char* smem, const float* src, int K, int N, const float* gain, bf16_t* dst, int perm, int t) {
  float* tl = (float*)smem;
  const int nkt = K >> 6; const int rt = t / nkt, kt = t - rt * nkt; const int R0 = rt * 64, k0 = kt * 64;
  const int tid = get_tid(); const int rr = tid & 63;
  const int R = R0 + rr; int sc = R;
  if (perm) { const int T = R >> 8, within = R & 255, wc = within >> 7, n = (within & 127) >> 4, i = within & 15; sc = (n & 1) * DFF + 128 * T + 64 * wc + 16 * (n >> 1) + i; }
  __syncthreads();
#pragma unroll 4
  for (int i = 0; i < 16; ++i) {
    const int kk = (tid >> 6) + 4 * i;
    float v = src[(size_t)(k0 + kk) * N + sc];
    if (gain) v *= gain[k0 + kk];
    tl[kk * 65 + rr] = v;
  }
  __syncthreads();
  const int r2 = tid >> 2, kq = tid & 3;
  u32x4 w0, w1;
  w0.x = cvtpk(tl[(16 * kq + 0) * 65 + r2], tl[(16 * kq + 1) * 65 + r2]); w0.y = cvtpk(tl[(16 * kq + 2) * 65 + r2], tl[(16 * kq + 3) * 65 + r2]);
  w0.z = cvtpk(tl[(16 * kq + 4) * 65 + r2], tl[(16 * kq + 5) * 65 + r2]); w0.w = cvtpk(tl[(16 * kq + 6) * 65 + r2], tl[(16 * kq + 7) * 65 + r2]);
  w1.x = cvtpk(tl[(16 * kq + 8) * 65 + r2], tl[(16 * kq + 9) * 65 + r2]); w1.y = cvtpk(tl[(16 * kq + 10) * 65 + r2], tl[(16 * kq + 11) * 65 + r2]);
  w1.z = cvtpk(tl[(16 * kq + 12) * 65 + r2], tl[(16 * kq + 13) * 65 + r2]); w1.w = cvtpk(tl[(16 * kq + 14) * 65 + r2], tl[(16 * kq + 15) * 65 + r2]);
  bf16_t* dp = dst + ((size_t)((k0 + 16 * kq) >> 5) * N + (R0 + r2)) * 32 + ((16 * kq) & 31);
  *(u32x4*)dp = w0; *(u32x4*)(dp + 8) = w1;
}
__device__ __forceinline__ void wt_matrix(unsigned char* smem, const float* src, int K, int N, const float* gain, bf16_t* dst, int perm) {
  const int ntile = (K >> 6) * (N >> 6);
  for (int t = blockIdx.x; t < ntile; t += gridDim.x) wt_tile(smem, src, K, N, gain, dst, perm, t);
}

__device__ __forceinline__ void tile_seq(int tt, int& seqbase, int& qb, int& S) {
  if (tt < 256) { seqbase = (tt >> 4) * 2048; qb = tt & 15; S = 2048; }
  else { const int u = tt - 256; seqbase = NPROMPT + (u >> 7) * 16384; qb = u & 127; S = 16384; }
}

typedef const __attribute__((address_space(4))) Params* KParams;
__device__ __forceinline__ void run_phase(int ph, KParams kp, unsigned char* smem) {
  unsigned char* ws = kp->ws;
  bf16_t* Z = (bf16_t*)(ws + WS_Z);
  const int tid = get_tid();
  const int L = ph >= 10 ? 1 : 0;
  switch (ph) {
    case 0: {
      wt_matrix(smem, kp->w_in_ab, 1024, 3072, kp->g_mix, (bf16_t*)(ws + WS_WT_IN_AB), 0);
      wt_matrix(smem, kp->w_out_ab, 768, 1024, nullptr, (bf16_t*)(ws + WS_WT_OUT_AB), 0);
      wt_matrix(smem, kp->w_in_c, 1024, 3072, kp->g_mix + 1024, (bf16_t*)(ws + WS_WT_IN_C), 0);
      wt_matrix(smem, kp->w_out_c, 1024, 1024, nullptr, (bf16_t*)(ws + WS_WT_OUT_C), 0);
      for (int l = 0; l < 2; ++l) {
        wt_matrix(smem, kp->wq_x + (size_t)l * 1024 * 1024, 1024, 1024, kp->g_xattn + l * 1024, (bf16_t*)(ws + WS_WT_Q) + (size_t)l * 1024 * 1024, 0);
        wt_matrix(smem, kp->wkv_x + (size_t)l * 1024 * 2048, 1024, 2048, kp->g_mem + l * 1024, (bf16_t*)(ws + WS_WT_KV) + (size_t)l * 2048 * 1024, 0);
        wt_matrix(smem, kp->wo_x + (size_t)l * 1024 * 1024, 1024, 1024, nullptr, (bf16_t*)(ws + WS_WT_O) + (size_t)l * 1024 * 1024, 0);
        wt_matrix(smem, kp->w_gu + (size_t)l * 1024 * 5632, 1024, 5632, kp->g_ffn + l * 1024, (bf16_t*)(ws + WS_WT_GU) + (size_t)l * 5632 * 1024, 1);
        wt_matrix(smem, kp->w_down + (size_t)l * DFF * 1024, DFF, 1024, nullptr, (bf16_t*)(ws + WS_WT_DOWN) + (size_t)l * 1024 * DFF, 0);
      }
      const int gi = blockIdx.x * 256 + tid;
      if (gi < 4096) {
        const int pos = gi >> 4, f = gi & 15;
        const float inv_freq = exp2f(-(float)f * 0.83048202372184058696f);
        const float ang = (float)pos * inv_freq;
        float2 cs; cs.x = cosf(ang); cs.y = sinf(ang);
        ((float2*)(ws + WS_ROPE))[gi] = cs;
      }
    } break;
    case 1: {
      const int n_ab = 512 * 12, n_kv = 36 * 8;
      for (int t = blockIdx.x; t < n_ab + 2 * n_kv; t += gridDim.x) {
        if (t < n_ab) {
          int mt, nt; tile_map(t, 12, gridDim.x, mt, nt);
          EpiInAB e{Z, kp->g_qn, kp->g_kn, (const float2*)(ws + WS_ROPE)};
          gemm_tile<true>(smem, xin_row(kp->x_prompt, kp->x_sample, mt * 128), 1024, (const bf16_t*)(ws + WS_WT_IN_AB), 3072, 1024, e, mt * 128, nt * 256);
        } else {
          int u = t - n_ab; const int l = u / n_kv; u -= l * n_kv; const int mt = u >> 3, nt = u & 7;
          EpiStore<true> e{(bf16_t*)(ws + WS_KVMEM) + (size_t)l * 4608 * 2048, 2048};
          gemm_tile<true>(smem, mem_row(kp->mem_prompt, kp->mem_sample, mt * 128), 1024, (const bf16_t*)(ws + WS_WT_KV) + (size_t)l * 2048 * 1024, 2048, 1024, e, mt * 128, nt * 256);
        }
      }
    } break;
    case 2: {
      for (int it = blockIdx.x; it < 2048 + 6144; it += gridDim.x) {
        if (it < 2048) {
          int seqbase, qi, h, nt;
          if (gridDim.x == 512) {
            const int bid = blockIdx.x, i = it >> 9, xcd = bid & 7, l = (bid >> 3) + 64 * (i & 1);
            if (it < 1024) { const int g = xcd >> 1, id = l * 2 + (xcd & 1); qi = id >> 2; h = (g & 1) * 4 + (id & 3); seqbase = NPROMPT + (g >> 1) * 16384; nt = 256; }
            else { const int grp = xcd + 8 * (l >> 5), id = l & 31; qi = id >> 2; h = (grp & 1) * 4 + (id & 3); seqbase = (grp >> 1) * 2048; nt = 32; }
          } else if (it < 1024) { const int s = it >> 9, rem = it & 511; qi = rem >> 3; h = rem & 7; seqbase = NPROMPT + s * 16384; nt = 256; }
          else { const int a = it - 1024; const int s = a >> 6, rem = a & 63; qi = rem >> 3; h = rem & 7; seqbase = s * 2048; nt = 32; }
          CtxA c{Z + (size_t)(seqbase + 256 * qi) * ZW + h * 64, Z + (size_t)seqbase * ZW + 512 + (h >> 2) * 64, nt};
          attn_item<64, 64, 4, true>(smem, c);
        } else {
          const int b = it - 2048; const int h = b & 3, g = (b >> 2) % 3, tt = b / 12;
          int seqbase, qb, S; tile_seq(tt, seqbase, qb, S);
          const int d = g == 0 ? 1 : (g == 1 ? 4 : 16);
          const int Ls = S / d, nb = Ls >> 7; const int r = qb / nb, mblk = qb - r * nb;
          const float slope = exp2f(-8.0f * (float)(4 * g + h + 1) / 12.0f);
          CtxB c{Z + (size_t)seqbase * ZW, (float*)(ws + WS_LSE) + (size_t)(g * 4 + h) * NTOK + seqbase + r * Ls, d, r, Ls, mblk * 128,
                 768 + ((0 * 3 + g) * 4 + h) * 64, 768 + ((1 * 3 + g) * 4 + h) * 64, 768 + ((2 * 3 + g) * 4 + h) * 64, slope * (float)d * LOG2E};
          attn_item<64, 64, 2, true>(smem, c);
        }
      }
    } break;
    case 3: {
      const float* lse = (const float*)(ws + WS_LSE);
      for (int i = blockIdx.x * 256 + tid; i < NTOK * 32; i += gridDim.x * 256) {
        const int T = i >> 5, h = (i >> 3) & 3, c8 = i & 7;
        int sb, pos, lg;
        if (T < NPROMPT) { sb = T & ~2047; pos = T & 2047; lg = 11; } else { sb = NPROMPT + ((T - NPROMPT) & ~16383); pos = (T - NPROMPT) & 16383; lg = 14; }
        const float l0 = ld_agent_f32(lse + (size_t)(0 * 4 + h) * NTOK + sb + pos);
        const float l1 = ld_agent_f32(lse + (size_t)(1 * 4 + h) * NTOK + sb + ((pos & 3) << (lg - 2)) + (pos >> 2));
        const float l2 = ld_agent_f32(lse + (size_t)(2 * 4 + h) * NTOK + sb + ((pos & 15) << (lg - 4)) + (pos >> 4));
        const float mx = fmaxf(l0, fmaxf(l1, l2));
        float w0 = __builtin_amdgcn_exp2f(l0 - mx), w1 = __builtin_amdgcn_exp2f(l1 - mx), w2 = __builtin_amdgcn_exp2f(l2 - mx);
        const float inv = 1.0f / (w0 + w1 + w2); w0 *= inv; w1 *= inv; w2 *= inv;
        const bf16_t* zr = Z + (size_t)T * ZW;
        const u32x4 a = ld_agent_u32x4(zr + 768 + (0 * 4 + h) * 64 + c8 * 8), b = ld_agent_u32x4(zr + 768 + (1 * 4 + h) * 64 + c8 * 8), cc = ld_agent_u32x4(zr + 768 + (2 * 4 + h) * 64 + c8 * 8);
        u32x4 o;
#pragma unroll
        for (int k = 0; k < 4; ++k) {
          const float lo = w0 * bf2f((unsigned short)(a[k] & 0xffff)) + w1 * bf2f((unsigned short)(b[k] & 0xffff)) + w2 * bf2f((unsigned short)(cc[k] & 0xffff));
          const float hi = w0 * bf2f((unsigned short)(a[k] >> 16)) + w1 * bf2f((unsigned short)(b[k] >> 16)) + w2 * bf2f((unsigned short)(cc[k] >> 16));
          o[k] = cvtpk(lo, hi);
        }
        *(u32x4*)(Z + (size_t)T * ZW + 512 + h * 64 + c8 * 8) = o;
      }
    } break;
    case 4: case 7: case 9: case 12: case 15: case 17: {
      const bf16_t* A; int lda, K; const bf16_t* Bt;
      if (ph == 4) { A = Z; lda = ZW; K = 768; Bt = (const bf16_t*)(ws + WS_WT_OUT_AB); }
      else if (ph == 12) { A = Z; lda = ZW; K = 1024; Bt = (const bf16_t*)(ws + WS_WT_OUT_C); }
      else if (ph == 7 || ph == 15) { A = Z; lda = 1024; K = 1024; Bt = (const bf16_t*)(ws + WS_WT_O) + (size_t)L * 1024 * 1024; }
      else { A = Z; lda = DFF; K = DFF; Bt = (const bf16_t*)(ws + WS_WT_DOWN) + (size_t)L * 1024 * DFF; }
      for (int t = blockIdx.x; t < 512 * 4; t += gridDim.x) {
        int mt, nt; tile_map(t, 4, gridDim.x, mt, nt);
        EpiResid e{ph == 4 ? xin_row(kp->x_prompt, kp->x_sample, mt * 128) : kp->out + (size_t)mt * 128 * 1024, kp->out};
        gemm_tile<false>(smem, A + (size_t)mt * 128 * lda, lda, Bt, 1024, K, e, mt * 128, nt * 256);
      }
    } break;
    case 5: case 10: case 13: {
      const bf16_t* Bt; int NT, ldc;
      if (ph == 10) { Bt = (const bf16_t*)(ws + WS_WT_IN_C); NT = 12; ldc = ZW; }
      else { Bt = (const bf16_t*)(ws + WS_WT_Q) + (size_t)L * 1024 * 1024; NT = 4; ldc = 1024; }
      for (int t = blockIdx.x; t < 512 * NT; t += gridDim.x) {
        int mt, nt; tile_map(t, NT, gridDim.x, mt, nt);
        EpiStore<true> e{Z, ldc};
        gemm_tile<true>(smem, kp->out + (size_t)mt * 128 * 1024, 1024, Bt, NT * 256, 1024, e, mt * 128, nt * 256);
      }
    } break;
    case 6: case 14: {
      const bf16_t* kvm = (const bf16_t*)(ws + WS_KVMEM) + (size_t)L * 4608 * 2048;
      for (int it = blockIdx.x; it < 4096; it += gridDim.x) {
        int idx = it; if (gridDim.x == 512) idx = (blockIdx.x & 7) * 512 + (blockIdx.x >> 3) + 64 * (it >> 9);
        const int h = idx & 3, tile = idx >> 2, T0 = tile * 64;
        const int bidx = T0 < NPROMPT ? (T0 >> 11) : 16 + ((T0 - NPROMPT) >> 14);
        CtxX c{Z + (size_t)T0 * 1024 + h * 256, kvm + (size_t)bidx * 256 * 2048 + h * 256};
        attn_item<256, 32, 1, false>(smem, c);
      }
    } break;
    case 8: case 16: {
      const bf16_t* Bt = (const bf16_t*)(ws + WS_WT_GU) + (size_t)L * 5632 * 1024;
      for (int t = blockIdx.x; t < 512 * 22; t += gridDim.x) {
        int mt, nt; tile_map(t, 22, gridDim.x, mt, nt);
        EpiSwiGLU e{Z};
        gemm_tile<true>(smem, kp->out + (size_t)mt * 128 * 1024, 1024, Bt, 5632, 1024, e, mt * 128, nt * 256);
      }
    } break;
    case 11: {
      float* srpb = (float*)(smem + 2 * 64 * 72 * 2);
      for (int it = blockIdx.x; it < 8192; it += gridDim.x) {
        int h = it & 15, tt = it >> 4;
        if (gridDim.x == 512) { const int l = (blockIdx.x >> 3) + 64 * (it >> 9); h = 2 * (blockIdx.x & 7) + (l & 1); tt = l >> 1; }
        int seqbase, rp, S; tile_seq(tt, seqbase, rp, S);
        const int R = S >> 6, r0 = 2 * rp;
        int rb = r0 - 4; rb = rb < 0 ? 0 : rb; rb = rb > R - 8 ? R - 8 : rb;
        __syncthreads();
        for (int i = tid; i < 15 * 31; i += 256) srpb[i] = kp->rpb_c[h * 15 * 31 + i];
        CtxC c{Z + (size_t)seqbase * ZW, srpb, R, r0, rb, h * 64};
        attn_item<64, 64, 2, true>(smem, c);
      }
    } break;
    case 18: {
      const int lane = tid & 63, wv = blockIdx.x * 4 + (tid >> 6), nwv = gridDim.x * 4;
      for (int row = wv; row < NTOK; row += nwv) {
        float* xr = kp->out + (size_t)row * 1024;
        f32x4 v[4]; float s = 0.f;
#pragma unroll
        for (int i = 0; i < 4; ++i) { v[i] = ld_agent_f32x4(xr + i * 256 + lane * 4); s += v[i][0] * v[i][0] + v[i][1] * v[i][1] + v[i][2] * v[i][2] + v[i][3] * v[i][3]; }
        s += __shfl_xor(s, 1); s += __shfl_xor(s, 2); s += __shfl_xor(s, 4); s += __shfl_xor(s, 8); s += __shfl_xor(s, 16); s += __shfl_xor(s, 32);
        const float r = rsqrtf(s * (1.0f / 1024.0f) + EPS);
#pragma unroll
        for (int i = 0; i < 4; ++i) { const f32x4 g = *(const f32x4*)(kp->g_final + i * 256 + lane * 4); *(f32x4*)(xr + i * 256 + lane * 4) = v[i] * r * g; }
      }
    } break;
    default: break;
  }
}

constexpr int NPHASE = 19;

template <bool COOP>
__global__ void __launch_bounds__(256, 2) mega(Params p) {
  __shared__ __attribute__((aligned(16))) unsigned char smem[SMEM_BYTES];
  if constexpr (COOP) {
    cg::grid_group grid = cg::this_grid();
#define STEP(PH) { KParams kp = (KParams)__builtin_amdgcn_kernarg_segment_ptr(); asm volatile("" : "+s"(kp)); run_phase(PH, kp, smem); if (PH + 1 < NPHASE) grid.sync(); }
    STEP(0) STEP(1) STEP(2) STEP(3) STEP(4) STEP(5) STEP(6) STEP(7) STEP(8) STEP(9)
    STEP(10) STEP(11) STEP(12) STEP(13) STEP(14) STEP(15) STEP(16) STEP(17) STEP(18)
#undef STEP
  } else {
    for (int ph = p.phase_lo; ph < p.phase_hi; ++ph) {
      KParams kp = (KParams)__builtin_amdgcn_kernarg_segment_ptr();
      asm volatile("" : "+s"(kp));
      run_phase(ph, kp, smem);
    }
  }
}

extern "C" void kernel_launch(void* const* d_in, const int* in_sizes, int n_in, void* d_out, int out_size, void* d_ws, size_t ws_size, hipStream_t stream) {
  static int grid = 0;
  if (grid == 0) {
    if (n_in != 21 || ws_size < WS_END) { fprintf(stderr, "kernel_launch: n_in %d ws %zu (need %zu)\n", n_in, ws_size, (size_t)WS_END); grid = -1; return; }
    int dev = 0, cus = 0, per_cu = 0;
    hipGetDevice(&dev);
    hipDeviceGetAttribute(&cus, hipDeviceAttributeMultiprocessorCount, dev);
#if MULTI_LAUNCH
    hipOccupancyMaxActiveBlocksPerMultiprocessor(&per_cu, (const void*)mega<false>, 256, 0);
#else
    hipOccupancyMaxActiveBlocksPerMultiprocessor(&per_cu, (const void*)mega<true>, 256, 0);
#endif
    if (per_cu < 1) per_cu = 1;
    if (per_cu > 2) per_cu = 2;
    grid = cus * per_cu;
  }
  if (grid < 0) return;
  Params p{};
  p.x_prompt = (const float*)d_in[0]; p.x_sample = (const float*)d_in[1]; p.mem_prompt = (const float*)d_in[2]; p.mem_sample = (const float*)d_in[3];
  p.g_mix = (const float*)d_in[4]; p.w_in_ab = (const float*)d_in[5]; p.g_qn = (const float*)d_in[6]; p.g_kn = (const float*)d_in[7]; p.w_out_ab = (const float*)d_in[8];
  p.w_in_c = (const float*)d_in[9]; p.rpb_c = (const float*)d_in[10]; p.w_out_c = (const float*)d_in[11]; p.g_xattn = (const float*)d_in[12]; p.g_mem = (const float*)d_in[13];
  p.wq_x = (const float*)d_in[14]; p.wkv_x = (const float*)d_in[15]; p.wo_x = (const float*)d_in[16]; p.g_ffn = (const float*)d_in[17]; p.w_gu = (const float*)d_in[18]; p.w_down = (const float*)d_in[19];
  p.g_final = (const float*)d_in[20];
  p.out = (float*)d_out; p.ws = (unsigned char*)d_ws;
#if MULTI_LAUNCH
  for (int ph = 0; ph < NPHASE; ++ph) {
    p.phase_lo = ph; p.phase_hi = ph + 1;
    hipLaunchKernelGGL(mega<false>, dim3(grid), dim3(256), 0, stream, p);
  }
#else
  p.phase_lo = 0; p.phase_hi = NPHASE;
  void* args[] = {&p};
  hipError_t e = hipLaunchCooperativeKernel((const void*)mega<true>, dim3(grid), dim3(256), args, 0, stream);
  if (e != hipSuccess) fprintf(stderr, "cooperative launch failed: %s (grid %d)\n", hipGetErrorString(e), grid);
#endif
}
#ifdef DBG_RES
template <int PH> __global__ void __launch_bounds__(256, 2) mega_one(Params p) {
  __shared__ __attribute__((aligned(16))) unsigned char smem[SMEM_BYTES];
  run_phase(PH, (KParams)__builtin_amdgcn_kernarg_segment_ptr(), smem);
}
template __global__ void mega_one<0>(Params); template __global__ void mega_one<1>(Params); template __global__ void mega_one<2>(Params);
template __global__ void mega_one<3>(Params); template __global__ void mega_one<4>(Params); template __global__ void mega_one<5>(Params);
template __global__ void mega_one<6>(Params); template __global__ void mega_one<8>(Params); template __global__ void mega_one<11>(Params);
template __global__ void mega_one<18>(Params);
#endif
```

```cpp
#include <hip/hip_runtime.h>
#include <hip/hip_cooperative_groups.h>
#include <cstdint>
#include <cstdio>
namespace cg = cooperative_groups;

#ifndef MULTI_LAUNCH
#define MULTI_LAUNCH 0
#endif

typedef unsigned short bf16_t;
typedef short bf16x8 __attribute__((ext_vector_type(8)));
typedef short s16x4 __attribute__((ext_vector_type(4)));
typedef short v4i16_t __attribute__((ext_vector_type(4)));
typedef float f32x4 __attribute__((ext_vector_type(4)));
typedef float f32x2_t __attribute__((ext_vector_type(2)));
typedef __bf16 bf16x2_t __attribute__((ext_vector_type(2)));
typedef unsigned u32x4 __attribute__((ext_vector_type(4)));
typedef unsigned u32x2 __attribute__((ext_vector_type(2)));

#define LOG2E 1.4426950408889634f
constexpr int NTOK = 65536;
constexpr int NPROMPT = 32768;
constexpr int ZW = 3072;
constexpr int DFF = 2816;
constexpr float EPS = 1e-6f;

constexpr size_t WS_WT_IN_AB = 0;
constexpr size_t WS_WT_OUT_AB = WS_WT_IN_AB + (size_t)3072 * 1024 * 2;
constexpr size_t WS_WT_IN_C = WS_WT_OUT_AB + (size_t)1024 * 768 * 2;
constexpr size_t WS_WT_OUT_C = WS_WT_IN_C + (size_t)3072 * 1024 * 2;
constexpr size_t WS_WT_Q = WS_WT_OUT_C + (size_t)1024 * 1024 * 2;
constexpr size_t WS_WT_KV = WS_WT_Q + (size_t)2 * 1024 * 1024 * 2;
constexpr size_t WS_WT_O = WS_WT_KV + (size_t)2 * 2048 * 1024 * 2;
constexpr size_t WS_WT_GU = WS_WT_O + (size_t)2 * 1024 * 1024 * 2;
constexpr size_t WS_WT_DOWN = WS_WT_GU + (size_t)2 * 5632 * 1024 * 2;
constexpr size_t WS_KVMEM = WS_WT_DOWN + (size_t)2 * 1024 * 2816 * 2;
constexpr size_t WS_LSE = WS_KVMEM + (size_t)2 * 4608 * 2048 * 2;
constexpr size_t WS_ROPE = WS_LSE + (size_t)3 * 65536 * 4 * 4;
constexpr size_t WS_Z = WS_ROPE + (size_t)256 * 16 * 8;
constexpr size_t WS_END = WS_Z + (size_t)NTOK * ZW * 2;

constexpr int SMEM_BYTES = 2 * (128 + 256) * 40 * 2 + 512;

struct Params {
  const float* x_prompt; const float* x_sample; const float* mem_prompt; const float* mem_sample;
  const float* g_mix; const float* w_in_ab; const float* g_qn; const float* g_kn; const float* w_out_ab;
  const float* w_in_c; const float* rpb_c; const float* w_out_c; const float* g_xattn; const float* g_mem;
  const float* wq_x; const float* wkv_x; const float* wo_x; const float* g_ffn; const float* w_gu; const float* w_down;
  const float* g_final;
  float* out; unsigned char* ws;
  int phase_lo, phase_hi;
};

__device__ __forceinline__ int get_tid() { int t = threadIdx.x; asm volatile("" : "+v"(t)); return t; }
__device__ __forceinline__ unsigned cvtpk(float lo, float hi) { f32x2_t v = {lo, hi}; bf16x2_t b = __builtin_convertvector(v, bf16x2_t); return __builtin_bit_cast(unsigned, b); }
__device__ __forceinline__ float bf2f(unsigned short h) { return __uint_as_float(((unsigned)h) << 16); }
__device__ __forceinline__ s16x4 tr_read(const bf16_t* p) {
  return __builtin_bit_cast(s16x4, __builtin_amdgcn_ds_read_tr16_b64_v4i16((__attribute__((address_space(3))) v4i16_t*)p));
}
__device__ __forceinline__ const float* xin_row(const float* xp, const float* xs, int row) {
  return row < NPROMPT ? xp + (size_t)row * 1024 : xs + (size_t)(row - NPROMPT) * 1024;
}
__device__ __forceinline__ const float* mem_row(const float* mp, const float* ms, int row) {
  return row < 4096 ? mp + (size_t)row * 1024 : ms + (size_t)(row - 4096) * 1024;
}


__device__ __forceinline__ void ld16_sc1(u32x4& v, const void* p) { asm volatile("global_load_dwordx4 %0, %1, off sc1" : "=v"(v) : "v"(p) : "memory"); }
__device__ __forceinline__ void ld16_sc1(f32x4& v, const float* p) { asm volatile("global_load_dwordx4 %0, %1, off sc1" : "=v"(v) : "v"(p) : "memory"); }
__device__ __forceinline__ u32x4 ld_agent_u32x4(const void* p) {
  const unsigned long long a = __hip_atomic_load((const unsigned long long*)p, __ATOMIC_RELAXED, __HIP_MEMORY_SCOPE_AGENT);
  const unsigned long long b = __hip_atomic_load((const unsigned long long*)p + 1, __ATOMIC_RELAXED, __HIP_MEMORY_SCOPE_AGENT);
  return (u32x4){(unsigned)a, (unsigned)(a >> 32), (unsigned)b, (unsigned)(b >> 32)};
}
__device__ __forceinline__ float ld_agent_f32(const float* p) { return __uint_as_float(__hip_atomic_load((const unsigned*)p, __ATOMIC_RELAXED, __HIP_MEMORY_SCOPE_AGENT)); }
__device__ __forceinline__ f32x4 ld_agent_f32x4(const float* p) {
  const unsigned long long a = __hip_atomic_load((const unsigned long long*)p, __ATOMIC_RELAXED, __HIP_MEMORY_SCOPE_AGENT);
  const unsigned long long b = __hip_atomic_load((const unsigned long long*)p + 1, __ATOMIC_RELAXED, __HIP_MEMORY_SCOPE_AGENT);
  f32x4 v; v[0] = __uint_as_float((unsigned)a); v[1] = __uint_as_float((unsigned)(a >> 32)); v[2] = __uint_as_float((unsigned)b); v[3] = __uint_as_float((unsigned)(b >> 32)); return v;
}
__device__ __forceinline__ void tile_map(int t, int NT, int gdim, int& mt, int& nt) {
  if ((gdim & 7) == 0) { const int i = t / gdim, b = t - i * gdim; const int lt = (b >> 3) + (gdim >> 3) * i; const int ml = lt / NT; nt = lt - ml * NT; mt = (b & 7) + 8 * ml; }
  else { mt = t / NT; nt = t - mt * NT; }
}
constexpr int GLD = 40;
constexpr int G_STAGE = (128 + 256) * GLD;
template <bool AF32, class Epi>
__device__ __forceinline__ void gemm_tile(unsigned char* smem, const void* Ap, int lda, const bf16_t* WT, int N, int K, const Epi& epi, int m0, int n0) {
  const int tid = get_tid(), lane = tid & 63;
  const int wid = __builtin_amdgcn_readfirstlane(tid >> 6);
  const int wr = wid >> 1, wc = wid & 1, l15 = lane & 15, quad = lane >> 4;
  bf16_t* sbase = (bf16_t*)smem; float* sR = (float*)(smem + 2 * G_STAGE * 2);
  f32x4 acc[4][8];
#pragma unroll
  for (int m = 0; m < 4; ++m)
#pragma unroll
    for (int n = 0; n < 8; ++n) acc[m][n] = (f32x4){0.f, 0.f, 0.f, 0.f};
  float ss[4];
#pragma unroll
  for (int i = 0; i < 4; ++i) ss[i] = 0.f;
  f32x4 ra[4]; u32x4 rab[2]; u32x4 rb[4];
  const int nk = K >> 5;
  const float* Af = (const float*)Ap + (size_t)(tid >> 3) * lda + (tid & 7) * 4;
  const bf16_t* Ab = (const bf16_t*)Ap + (size_t)(tid >> 2) * lda + (tid & 3) * 8;
  const bf16_t* Bp = WT + (size_t)n0 * 32 + tid * 8;
  const size_t bstep = (size_t)N * 32;
  const int awf = (tid >> 3) * GLD + (tid & 7) * 4;
  const int awb = (tid >> 2) * GLD + (tid & 3) * 8;
#define G_LOAD(kt_) do { \
    if constexpr (AF32) { _Pragma("unroll") for (int i = 0; i < 4; ++i) ld16_sc1(ra[i], Af + (size_t)i * 32 * lda + (kt_) * 32); } \
    else { _Pragma("unroll") for (int i = 0; i < 2; ++i) ld16_sc1(rab[i], Ab + (size_t)i * 64 * lda + (kt_) * 32); } \
    _Pragma("unroll") for (int i = 0; i < 4; ++i) ld16_sc1(rb[i], Bp + (size_t)(kt_) * bstep + i * 2048); } while (0)
#define G_STORE(st_) do { bf16_t* sa_ = sbase + (st_) * G_STAGE; bf16_t* sb_ = sa_ + 128 * GLD; \
    if constexpr (AF32) { asm volatile("s_waitcnt vmcnt(0)" : "+v"(ra[0]), "+v"(ra[1]), "+v"(ra[2]), "+v"(ra[3]), "+v"(rb[0]), "+v"(rb[1]), "+v"(rb[2]), "+v"(rb[3]) :: "memory"); \
      _Pragma("unroll") for (int i = 0; i < 4; ++i) { const f32x4 v = ra[i]; \
        ss[i] += v[0] * v[0] + v[1] * v[1] + v[2] * v[2] + v[3] * v[3]; \
        u32x2 w; w.x = cvtpk(v[0], v[1]); w.y = cvtpk(v[2], v[3]); *(u32x2*)(sa_ + awf + i * 32 * GLD) = w; } } \
    else { asm volatile("s_waitcnt vmcnt(0)" : "+v"(rab[0]), "+v"(rab[1]), "+v"(rb[0]), "+v"(rb[1]), "+v"(rb[2]), "+v"(rb[3]) :: "memory"); \
      _Pragma("unroll") for (int i = 0; i < 2; ++i) *(u32x4*)(sa_ + awb + i * 64 * GLD) = rab[i]; } \
    _Pragma("unroll") for (int i = 0; i < 4; ++i) *(u32x4*)(sb_ + awb + i * 64 * GLD) = rb[i]; } while (0)
  G_LOAD(0);
  G_STORE(0);
  if (nk > 1) G_LOAD(1);
  __syncthreads();
  for (int kt = 0; kt < nk; ++kt) {
    const int cur = kt & 1;
    if (kt + 1 < nk) G_STORE(cur ^ 1);
    if (kt + 2 < nk) G_LOAD(kt + 2);
    const bf16_t* a_s = sbase + cur * G_STAGE + (wr * 64 + l15) * GLD + quad * 8;
    const bf16_t* b_s = sbase + cur * G_STAGE + 128 * GLD + (wc * 128 + l15) * GLD + quad * 8;
    __builtin_amdgcn_s_setprio(1);
    bf16x8 af[4];
#pragma unroll
    for (int m = 0; m < 4; ++m) af[m] = *(const bf16x8*)(a_s + m * 16 * GLD);
#pragma unroll
    for (int nh = 0; nh < 4; ++nh) {
      bf16x8 bfr[2];
#pragma unroll
      for (int n2 = 0; n2 < 2; ++n2) bfr[n2] = *(const bf16x8*)(b_s + (nh * 2 + n2) * 16 * GLD);
#pragma unroll
      for (int m = 0; m < 4; ++m)
#pragma unroll
        for (int n2 = 0; n2 < 2; ++n2) acc[m][nh * 2 + n2] = __builtin_amdgcn_mfma_f32_16x16x32_bf16(bfr[n2], af[m], acc[m][nh * 2 + n2], 0, 0, 0);
    }
    __builtin_amdgcn_s_setprio(0);
    __syncthreads();
  }
#undef G_LOAD
#undef G_STORE
  if constexpr (AF32) {
    const float invK = 1.0f / (float)K;
#pragma unroll
    for (int i = 0; i < 4; ++i) {
      float s = ss[i];
      s += __shfl_xor(s, 1); s += __shfl_xor(s, 2); s += __shfl_xor(s, 4);
      if ((tid & 7) == 0) sR[(tid >> 3) + 32 * i] = rsqrtf(s * invK + EPS);
    }
    __syncthreads();
  }
  epi(acc, m0, wr * 64, n0 + wc * 128, l15, quad, sR);
}

template <bool RS> struct EpiStore {
  bf16_t* C; int ldc;
  __device__ __forceinline__ void operator()(f32x4 (&acc)[4][8], int m0, int rl0, int cb, int l15, int quad, const float* sR) const {
#pragma unroll
    for (int m = 0; m < 4; ++m) {
      const int rl = rl0 + 16 * m + l15; const float rs = RS ? sR[rl] : 1.f;
      bf16_t* rp = C + (size_t)(m0 + rl) * ldc + cb + 4 * quad;
#pragma unroll
      for (int n = 0; n < 8; ++n) { const f32x4 v = acc[m][n] * rs; u32x2 w; w.x = cvtpk(v[0], v[1]); w.y = cvtpk(v[2], v[3]); *(u32x2*)(rp + 16 * n) = w; }
    }
  }
};
struct EpiInAB {
  bf16_t* Z; const float* gq; const float* gk; const float2* rope;
  __device__ __forceinline__ void operator()(f32x4 (&acc)[4][8], int m0, int rl0, int cb0, int l15, int quad, const float* sR) const {
#pragma unroll
    for (int hh = 0; hh < 2; ++hh) {
      const int cb = cb0 + 64 * hh;
      if (cb >= 640) {
#pragma unroll
        for (int m = 0; m < 4; ++m) {
          const int rl = rl0 + 16 * m + l15; const float rs = sR[rl];
          bf16_t* rp = Z + (size_t)(m0 + rl) * ZW + cb + 4 * quad;
#pragma unroll
          for (int n = 0; n < 4; ++n) { const f32x4 v = acc[m][4 * hh + n] * rs; u32x2 w; w.x = cvtpk(v[0], v[1]); w.y = cvtpk(v[2], v[3]); *(u32x2*)(rp + 16 * n) = w; }
        }
      } else {
        const float* g = cb < 512 ? gq : gk;
        const float qs = cb < 512 ? 0.125f * LOG2E : 1.0f;
        f32x4 gv[4];
#pragma unroll
        for (int n = 0; n < 4; ++n) gv[n] = *(const f32x4*)(g + 16 * n + 4 * quad) * qs;
#pragma unroll
        for (int m = 0; m < 4; ++m) {
          const int rl = rl0 + 16 * m + l15; const int row = m0 + rl; const float rs = sR[rl];
          f32x4 z[4]; float s2 = 0.f;
#pragma unroll
          for (int n = 0; n < 4; ++n) { z[n] = acc[m][4 * hh + n] * rs; s2 += z[n][0] * z[n][0] + z[n][1] * z[n][1] + z[n][2] * z[n][2] + z[n][3] * z[n][3]; }
          s2 += __shfl_xor(s2, 16); s2 += __shfl_xor(s2, 32);
          const float r = rsqrtf(s2 * (1.0f / 64.0f) + EPS);
          const int pos = row < NPROMPT ? (row & 2047) : (row & 16383);
          const int gr = pos >> 6, gc = pos & 63;
          bf16_t* rp = Z + (size_t)row * ZW + cb + 4 * quad;
#pragma unroll
          for (int n = 0; n < 4; ++n) {
            const int ap = (n < 2) ? gr : gc;
            const f32x4 zn = z[n] * r * gv[n];
            float2 c0, c1; { const unsigned long long w0 = __hip_atomic_load((const unsigned long long*)(rope + ap * 16 + ((8 * n + 2 * quad) & 15)), __ATOMIC_RELAXED, __HIP_MEMORY_SCOPE_AGENT), w1 = __hip_atomic_load((const unsigned long long*)(rope + ap * 16 + ((8 * n + 2 * quad + 1) & 15)), __ATOMIC_RELAXED, __HIP_MEMORY_SCOPE_AGENT); c0.x = __uint_as_float((unsigned)w0); c0.y = __uint_as_float((unsigned)(w0 >> 32)); c1.x = __uint_as_float((unsigned)w1); c1.y = __uint_as_float((unsigned)(w1 >> 32)); }
            const float o0 = zn[0] * c0.x - zn[1] * c0.y, o1 = zn[0] * c0.y + zn[1] * c0.x;
            const float o2 = zn[2] * c1.x - zn[3] * c1.y, o3 = zn[2] * c1.y + zn[3] * c1.x;
            u32x2 w; w.x = cvtpk(o0, o1); w.y = cvtpk(o2, o3); *(u32x2*)(rp + 16 * n) = w;
          }
        }
      }
    }
  }
};
struct EpiResid {
  const float* src_tile; float* dst;
  __device__ __forceinline__ void operator()(f32x4 (&acc)[4][8], int m0, int rl0, int cb, int l15, int quad, const float* sR) const {
#pragma unroll
    for (int m = 0; m < 4; ++m) {
      const int rl = rl0 + 16 * m + l15;
      const float* sp = src_tile + (size_t)rl * 1024 + cb + 4 * quad; float* dp = dst + (size_t)(m0 + rl) * 1024 + cb + 4 * quad;
#pragma unroll
      for (int n = 0; n < 8; ++n) { const f32x4 x = ld_agent_f32x4(sp + 16 * n); *(f32x4*)(dp + 16 * n) = x + acc[m][n]; }
    }
  }
};
struct EpiSwiGLU {
  bf16_t* H;
  __device__ __forceinline__ void operator()(f32x4 (&acc)[4][8], int m0, int rl0, int cb, int l15, int quad, const float* sR) const {
    const int hc0 = (cb >> 8) * 128 + ((cb >> 7) & 1) * 64 + 4 * quad;
#pragma unroll
    for (int m = 0; m < 4; ++m) {
      const int rl = rl0 + 16 * m + l15; const float rs = sR[rl];
      bf16_t* rp = H + (size_t)(m0 + rl) * DFF + hc0;
#pragma unroll
      for (int pp = 0; pp < 4; ++pp) {
        const f32x4 g = acc[m][2 * pp] * rs, u = acc[m][2 * pp + 1] * rs; float h[4];
#pragma unroll
        for (int j = 0; j < 4; ++j) h[j] = g[j] / (1.0f + __expf(-g[j])) * u[j];
        u32x2 w; w.x = cvtpk(h[0], h[1]); w.y = cvtpk(h[2], h[3]); *(u32x2*)(rp + 16 * pp) = w;
      }
    }
  }
};

template <int DH, int KT, int NQT, bool PF, class Ctx>
__device__ __forceinline__ void attn_item(unsigned char* smem, const Ctx& c) {
  constexpr int LDK = DH + 8, CH = DH / 8, NCH = KT * CH / 256, NKS = DH / 32, NK4 = KT / 16, NKK = KT / 32, NDT = DH / 16;
  bf16_t* sK = (bf16_t*)smem; bf16_t* sV = sK + KT * LDK;
  const int tid = get_tid(), lane = tid & 63;
  const int wid = __builtin_amdgcn_readfirstlane(tid >> 6);
  const int l15 = lane & 15, quad = lane >> 4;
  bf16x8 qf[NQT][NKS];
#pragma unroll
  for (int qt = 0; qt < NQT; ++qt) {
    const bf16_t* qp = c.qptr(wid, qt * 16 + l15);
#pragma unroll
    for (int ks = 0; ks < NKS; ++ks) qf[qt][ks] = __builtin_bit_cast(bf16x8, ld_agent_u32x4(qp + ks * 32 + quad * 8));
  }
  f32x4 o[NQT][NDT];
  float mrow[NQT], lrow[NQT];
#pragma unroll
  for (int qt = 0; qt < NQT; ++qt) {
    mrow[qt] = -1e30f; lrow[qt] = 0.f;
#pragma unroll
    for (int dt = 0; dt < NDT; ++dt) o[qt][dt] = (f32x4){0.f, 0.f, 0.f, 0.f};
  }
  const int nt = c.ntiles();
  u32x4 rk[NCH], rv[NCH];
  if constexpr (PF) {
#pragma unroll
    for (int i = 0; i < NCH; ++i) {
      const int ci = tid + 256 * i, row = ci / CH, ch = ci % CH;
      ld16_sc1(rk[i], c.kptr(0, row) + ch * 8); ld16_sc1(rv[i], c.vptr(0, row) + ch * 8);
    }
  }
  for (int t = 0; t < nt; ++t) {
    __syncthreads();
    if constexpr (PF) {
      static_assert(!PF || NCH == 2, "wait list below is written for two chunks per matrix");
      asm volatile("s_waitcnt vmcnt(0)" : "+v"(rk[0]), "+v"(rk[NCH - 1]), "+v"(rv[0]), "+v"(rv[NCH - 1]) :: "memory");
#pragma unroll
      for (int i = 0; i < NCH; ++i) {
        const int ci = tid + 256 * i, row = ci / CH, ch = ci % CH;
        *(u32x4*)(sK + row * LDK + ch * 8) = rk[i]; *(u32x4*)(sV + row * LDK + ch * 8) = rv[i];
      }
    } else {
#pragma unroll
      for (int i = 0; i < NCH; ++i) {
        const int ci = tid + 256 * i, row = ci / CH, ch = ci % CH;
        *(u32x4*)(sK + row * LDK + ch * 8) = ld_agent_u32x4(c.kptr(t, row) + ch * 8);
      }
#pragma unroll
      for (int i = 0; i < NCH; ++i) {
        const int ci = tid + 256 * i, row = ci / CH, ch = ci % CH;
        *(u32x4*)(sV + row * LDK + ch * 8) = ld_agent_u32x4(c.vptr(t, row) + ch * 8);
      }
    }
    __syncthreads();
    if constexpr (PF) {
      if (t + 1 < nt) {
#pragma unroll
        for (int i = 0; i < NCH; ++i) {
          const int ci = tid + 256 * i, row = ci / CH, ch = ci % CH;
          ld16_sc1(rk[i], c.kptr(t + 1, row) + ch * 8); ld16_sc1(rv[i], c.vptr(t + 1, row) + ch * 8);
        }
      }
    }
    if (c.active(t, wid)) {
      constexpr int QG = NQT < 2 ? NQT : 2;
      bf16x8 pfa[NQT][NKK];
#pragma unroll
      for (int g = 0; g < NQT; g += QG) {
        f32x4 s[QG][NK4];
#pragma unroll
        for (int q = 0; q < QG; ++q)
#pragma unroll
          for (int k4 = 0; k4 < NK4; ++k4) s[q][k4] = (f32x4){0.f, 0.f, 0.f, 0.f};
#pragma unroll
        for (int k4 = 0; k4 < NK4; ++k4)
#pragma unroll
          for (int ks = 0; ks < NKS; ++ks) {
            const bf16x8 kf = *(const bf16x8*)(sK + (16 * k4 + l15) * LDK + ks * 32 + quad * 8);
#pragma unroll
            for (int q = 0; q < QG; ++q) s[q][k4] = __builtin_amdgcn_mfma_f32_16x16x32_bf16(kf, qf[g + q][ks], s[q][k4], 0, 0, 0);
          }
#pragma unroll
        for (int q = 0; q < QG; ++q) {
          const int qt = g + q;
          float mx = -1e30f;
#pragma unroll
          for (int k4 = 0; k4 < NK4; ++k4)
#pragma unroll
            for (int j = 0; j < 4; ++j) { const float v = c.score(t, wid, qt * 16 + l15, 16 * k4 + 4 * quad + j, s[q][k4][j]); s[q][k4][j] = v; mx = fmaxf(mx, v); }
          mx = fmaxf(mx, __shfl_xor(mx, 16)); mx = fmaxf(mx, __shfl_xor(mx, 32));
          const float mnew = fmaxf(mrow[qt], mx);
          const float alpha = __builtin_amdgcn_exp2f(mrow[qt] - mnew);
          mrow[qt] = mnew;
          float psum = 0.f;
#pragma unroll
          for (int k4 = 0; k4 < NK4; ++k4)
#pragma unroll
            for (int j = 0; j < 4; ++j) { const float pv = __builtin_amdgcn_exp2f(s[q][k4][j] - mnew); s[q][k4][j] = pv; psum += pv; }
          lrow[qt] = lrow[qt] * alpha + psum;
#pragma unroll
          for (int dt = 0; dt < NDT; ++dt) o[qt][dt] *= alpha;
#pragma unroll
          for (int kk = 0; kk < NKK; ++kk) {
            u32x4 w;
            w.x = cvtpk(s[q][2 * kk][0], s[q][2 * kk][1]); w.y = cvtpk(s[q][2 * kk][2], s[q][2 * kk][3]);
            w.z = cvtpk(s[q][2 * kk + 1][0], s[q][2 * kk + 1][1]); w.w = cvtpk(s[q][2 * kk + 1][2], s[q][2 * kk + 1][3]);
            pfa[qt][kk] = __builtin_bit_cast(bf16x8, w);
          }
        }
      }
#pragma unroll
      for (int kk = 0; kk < NKK; ++kk) {
        const bf16_t* vb = sV + (32 * kk + 4 * quad + (l15 >> 2)) * LDK + 4 * (l15 & 3);
#pragma unroll
        for (int dt = 0; dt < NDT; ++dt) {
          const s16x4 lo = tr_read(vb + 16 * dt);
          const s16x4 hi = tr_read(vb + 16 * LDK + 16 * dt);
          const bf16x8 vf = (bf16x8){lo[0], lo[1], lo[2], lo[3], hi[0], hi[1], hi[2], hi[3]};
#pragma unroll
          for (int qt = 0; qt < NQT; ++qt) o[qt][dt] = __builtin_amdgcn_mfma_f32_16x16x32_bf16(vf, pfa[qt][kk], o[qt][dt], 0, 0, 0);
        }
      }
    }
  }
#pragma unroll
  for (int qt = 0; qt < NQT; ++qt) {
    float l = lrow[qt];
    l += __shfl_xor(l, 16); l += __shfl_xor(l, 32);
    const float inv = 1.0f / l;
    bf16_t* op = c.optr(wid, qt * 16 + l15) + 4 * quad;
#pragma unroll
    for (int dt = 0; dt < NDT; ++dt) { const f32x4 v = o[qt][dt] * inv; u32x2 w; w.x = cvtpk(v[0], v[1]); w.y = cvtpk(v[2], v[3]); *(u32x2*)(op + 16 * dt) = w; }
    if (quad == 0) c.store_lse(wid, qt * 16 + l15, mrow[qt] + __builtin_amdgcn_logf(l));
  }
}

struct CtxA {
  bf16_t* qbase; const bf16_t* kbase; int nt;
  __device__ __forceinline__ const bf16_t* qptr(int w, int ql) const { return qbase + (size_t)(64 * w + ql) * ZW; }
  __device__ __forceinline__ bf16_t* optr(int w, int ql) const { return qbase + (size_t)(64 * w + ql) * ZW; }
  __device__ __forceinline__ const bf16_t* kptr(int t, int r) const { return kbase + (size_t)(64 * t + r) * ZW; }
  __device__ __forceinline__ const bf16_t* vptr(int t, int r) const { return kbase + (size_t)(64 * t + r) * ZW + 128; }
  __device__ __forceinline__ int ntiles() const { return nt; }
  __device__ __forceinline__ bool active(int, int) const { return true; }
  __device__ __forceinline__ float score(int, int, int, int, float s) const { return s; }
  __device__ __forceinline__ void store_lse(int, int, float) const {}
};
struct CtxB {
  bf16_t* zs; float* lse; int d, r, L, i0, qcol, kcol, vcol; float slope_l2;
  __device__ __forceinline__ const bf16_t* qptr(int w, int ql) const { return zs + (size_t)((i0 + 32 * w + ql) * d + r) * ZW + qcol; }
  __device__ __forceinline__ bf16_t* optr(int w, int ql) const { return zs + (size_t)((i0 + 32 * w + ql) * d + r) * ZW + qcol; }
  __device__ __forceinline__ int kidx(int t, int row) const { int i = i0 - 64 + 64 * t + row; i = i < 0 ? 0 : i; return i > L - 1 ? L - 1 : i; }
  __device__ __forceinline__ const bf16_t* kptr(int t, int row) const { return zs + (size_t)(kidx(t, row) * d + r) * ZW + kcol; }
  __device__ __forceinline__ const bf16_t* vptr(int t, int row) const { return zs + (size_t)(kidx(t, row) * d + r) * ZW + vcol; }
  __device__ __forceinline__ int ntiles() const { return 4; }
  __device__ __forceinline__ bool active(int t, int w) const { return w < 2 ? (t < 3) : (t >= 1); }
  __device__ __forceinline__ float score(int t, int w, int ql, int kl, float s) const {
    const int qi = i0 + 32 * w + ql, ki = i0 - 64 + 64 * t + kl; int rel = ki - qi; rel = rel < 0 ? -rel : rel;
    const bool valid = (rel <= 64) && (ki >= 0) && (ki < L);
    return valid ? s * (0.125f * LOG2E) - slope_l2 * (float)rel : -1e30f;
  }
  __device__ __forceinline__ void store_lse(int w, int ql, float v) const { lse[i0 + 32 * w + ql] = v; }
};
struct CtxC {
  bf16_t* zs; const float* rpb; int R, r0, rb, hc;
  __device__ __forceinline__ const bf16_t* qptr(int w, int ql) const { return zs + (size_t)((r0 + (w >> 1)) * 64 + 32 * (w & 1) + ql) * ZW + hc; }
  __device__ __forceinline__ bf16_t* optr(int w, int ql) const { return zs + (size_t)((r0 + (w >> 1)) * 64 + 32 * (w & 1) + ql) * ZW + hc; }
  __device__ __forceinline__ int krow(int t) const { const int kr = rb + t; return kr > R - 1 ? R - 1 : kr; }
  __device__ __forceinline__ const bf16_t* kptr(int t, int row) const { return zs + (size_t)(krow(t) * 64 + row) * ZW + 1024 + hc; }
  __device__ __forceinline__ const bf16_t* vptr(int t, int row) const { return zs + (size_t)(krow(t) * 64 + row) * ZW + 2048 + hc; }
  __device__ __forceinline__ int ntiles() const { return 9; }
  __device__ __forceinline__ int rstart(int r) const { int rs = r - 4; rs = rs < 0 ? 0 : rs; return rs > R - 8 ? R - 8 : rs; }
  __device__ __forceinline__ bool active(int t, int w) const { const int r = r0 + (w >> 1), rs = rstart(r), kr = rb + t; return kr >= rs && kr < rs + 8; }
  __device__ __forceinline__ float score(int t, int w, int ql, int kl, float s) const {
    const int r = r0 + (w >> 1), cq = 32 * (w & 1) + ql, kr = rb + t;
    int cs = cq - 8; cs = cs < 0 ? 0 : cs; cs = cs > 48 ? 48 : cs;
    const bool valid = (kl >= cs) && (kl < cs + 16);
    const int idx = valid ? (kr - r + 7) * 31 + (kl - cq + 15) : 0;
    const float b = rpb[idx];
    return valid ? (s * 0.125f + b) * LOG2E : -1e30f;
  }
  __device__ __forceinline__ void store_lse(int, int, float) const {}
};
struct CtxX {
  bf16_t* qbase; const bf16_t* kv;
  __device__ __forceinline__ const bf16_t* qptr(int w, int ql) const { return qbase + (size_t)(16 * w + ql) * 1024; }
  __device__ __forceinline__ bf16_t* optr(int w, int ql) const { return qbase + (size_t)(16 * w + ql) * 1024; }
  __device__ __forceinline__ const bf16_t* kptr(int t, int row) const { return kv + (size_t)(32 * t + row) * 2048; }
  __device__ __forceinline__ const bf16_t* vptr(int t, int row) const { return kv + (size_t)(32 * t + row) * 2048 + 1024; }
  __device__ __forceinline__ int ntiles() const { return 8; }
  __device__ __forceinline__ bool active(int, int) const { return true; }
  __device__ __forceinline__ float score(int, int, int, int, float s) const { return s * (0.0625f * LOG2E); }
  __device__ __forceinline__ void store_lse(int, int, float) const {}
};

__device__ __forceinline__ void wt_tile(unsigned char* smem, const float* src, int K, int N, const float* gain, bf16_t* dst, int perm, int t) {
  float* tl = (float*)smem;
  const int nkt = K >> 6; const int rt = t / nkt, kt = t - rt * nkt; const int R0 = rt * 64, k0 = kt * 64;
  const int tid = get_tid(); const int rr = tid & 63;
  const int R = R0 + rr; int sc = R;
  if (perm) { const int T = R >> 8, within = R & 255, wc = within >> 7, n = (within & 127) >> 4, i = within & 15; sc = (n & 1) * DFF + 128 * T + 64 * wc + 16 * (n >> 1) + i; }
  __syncthreads();
#pragma unroll 4
  for (int i = 0; i < 16; ++i) {
    const int kk = (tid >> 6) + 4 * i;
    float v = src[(size_t)(k0 + kk) * N + sc];
    if (gain) v *= gain[k0 + kk];
    tl[kk * 65 + rr] = v;
  }
  __syncthreads();
  const int r2 = tid >> 2, kq = tid & 3;
  u32x4 w0, w1;
  w0.x = cvtpk(tl[(16 * kq + 0) * 65 + r2], tl[(16 * kq + 1) * 65 + r2]); w0.y = cvtpk(tl[(16 * kq + 2) * 65 + r2], tl[(16 * kq + 3) * 65 + r2]);
  w0.z = cvtpk(tl[(16 * kq + 4) * 65 + r2], tl[(16 * kq + 5) * 65 + r2]); w0.w = cvtpk(tl[(16 * kq + 6) * 65 + r2], tl[(16 * kq + 7) * 65 + r2]);
  w1.x = cvtpk(tl[(16 * kq + 8) * 65 + r2], tl[(16 * kq + 9) * 65 + r2]); w1.y = cvtpk(tl[(16 * kq + 10) * 65 + r2], tl[(16 * kq + 11) * 65 + r2]);
  w1.z = cvtpk(tl[(16 * kq + 12) * 65 + r2], tl[(16 * kq + 13) * 65 + r2]); w1.w = cvtpk(tl[(16 * kq + 14) * 65 + r2], tl[(16 * kq + 15) * 65 + r2]);
  bf16_t* dp = dst + ((size_t)((k0 + 16 * kq) >> 5) * N + (R0 + r2)) * 32 + ((16 * kq) & 31);
  *(u32x4*)dp = w0; *(u32x4*)(dp + 8) = w1;
}
__device__ __forceinline__ void wt_matrix(unsigned char* smem, const float* src, int K, int N, const float* gain, bf16_t* dst, int perm) {
  const int ntile = (K >> 6) * (N >> 6);
  for (int t = blockIdx.x; t < ntile; t += gridDim.x) wt_tile(smem, src, K, N, gain, dst, perm, t);
}

__device__ __forceinline__ void tile_seq(int tt, int& seqbase, int& qb, int& S) {
  if (tt < 256) { seqbase = (tt >> 4) * 2048; qb = tt & 15; S = 2048; }
  else { const int u = tt - 256; seqbase = NPROMPT + (u >> 7) * 16384; qb = u & 127; S = 16384; }
}

typedef const __attribute__((address_space(4))) Params* KParams;
__device__ __forceinline__ void run_phase(int ph, KParams kp, unsigned char* smem) {
  unsigned char* ws = kp->ws;
  bf16_t* Z = (bf16_t*)(ws + WS_Z);
  const int tid = get_tid();
  const int L = ph >= 10 ? 1 : 0;
  switch (ph) {
    case 0: {
      wt_matrix(smem, kp->w_in_ab, 1024, 3072, kp->g_mix, (bf16_t*)(ws + WS_WT_IN_AB), 0);
      wt_matrix(smem, kp->w_out_ab, 768, 1024, nullptr, (bf16_t*)(ws + WS_WT_OUT_AB), 0);
      wt_matrix(smem, kp->w_in_c, 1024, 3072, kp->g_mix + 1024, (bf16_t*)(ws + WS_WT_IN_C), 0);
      wt_matrix(smem, kp->w_out_c, 1024, 1024, nullptr, (bf16_t*)(ws + WS_WT_OUT_C), 0);
      for (int l = 0; l < 2; ++l) {
        wt_matrix(smem, kp->wq_x + (size_t)l * 1024 * 1024, 1024, 1024, kp->g_xattn + l * 1024, (bf16_t*)(ws + WS_WT_Q) + (size_t)l * 1024 * 1024, 0);
        wt_matrix(smem, kp->wkv_x + (size_t)l * 1024 * 2048, 1024, 2048, kp->g_mem + l * 1024, (bf16_t*)(ws + WS_WT_KV) + (size_t)l * 2048 * 1024, 0);
        wt_matrix(smem, kp->wo_x + (size_t)l * 1024 * 1024, 1024, 1024, nullptr, (bf16_t*)(ws + WS_WT_O) + (size_t)l * 1024 * 1024, 0);
        wt_matrix(smem, kp->w_gu + (size_t)l * 1024 * 5632, 1024, 5632, kp->g_ffn + l * 1024, (bf16_t*)(ws + WS_WT_GU) + (size_t)l * 5632 * 1024, 1);
        wt_matrix(smem, kp->w_down + (size_t)l * DFF * 1024, DFF, 1024, nullptr, (bf16_t*)(ws + WS_WT_DOWN) + (size_t)l * 1024 * DFF, 0);
      }
      const int gi = blockIdx.x * 256 + tid;
      if (gi < 4096) {
        const int pos = gi >> 4, f = gi & 15;
        const float inv_freq = exp2f(-(float)f * 0.83048202372184058696f);
        const float ang = (float)pos * inv_freq;
        float2 cs; cs.x = cosf(ang); cs.y = sinf(ang);
        ((float2*)(ws + WS_ROPE))[gi] = cs;
      }
    } break;
    case 1: {
      const int n_ab = 512 * 12, n_kv = 36 * 8;
      for (int t = blockIdx.x; t < n_ab + 2 * n_kv; t += gridDim.x) {
        if (t < n_ab) {
          int mt, nt; tile_map(t, 12, gridDim.x, mt, nt);
          EpiInAB e{Z, kp->g_qn, kp->g_kn, (const float2*)(ws + WS_ROPE)};
          gemm_tile<true>(smem, xin_row(kp->x_prompt, kp->x_sample, mt * 128), 1024, (const bf16_t*)(ws + WS_WT_IN_AB), 3072, 1024, e, mt * 128, nt * 256);
        } else {
          int u = t - n_ab; const int l = u / n_kv; u -= l * n_kv; const int mt = u >> 3, nt = u & 7;
          EpiStore<true> e{(bf16_t*)(ws + WS_KVMEM) + (size_t)l * 4608 * 2048, 2048};
          gemm_tile<true>(smem, mem_row(kp->mem_prompt, kp->mem_sample, mt * 128), 1024, (const bf16_t*)(ws + WS_WT_KV) + (size_t)l * 2048 * 1024, 2048, 1024, e, mt * 128, nt * 256);
        }
      }
    } break;
    case 2: {
      for (int it = blockIdx.x; it < 2048 + 6144; it += gridDim.x) {
        if (it < 2048) {
          int seqbase, qi, h, nt;
          if (gridDim.x == 512) {
            const int bid = blockIdx.x, i = it >> 9, xcd = bid & 7, l = (bid >> 3) + 64 * (i & 1);
            if (it < 1024) { const int g = xcd >> 1, id = l * 2 + (xcd & 1); qi = id >> 2; h = (g & 1) * 4 + (id & 3); seqbase = NPROMPT + (g >> 1) * 16384; nt = 256; }
            else { const int grp = xcd + 8 * (l >> 5), id = l & 31; qi = id >> 2; h = (grp & 1) * 4 + (id & 3); seqbase = (grp >> 1) * 2048; nt = 32; }
          } else if (it < 1024) { const int s = it >> 9, rem = it & 511; qi = rem >> 3; h = rem & 7; seqbase = NPROMPT + s * 16384; nt = 256; }
          else { const int a = it - 1024; const int s = a >> 6, rem = a & 63; qi = rem >> 3; h = rem & 7; seqbase = s * 2048; nt = 32; }
          CtxA c{Z + (size_t)(seqbase + 256 * qi) * ZW + h * 64, Z + (size_t)seqbase * ZW + 512 + (h >> 2) * 64, nt};
          attn_item<64, 64, 4, true>(smem, c);
        } else {
          const int b = it - 2048; const int h = b & 3, g = (b >> 2) % 3, tt = b / 12;
          int seqbase, qb, S; tile_seq(tt, seqbase, qb, S);
          const int d = g == 0 ? 1 : (g == 1 ? 4 : 16);
          const int Ls = S / d, nb = Ls >> 7; const int r = qb / nb, mblk = qb - r * nb;
          const float slope = exp2f(-8.0f * (float)(4 * g + h + 1) / 12.0f);
          CtxB c{Z + (size_t)seqbase * ZW, (float*)(ws + WS_LSE) + (size_t)(g * 4 + h) * NTOK + seqbase + r * Ls, d, r, Ls, mblk * 128,
                 768 + ((0 * 3 + g) * 4 + h) * 64, 768 + ((1 * 3 + g) * 4 + h) * 64, 768 + ((2 * 3 + g) * 4 + h) * 64, slope * (float)d * LOG2E};
          attn_item<64, 64, 2, true>(smem, c);
        }
      }
    } break;
    case 3: {
      const float* lse = (const float*)(ws + WS_LSE);
      for (int i = blockIdx.x * 256 + tid; i < NTOK * 32; i += gridDim.x * 256) {
        const int T = i >> 5, h = (i >> 3) & 3, c8 = i & 7;
        int sb, pos, lg;
        if (T < NPROMPT) { sb = T & ~2047; pos = T & 2047; lg = 11; } else { sb = NPROMPT + ((T - NPROMPT) & ~16383); pos = (T - NPROMPT) & 16383; lg = 14; }
        const float l0 = ld_agent_f32(lse + (size_t)(0 * 4 + h) * NTOK + sb + pos);
        const float l1 = ld_agent_f32(lse + (size_t)(1 * 4 + h) * NTOK + sb + ((pos & 3) << (lg - 2)) + (pos >> 2));
        const float l2 = ld_agent_f32(lse + (size_t)(2 * 4 + h) * NTOK + sb + ((pos & 15) << (lg - 4)) + (pos >> 4));
        const float mx = fmaxf(l0, fmaxf(l1, l2));
        float w0 = __builtin_amdgcn_exp2f(l0 - mx), w1 = __builtin_amdgcn_exp2f(l1 - mx), w2 = __builtin_amdgcn_exp2f(l2 - mx);
        const float inv = 1.0f / (w0 + w1 + w2); w0 *= inv; w1 *= inv; w2 *= inv;
        const bf16_t* zr = Z + (size_t)T * ZW;
        const u32x4 a = ld_agent_u32x4(zr + 768 + (0 * 4 + h) * 64 + c8 * 8), b = ld_agent_u32x4(zr + 768 + (1 * 4 + h) * 64 + c8 * 8), cc = ld_agent_u32x4(zr + 768 + (2 * 4 + h) * 64 + c8 * 8);
        u32x4 o;
#pragma unroll
        for (int k = 0; k < 4; ++k) {
          const float lo = w0 * bf2f((unsigned short)(a[k] & 0xffff)) + w1 * bf2f((unsigned short)(b[k] & 0xffff)) + w2 * bf2f((unsigned short)(cc[k] & 0xffff));
          const float hi = w0 * bf2f((unsigned short)(a[k] >> 16)) + w1 * bf2f((unsigned short)(b[k] >> 16)) + w2 * bf2f((unsigned short)(cc[k] >> 16));
          o[k] = cvtpk(lo, hi);
        }
        *(u32x4*)(Z + (size_t)T * ZW + 512 + h * 64 + c8 * 8) = o;
      }
    } break;
    case 4: case 7: case 9: case 12: case 15: case 17: {
      const bf16_t* A; int lda, K; const bf16_t* Bt;
      if (ph == 4) { A = Z; lda = ZW; K = 768; Bt = (const bf16_t*)(ws + WS_WT_OUT_AB); }
      else if (ph == 12) { A = Z; lda = ZW; K = 1024; Bt = (const bf16_t*)(ws + WS_WT_OUT_C); }
      else if (ph == 7 || ph == 15) { A = Z; lda = 1024; K = 1024; Bt = (const bf16_t*)(ws + WS_WT_O) + (size_t)L * 1024 * 1024; }
      else { A = Z; lda = DFF; K = DFF; Bt = (const bf16_t*)(ws + WS_WT_DOWN) + (size_t)L * 1024 * DFF; }
      for (int t = blockIdx.x; t < 512 * 4; t += gridDim.x) {
        int mt, nt; tile_map(t, 4, gridDim.x, mt, nt);
        EpiResid e{ph == 4 ? xin_row(kp->x_prompt, kp->x_sample, mt * 128) : kp->out + (size_t)mt * 128 * 1024, kp->out};
        gemm_tile<false>(smem, A + (size_t)mt * 128 * lda, lda, Bt, 1024, K, e, mt * 128, nt * 256);
      }
    } break;
    case 5: case 10: case 13: {
      const bf16_t* Bt; int NT, ldc;
      if (ph == 10) { Bt = (const bf16_t*)(ws + WS_WT_IN_C); NT = 12; ldc = ZW; }
      else { Bt = (const bf16_t*)(ws + WS_WT_Q) + (size_t)L * 1024 * 1024; NT = 4; ldc = 1024; }
      for (int t = blockIdx.x; t < 512 * NT; t += gridDim.x) {
        int mt, nt; tile_map(t, NT, gridDim.x, mt, nt);
        EpiStore<true> e{Z, ldc};
        gemm_tile<true>(smem, kp->out + (size_t)mt * 128 * 1024, 1024, Bt, NT * 256, 1024, e, mt * 128, nt * 256);
      }
    } break;
    case 6: case 14: {
      const bf16_t* kvm = (const bf16_t*)(ws + WS_KVMEM) + (size_t)L * 4608 * 2048;
      for (int it = blockIdx.x; it < 4096; it += gridDim.x) {
        int idx = it; if (gridDim.x == 512) idx = (blockIdx.x & 7) * 512 + (blockIdx.x >> 3) + 64 * (it >> 9);
        const int h = idx & 3, tile = idx >> 2, T0 = tile * 64;
        const int bidx = T0 < NPROMPT ? (T0 >> 11) : 16 + ((T0 - NPROMPT) >> 14);
        CtxX c{Z + (size_t)T0 * 1024 + h * 256, kvm + (size_t)bidx * 256 * 2048 + h * 256};
        attn_item<256, 32, 1, false>(smem, c);
      }
    } break;
    case 8: case 16: {
      const bf16_t* Bt = (const bf16_t*)(ws + WS_WT_GU) + (size_t)L * 5632 * 1024;
      for (int t = blockIdx.x; t < 512 * 22; t += gridDim.x) {
        int mt, nt; tile_map(t, 22, gridDim.x, mt, nt);
        EpiSwiGLU e{Z};
        gemm_tile<true>(smem, kp->out + (size_t)mt * 128 * 1024, 1024, Bt, 5632, 1024, e, mt * 128, nt * 256);
      }
    } break;
    case 11: {
      float* srpb = (float*)(smem + 2 * 64 * 72 * 2);
      for (int it = blockIdx.x; it < 8192; it += gridDim.x) {
        int h = it & 15, tt = it >> 4;
        if (gridDim.x == 512) { const int l = (blockIdx.x >> 3) + 64 * (it >> 9); h = 2 * (blockIdx.x & 7) + (l & 1); tt = l >> 1; }
        int seqbase, rp, S; tile_seq(tt, seqbase, rp, S);
        const int R = S >> 6, r0 = 2 * rp;
        int rb = r0 - 4; rb = rb < 0 ? 0 : rb; rb = rb > R - 8 ? R - 8 : rb;
        __syncthreads();
        for (int i = tid; i < 15 * 31; i += 256) srpb[i] = kp->rpb_c[h * 15 * 31 + i];
        CtxC c{Z + (size_t)seqbase * ZW, srpb, R, r0, rb, h * 64};
        attn_item<64, 64, 2, true>(smem, c);
      }
    } break;
    case 18: {
      const int lane = tid & 63, wv = blockIdx.x * 4 + (tid >> 6), nwv = gridDim.x * 4;
      for (int row = wv; row < NTOK; row += nwv) {
        float* xr = kp->out + (size_t)row * 1024;
        f32x4 v[4]; float s = 0.f;
#pragma unroll
        for (int i = 0; i < 4; ++i) { v[i] = ld_agent_f32x4(xr + i * 256 + lane * 4); s += v[i][0] * v[i][0] + v[i][1] * v[i][1] + v[i][2] * v[i][2] + v[i][3] * v[i][3]; }
        s += __shfl_xor(s, 1); s += __shfl_xor(s, 2); s += __shfl_xor(s, 4); s += __shfl_xor(s, 8); s += __shfl_xor(s, 16); s += __shfl_xor(s, 32);
        const float r = rsqrtf(s * (1.0f / 1024.0f) + EPS);
#pragma unroll
        for (int i = 0; i < 4; ++i) { const f32x4 g = *(const f32x4*)(kp->g_final + i * 256 + lane * 4); *(f32x4*)(xr + i * 256 + lane * 4) = v[i] * r * g; }
      }
    } break;
    default: break;
  }
}

constexpr int NPHASE = 19;

template <bool COOP>
__global__ void __launch_bounds__(256, 2) mega(Params p) {
  __shared__ __attribute__((aligned(16))) unsigned char smem[SMEM_BYTES];
  if constexpr (COOP) {
    cg::grid_group grid = cg::this_grid();
#define STEP(PH) { KParams kp = (KParams)__builtin_amdgcn_kernarg_segment_ptr(); asm volatile("" : "+s"(kp)); run_phase(PH, kp, smem); if (PH + 1 < NPHASE) grid.sync(); }
    STEP(0) STEP(1) STEP(2) STEP(3) STEP(4) STEP(5) STEP(6) STEP(7) STEP(8) STEP(9)
    STEP(10) STEP(11) STEP(12) STEP(13) STEP(14) STEP(15) STEP(16) STEP(17) STEP(18)
#undef STEP
  } else {
    for (int ph = p.phase_lo; ph < p.phase_hi; ++ph) {
      KParams kp = (KParams)__builtin_amdgcn_kernarg_segment_ptr();
      asm volatile("" : "+s"(kp));
      run_phase(ph, kp, smem);
    }
  }
}

extern "C" void kernel_launch(void* const* d_in, const int* in_sizes, int n_in, void* d_out, int out_size, void* d_ws, size_t ws_size, hipStream_t stream) {
  static int grid = 0;
  if (grid == 0) {
    if (n_in != 21 || ws_size < WS_END) { fprintf(stderr, "kernel_launch: n_in %d ws %zu (need %zu)\n", n_in, ws_size, (size_t)WS_END); grid = -1; return; }
    int dev = 0, cus = 0, per_cu = 0;
    hipGetDevice(&dev);
    hipDeviceGetAttribute(&cus, hipDeviceAttributeMultiprocessorCount, dev);
#if MULTI_LAUNCH
    hipOccupancyMaxActiveBlocksPerMultiprocessor(&per_cu, (const void*)mega<false>, 256, 0);
#else
    hipOccupancyMaxActiveBlocksPerMultiprocessor(&per_cu, (const void*)mega<true>, 256, 0);
#endif
    if (per_cu < 1) per_cu = 1;
    if (per_cu > 2) per_cu = 2;
    grid = cus * per_cu;
  }
  if (grid < 0) return;
  Params p{};
  p.x_prompt = (const float*)d_in[0]; p.x_sample = (const float*)d_in[1]; p.mem_prompt = (const float*)d_in[2]; p.mem_sample = (const float*)d_in[3];
  p.g_mix = (const float*)d_in[4]; p.w_in_ab = (const float*)d_in[5]; p.g_qn = (const float*)d_in[6]; p.g_kn = (const float*)d_in[7]; p.w_out_ab = (const float*)d_in[8];
  p.w_in_c = (const float*)d_in[9]; p.rpb_c = (const float*)d_in[10]; p.w_out_c = (const float*)d_in[11]; p.g_xattn = (const float*)d_in[12]; p.g_mem = (const float*)d_in[13];
  p.wq_x = (const float*)d_in[14]; p.wkv_x = (const float*)d_in[15]; p.wo_x = (const float*)d_in[16]; p.g_ffn = (const float*)d_in[17]; p.w_gu = (const float*)d_in[18]; p.w_down = (const float*)d_in[19];
  p.g_final = (const float*)d_in[20];
  p.out = (float*)d_out; p.ws = (unsigned char*)d_ws;
#if MULTI_LAUNCH
  for (int ph = 0; ph < NPHASE; ++ph) {
    p.phase_lo = ph; p.phase_hi = ph + 1;
    hipLaunchKernelGGL(mega<false>, dim3(grid), dim3(256), 0, stream, p);
  }
#else
  p.phase_lo = 0; p.phase_hi = NPHASE;
  void* args[] = {&p};
  hipError_t e = hipLaunchCooperativeKernel((const void*)mega<true>, dim3(grid), dim3(256), args, 0, stream);
  if (e != hipSuccess) fprintf(stderr, "cooperative launch failed: %s (grid %d)\n", hipGetErrorString(e), grid);
#endif
}
#ifdef DBG_RES
template <int PH> __global__ void __launch_bounds__(256, 2) mega_one(Params p) {
  __shared__ __attribute__((aligned(16))) unsigned char smem[SMEM_BYTES];
  run_phase(PH, (KParams)__builtin_amdgcn_kernarg_segment_ptr(), smem);
}
template __global__ void mega_one<0>(Params); template __global__ void mega_one<1>(Params); template __global__ void mega_one<2>(Params);
template __global__ void mega_one<3>(Params); template __global__ void mega_one<4>(Params); template __global__ void mega_one<5>(Params);
template __global__ void mega_one<6>(Params); template __global__ void mega_one<8>(Params); template __global__ void mega_one<11>(Params);
template __global__ void mega_one<18>(Params);
#endif
```

```cpp
#include <hip/hip_runtime.h>
#include <hip/hip_cooperative_groups.h>
#include <cstdint>
#include <cstdio>
namespace cg = cooperative_groups;

#ifndef MULTI_LAUNCH
#define MULTI_LAUNCH 0
#endif

typedef unsigned short bf16_t;
typedef short bf16x8 __attribute__((ext_vector_type(8)));
typedef short s16x4 __attribute__((ext_vector_type(4)));
typedef short v4i16_t __attribute__((ext_vector_type(4)));
typedef float f32x4 __attribute__((ext_vector_type(4)));
typedef float f32x2_t __attribute__((ext_vector_type(2)));
typedef __bf16 bf16x2_t __attribute__((ext_vector_type(2)));
typedef unsigned u32x4 __attribute__((ext_vector_type(4)));
typedef unsigned u32x2 __attribute__((ext_vector_type(2)));

#define LOG2E 1.4426950408889634f
constexpr int NTOK = 65536;
constexpr int NPROMPT = 32768;
constexpr int ZW = 3072;
constexpr int DFF = 2816;
constexpr float EPS = 1e-6f;

constexpr size_t WS_WT_IN_AB = 0;
constexpr size_t WS_WT_OUT_AB = WS_WT_IN_AB + (size_t)3072 * 1024 * 2;
constexpr size_t WS_WT_IN_C = WS_WT_OUT_AB + (size_t)1024 * 768 * 2;
constexpr size_t WS_WT_OUT_C = WS_WT_IN_C + (size_t)3072 * 1024 * 2;
constexpr size_t WS_WT_Q = WS_WT_OUT_C + (size_t)1024 * 1024 * 2;
constexpr size_t WS_WT_KV = WS_WT_Q + (size_t)2 * 1024 * 1024 * 2;
constexpr size_t WS_WT_O = WS_WT_KV + (size_t)2 * 2048 * 1024 * 2;
constexpr size_t WS_WT_GU = WS_WT_O + (size_t)2 * 1024 * 1024 * 2;
constexpr size_t WS_WT_DOWN = WS_WT_GU + (size_t)2 * 5632 * 1024 * 2;
constexpr size_t WS_KVMEM = WS_WT_DOWN + (size_t)2 * 1024 * 2816 * 2;
constexpr size_t WS_LSE = WS_KVMEM + (size_t)2 * 4608 * 2048 * 2;
constexpr size_t WS_ROPE = WS_LSE + (size_t)3 * 65536 * 4 * 4;
constexpr size_t WS_Z = WS_ROPE + (size_t)256 * 16 * 8;
constexpr size_t WS_END = WS_Z + (size_t)NTOK * ZW * 2;

constexpr int SMEM_BYTES = 2 * (128 + 256) * 40 * 2 + 512;

struct Params {
  const float* x_prompt; const float* x_sample; const float* mem_prompt; const float* mem_sample;
  const float* g_mix; const float* w_in_ab; const float* g_qn; const float* g_kn; const float* w_out_ab;
  const float* w_in_c; const float* rpb_c; const float* w_out_c; const float* g_xattn; const float* g_mem;
  const float* wq_x; const float* wkv_x; const float* wo_x; const float* g_ffn; const float* w_gu; const float* w_down;
  const float* g_final;
  float* out; unsigned char* ws;
  int phase_lo, phase_hi;
};

__device__ __forceinline__ int get_tid() { int t = threadIdx.x; asm volatile("" : "+v"(t)); return t; }
__device__ __forceinline__ unsigned cvtpk(float lo, float hi) { f32x2_t v = {lo, hi}; bf16x2_t b = __builtin_convertvector(v, bf16x2_t); return __builtin_bit_cast(unsigned, b); }
__device__ __forceinline__ float bf2f(unsigned short h) { return __uint_as_float(((unsigned)h) << 16); }
__device__ __forceinline__ s16x4 tr_read(const bf16_t* p) {
  return __builtin_bit_cast(s16x4, __builtin_amdgcn_ds_read_tr16_b64_v4i16((__attribute__((address_space(3))) v4i16_t*)p));
}
__device__ __forceinline__ const float* xin_row(const float* xp, const float* xs, int row) {
  return row < NPROMPT ? xp + (size_t)row * 1024 : xs + (size_t)(row - NPROMPT) * 1024;
}
__device__ __forceinline__ const float* mem_row(const float* mp, const float* ms, int row) {
  return row < 4096 ? mp + (size_t)row * 1024 : ms + (size_t)(row - 4096) * 1024;
}


__device__ __forceinline__ void ld16_sc1(u32x4& v, const void* p) { asm volatile("global_load_dwordx4 %0, %1, off sc1" : "=v"(v) : "v"(p) : "memory"); }
__device__ __forceinline__ void ld16_sc1(f32x4& v, const float* p) { asm volatile("global_load_dwordx4 %0, %1, off sc1" : "=v"(v) : "v"(p) : "memory"); }
__device__ __forceinline__ u32x4 ld_agent_u32x4(const void* p) {
  const unsigned long long a = __hip_atomic_load((const unsigned long long*)p, __ATOMIC_RELAXED, __HIP_MEMORY_SCOPE_AGENT);
  const unsigned long long b = __hip_atomic_load((const unsigned long long*)p + 1, __ATOMIC_RELAXED, __HIP_MEMORY_SCOPE_AGENT);
  return (u32x4){(unsigned)a, (unsigned)(a >> 32), (unsigned)b, (unsigned)(b >> 32)};
}
__device__ __forceinline__ float ld_agent_f32(const float* p) { return __uint_as_float(__hip_atomic_load((const unsigned*)p, __ATOMIC_RELAXED, __HIP_MEMORY_SCOPE_AGENT)); }
__device__ __forceinline__ f32x4 ld_agent_f32x4(const float* p) {
  const unsigned long long a = __hip_atomic_load((const unsigned long long*)p, __ATOMIC_RELAXED, __HIP_MEMORY_SCOPE_AGENT);
  const unsigned long long b = __hip_atomic_load((const unsigned long long*)p + 1, __ATOMIC_RELAXED, __HIP_MEMORY_SCOPE_AGENT);
  f32x4 v; v[0] = __uint_as_float((unsigned)a); v[1] = __uint_as_float((unsigned)(a >> 32)); v[2] = __uint_as_float((unsigned)b); v[3] = __uint_as_float((unsigned)(b >> 32)); return v;
}
__device__ __forceinline__ void tile_map(int t, int NT, int gdim, int& mt, int& nt) {
  if ((gdim & 7) == 0) { const int i = t / gdim, b = t - i * gdim; const int lt = (b >> 3) + (gdim >> 3) * i; const int ml = lt / NT; nt = lt - ml * NT; mt = (b & 7) + 8 * ml; }
  else { mt = t / NT; nt = t - mt * NT; }
}
constexpr int GLD = 40;
constexpr int G_STAGE = (128 + 256) * GLD;
template <bool AF32, class Epi>
__device__ __forceinline__ void gemm_tile(unsigned char* smem, const void* Ap, int lda, const bf16_t* WT, int N, int K, const Epi& epi, int m0, int n0) {
  const int tid = get_tid(), lane = tid & 63;
  const int wid = __builtin_amdgcn_readfirstlane(tid >> 6);
  const int wr = wid >> 1, wc = wid & 1, l15 = lane & 15, quad = lane >> 4;
  bf16_t* sbase = (bf16_t*)smem; float* sR = (float*)(smem + 2 * G_STAGE * 2);
  f32x4 acc[4][8];
#pragma unroll
  for (int m = 0; m < 4; ++m)
#pragma unroll
    for (int n = 0; n < 8; ++n) acc[m][n] = (f32x4){0.f, 0.f, 0.f, 0.f};
  float ss[4];
#pragma unroll
  for (int i = 0; i < 4; ++i) ss[i] = 0.f;
  f32x4 ra[4]; u32x4 rab[2]; u32x4 rb[4];
  const int nk = K >> 5;
  const float* Af = (const float*)Ap + (size_t)(tid >> 3) * lda + (tid & 7) * 4;
  const bf16_t* Ab = (const bf16_t*)Ap + (size_t)(tid >> 2) * lda + (tid & 3) * 8;
  const bf16_t* Bp = WT + (size_t)n0 * 32 + tid * 8;
  const size_t bstep = (size_t)N * 32;
  const int awf = (tid >> 3) * GLD + (tid & 7) * 4;
  const int awb = (tid >> 2) * GLD + (tid & 3) * 8;
#define G_LOAD(kt_) do { \
    if constexpr (AF32) { _Pragma("unroll") for (int i = 0; i < 4; ++i) ld16_sc1(ra[i], Af + (size_t)i * 32 * lda + (kt_) * 32); } \
    else { _Pragma("unroll") for (int i = 0; i < 2; ++i) ld16_sc1(rab[i], Ab + (size_t)i * 64 * lda + (kt_) * 32); } \
    _Pragma("unroll") for (int i = 0; i < 4; ++i) ld16_sc1(rb[i], Bp + (size_t)(kt_) * bstep + i * 2048); } while (0)
#define G_STORE(st_) do { bf16_t* sa_ = sbase + (st_) * G_STAGE; bf16_t* sb_ = sa_ + 128 * GLD; \
    if constexpr (AF32) { asm volatile("s_waitcnt vmcnt(0)" : "+v"(ra[0]), "+v"(ra[1]), "+v"(ra[2]), "+v"(ra[3]), "+v"(rb[0]), "+v"(rb[1]), "+v"(rb[2]), "+v"(rb[3]) :: "memory"); \
      _Pragma("unroll") for (int i = 0; i < 4; ++i) { const f32x4 v = ra[i]; \
        ss[i] += v[0] * v[0] + v[1] * v[1] + v[2] * v[2] + v[3] * v[3]; \
        u32x2 w; w.x = cvtpk(v[0], v[1]); w.y = cvtpk(v[2], v[3]); *(u32x2*)(sa_ + awf + i * 32 * GLD) = w; } } \
    else { asm volatile("s_waitcnt vmcnt(0)" : "+v"(rab[0]), "+v"(rab[1]), "+v"(rb[0]), "+v"(rb[1]), "+v"(rb[2]), "+v"(rb[3]) :: "memory"); \
      _Pragma("unroll") for (int i = 0; i < 2; ++i) *(u32x4*)(sa_ + awb + i * 64 * GLD) = rab[i]; } \
    _Pragma("unroll") for (int i = 0; i < 4; ++i) *(u32x4*)(sb_ + awb + i * 64 * GLD) = rb[i]; } while (0)
  G_LOAD(0);
  G_STORE(0);
  if (nk > 1) G_LOAD(1);
  __syncthreads();
  for (int kt = 0; kt < nk; ++kt) {
    const int cur = kt & 1;
    if (kt + 1 < nk) G_STORE(cur ^ 1);
    if (kt + 2 < nk) G_LOAD(kt + 2);
    const bf16_t* a_s = sbase + cur * G_STAGE + (wr * 64 + l15) * GLD + quad * 8;
    const bf16_t* b_s = sbase + cur * G_STAGE + 128 * GLD + (wc * 128 + l15) * GLD + quad * 8;
    __builtin_amdgcn_s_setprio(1);
    bf16x8 af[4];
#pragma unroll
    for (int m = 0; m < 4; ++m) af[m] = *(const bf16x8*)(a_s + m * 16 * GLD);
#pragma unroll
    for (int nh = 0; nh < 4; ++nh) {
      bf16x8 bfr[2];
#pragma unroll
      for (int n2 = 0; n2 < 2; ++n2) bfr[n2] = *(const bf16x8*)(b_s + (nh * 2 + n2) * 16 * GLD);
#pragma unroll
      for (int m = 0; m < 4; ++m)
#pragma unroll
        for (int n2 = 0; n2 < 2; ++n2) acc[m][nh * 2 + n2] = __builtin_amdgcn_mfma_f32_16x16x32_bf16(bfr[n2], af[m], acc[m][nh * 2 + n2], 0, 0, 0);
    }
    __builtin_amdgcn_s_setprio(0);
    __syncthreads();
  }
#undef G_LOAD
#undef G_STORE
  if constexpr (AF32) {
    const float invK = 1.0f / (float)K;
#pragma unroll
    for (int i = 0; i < 4; ++i) {
      float s = ss[i];
      s += __shfl_xor(s, 1); s += __shfl_xor(s, 2); s += __shfl_xor(s, 4);
      if ((tid & 7) == 0) sR[(tid >> 3) + 32 * i] = rsqrtf(s * invK + EPS);
    }
    __syncthreads();
  }
  epi(acc, m0, wr * 64, n0 + wc * 128, l15, quad, sR);
}

template <bool RS> struct EpiStore {
  bf16_t* C; int ldc;
  __device__ __forceinline__ void operator()(f32x4 (&acc)[4][8], int m0, int rl0, int cb, int l15, int quad, const float* sR) const {
#pragma unroll
    for (int m = 0; m < 4; ++m) {
      const int rl = rl0 + 16 * m + l15; const float rs = RS ? sR[rl] : 1.f;
      bf16_t* rp = C + (size_t)(m0 + rl) * ldc + cb + 4 * quad;
#pragma unroll
      for (int n = 0; n < 8; ++n) { const f32x4 v = acc[m][n] * rs; u32x2 w; w.x = cvtpk(v[0], v[1]); w.y = cvtpk(v[2], v[3]); *(u32x2*)(rp + 16 * n) = w; }
    }
  }
};
struct EpiInAB {
  bf16_t* Z; const float* gq; const float* gk; const float2* rope;
  __device__ __forceinline__ void operator()(f32x4 (&acc)[4][8], int m0, int rl0, int cb0, int l15, int quad, const float* sR) const {
#pragma unroll
    for (int hh = 0; hh < 2; ++hh) {
      const int cb = cb0 + 64 * hh;
      if (cb >= 640) {
#pragma unroll
        for (int m = 0; m < 4; ++m) {
          const int rl = rl0 + 16 * m + l15; const float rs = sR[rl];
          bf16_t* rp = Z + (size_t)(m0 + rl) * ZW + cb + 4 * quad;
#pragma unroll
          for (int n = 0; n < 4; ++n) { const f32x4 v = acc[m][4 * hh + n] * rs; u32x2 w; w.x = cvtpk(v[0], v[1]); w.y = cvtpk(v[2], v[3]); *(u32x2*)(rp + 16 * n) = w; }
        }
      } else {
        const float* g = cb < 512 ? gq : gk;
        const float qs = cb < 512 ? 0.125f * LOG2E : 1.0f;
        f32x4 gv[4];
#pragma unroll
        for (int n = 0; n < 4; ++n) gv[n] = *(const f32x4*)(g + 16 * n + 4 * quad) * qs;
#pragma unroll
        for (int m = 0; m < 4; ++m) {
          const int rl = rl0 + 16 * m + l15; const int row = m0 + rl; const float rs = sR[rl];
          f32x4 z[4]; float s2 = 0.f;
#pragma unroll
          for (int n = 0; n < 4; ++n) { z[n] = acc[m][4 * hh + n] * rs; s2 += z[n][0] * z[n][0] + z[n][1] * z[n][1] + z[n][2] * z[n][2] + z[n][3] * z[n][3]; }
          s2 += __shfl_xor(s2, 16); s2 += __shfl_xor(s2, 32);
          const float r = rsqrtf(s2 * (1.0f / 64.0f) + EPS);
          const int pos = row < NPROMPT ? (row & 2047) : (row & 16383);
          const int gr = pos >> 6, gc = pos & 63;
          bf16_t* rp = Z + (size_t)row * ZW + cb + 4 * quad;
#pragma unroll
          for (int n = 0; n < 4; ++n) {
            const int ap = (n < 2) ? gr : gc;
            const f32x4 zn = z[n] * r * gv[n];
            float2 c0, c1; { const unsigned long long w0 = __hip_atomic_load((const unsigned long long*)(rope + ap * 16 + ((8 * n + 2 * quad) & 15)), __ATOMIC_RELAXED, __HIP_MEMORY_SCOPE_AGENT), w1 = __hip_atomic_load((const unsigned long long*)(rope + ap * 16 + ((8 * n + 2 * quad + 1) & 15)), __ATOMIC_RELAXED, __HIP_MEMORY_SCOPE_AGENT); c0.x = __uint_as_float((unsigned)w0); c0.y = __uint_as_float((unsigned)(w0 >> 32)); c1.x = __uint_as_float((unsigned)w1); c1.y = __uint_as_float((unsigned)(w1 >> 32)); }
            const float o0 = zn[0] * c0.x - zn[1] * c0.y, o1 = zn[0] * c0.y + zn[1] * c0.x;
            const float o2 = zn[2] * c1.x - zn[3] * c1.y, o3 = zn[2] * c1.y + zn[3] * c1.x;
            u32x2 w; w.x = cvtpk(o0, o1); w.y = cvtpk(o2, o3); *(u32x2*)(rp + 16 * n) = w;
          }
        }
      }
    }
  }
};
struct EpiResid {
  const float* src_tile; float* dst;
  __device__ __forceinline__ void operator()(f32x4 (&acc)[4][8], int m0, int rl0, int cb, int l15, int quad, const float* sR) const {
#pragma unroll
    for (int m = 0; m < 4; ++m) {
      const int rl = rl0 + 16 * m + l15;
      const float* sp = src_tile + (size_t)rl * 1024 + cb + 4 * quad; float* dp = dst + (size_t)(m0 + rl) * 1024 + cb + 4 * quad;
#pragma unroll
      for (int n = 0; n < 8; ++n) { const f32x4 x = ld_agent_f32x4(sp + 16 * n); *(f32x4*)(dp + 16 * n) = x + acc[m][n]; }
    }
  }
};
struct EpiSwiGLU {
  bf16_t* H;
  __device__ __forceinline__ void operator()(f32x4 (&acc)[4][8], int m0, int rl0, int cb, int l15, int quad, const float* sR) const {
    const int hc0 = (cb >> 8) * 128 + ((cb >> 7) & 1) * 64 + 4 * quad;
#pragma unroll
    for (int m = 0; m < 4; ++m) {
      const int rl = rl0 + 16 * m + l15; const float rs = sR[rl];
      bf16_t* rp = H + (size_t)(m0 + rl) * DFF + hc0;
#pragma unroll
      for (int pp = 0; pp < 4; ++pp) {
        const f32x4 g = acc[m][2 * pp] * rs, u = acc[m][2 * pp + 1] * rs; float h[4];
#pragma unroll
        for (int j = 0; j < 4; ++j) h[j] = g[j] / (1.0f + __expf(-g[j])) * u[j];
        u32x2 w; w.x = cvtpk(h[0], h[1]); w.y = cvtpk(h[2], h[3]); *(u32x2*)(rp + 16 * pp) = w;
      }
    }
  }
};

template <int DH, int KT, int NQT, bool PF, class Ctx>
__device__ __forceinline__ void attn_item(unsigned char* smem, const Ctx& c) {
  constexpr int LDK = DH + 8, CH = DH / 8, NCH = KT * CH / 256, NKS = DH / 32, NK4 = KT / 16, NKK = KT / 32, NDT = DH / 16;
  bf16_t* sK = (bf16_t*)smem; bf16_t* sV = sK + KT * LDK;
  const int tid = get_tid(), lane = tid & 63;
  const int wid = __builtin_amdgcn_readfirstlane(tid >> 6);
  const int l15 = lane & 15, quad = lane >> 4;
  bf16x8 qf[NQT][NKS];
#pragma unroll
  for (int qt = 0; qt < NQT; ++qt) {
    const bf16_t* qp = c.qptr(wid, qt * 16 + l15);
#pragma unroll
    for (int ks = 0; ks < NKS; ++ks) qf[qt][ks] = __builtin_bit_cast(bf16x8, ld_agent_u32x4(qp + ks * 32 + quad * 8));
  }
  f32x4 o[NQT][NDT];
  float mrow[NQT], lrow[NQT];
#pragma unroll
  for (int qt = 0; qt < NQT; ++qt) {
    mrow[qt] = -1e30f; lrow[qt] = 0.f;
#pragma unroll
    for (int dt = 0; dt < NDT; ++dt) o[qt][dt] = (f32x4){0.f, 0.f, 0.f, 0.f};
  }
  const int nt = c.ntiles();
  u32x4 rk[NCH], rv[NCH];
  if constexpr (PF) {
#pragma unroll
    for (int i = 0; i < NCH; ++i) {
      const int ci = tid + 256 * i, row = ci / CH, ch = ci % CH;
      ld16_sc1(rk[i], c.kptr(0, row) + ch * 8); ld16_sc1(rv[i], c.vptr(0, row) + ch * 8);
    }
  }
  for (int t = 0; t < nt; ++t) {
    __syncthreads();
    if constexpr (PF) {
      static_assert(!PF || NCH == 2 || NCH == 4, "wait lists below are written for two or four chunks per matrix");
      if constexpr (NCH == 2) asm volatile("s_waitcnt vmcnt(0)" : "+v"(rk[0]), "+v"(rk[NCH - 1]), "+v"(rv[0]), "+v"(rv[NCH - 1]) :: "memory");
      else asm volatile("s_waitcnt vmcnt(0)" : "+v"(rk[0]), "+v"(rk[1]), "+v"(rk[NCH - 2]), "+v"(rk[NCH - 1]), "+v"(rv[0]), "+v"(rv[1]), "+v"(rv[NCH - 2]), "+v"(rv[NCH - 1]) :: "memory");
#pragma unroll
      for (int i = 0; i < NCH; ++i) {
        const int ci = tid + 256 * i, row = ci / CH, ch = ci % CH;
        *(u32x4*)(sK + row * LDK + ch * 8) = rk[i]; *(u32x4*)(sV + row * LDK + ch * 8) = rv[i];
      }
    } else {
#pragma unroll
      for (int i = 0; i < NCH; ++i) {
        const int ci = tid + 256 * i, row = ci / CH, ch = ci % CH;
        *(u32x4*)(sK + row * LDK + ch * 8) = ld_agent_u32x4(c.kptr(t, row) + ch * 8);
      }
#pragma unroll
      for (int i = 0; i < NCH; ++i) {
        const int ci = tid + 256 * i, row = ci / CH, ch = ci % CH;
        *(u32x4*)(sV + row * LDK + ch * 8) = ld_agent_u32x4(c.vptr(t, row) + ch * 8);
      }
    }
    __syncthreads();
    if constexpr (PF) {
      if (t + 1 < nt) {
#pragma unroll
        for (int i = 0; i < NCH; ++i) {
          const int ci = tid + 256 * i, row = ci / CH, ch = ci % CH;
          ld16_sc1(rk[i], c.kptr(t + 1, row) + ch * 8); ld16_sc1(rv[i], c.vptr(t + 1, row) + ch * 8);
        }
      }
    }
    if (c.active(t, wid)) {
      constexpr int QG = NQT < 2 ? NQT : 2;
      bf16x8 pfa[NQT][NKK];
#pragma unroll
      for (int g = 0; g < NQT; g += QG) {
        f32x4 s[QG][NK4];
#pragma unroll
        for (int q = 0; q < QG; ++q)
#pragma unroll
          for (int k4 = 0; k4 < NK4; ++k4) s[q][k4] = (f32x4){0.f, 0.f, 0.f, 0.f};
#pragma unroll
        for (int k4 = 0; k4 < NK4; ++k4)
#pragma unroll
          for (int ks = 0; ks < NKS; ++ks) {
            const bf16x8 kf = *(const bf16x8*)(sK + (16 * k4 + l15) * LDK + ks * 32 + quad * 8);
#pragma unroll
            for (int q = 0; q < QG; ++q) s[q][k4] = __builtin_amdgcn_mfma_f32_16x16x32_bf16(kf, qf[g + q][ks], s[q][k4], 0, 0, 0);
          }
#pragma unroll
        for (int q = 0; q < QG; ++q) {
          const int qt = g + q;
          float mx = -1e30f;
#pragma unroll
          for (int k4 = 0; k4 < NK4; ++k4)
#pragma unroll
            for (int j = 0; j < 4; ++j) { const float v = c.score(t, wid, qt * 16 + l15, 16 * k4 + 4 * quad + j, s[q][k4][j]); s[q][k4][j] = v; mx = fmaxf(mx, v); }
          mx = fmaxf(mx, __shfl_xor(mx, 16)); mx = fmaxf(mx, __shfl_xor(mx, 32));
          const float mnew = fmaxf(mrow[qt], mx);
          const float alpha = __builtin_amdgcn_exp2f(mrow[qt] - mnew);
          mrow[qt] = mnew;
          float psum = 0.f;
#pragma unroll
          for (int k4 = 0; k4 < NK4; ++k4)
#pragma unroll
            for (int j = 0; j < 4; ++j) { const float pv = __builtin_amdgcn_exp2f(s[q][k4][j] - mnew); s[q][k4][j] = pv; psum += pv; }
          lrow[qt] = lrow[qt] * alpha + psum;
#pragma unroll
          for (int dt = 0; dt < NDT; ++dt) o[qt][dt] *= alpha;
#pragma unroll
          for (int kk = 0; kk < NKK; ++kk) {
            u32x4 w;
            w.x = cvtpk(s[q][2 * kk][0], s[q][2 * kk][1]); w.y = cvtpk(s[q][2 * kk][2], s[q][2 * kk][3]);
            w.z = cvtpk(s[q][2 * kk + 1][0], s[q][2 * kk + 1][1]); w.w = cvtpk(s[q][2 * kk + 1][2], s[q][2 * kk + 1][3]);
            pfa[qt][kk] = __builtin_bit_cast(bf16x8, w);
          }
        }
      }
#pragma unroll
      for (int kk = 0; kk < NKK; ++kk) {
        const bf16_t* vb = sV + (32 * kk + 4 * quad + (l15 >> 2)) * LDK + 4 * (l15 & 3);
#pragma unroll
        for (int dt = 0; dt < NDT; ++dt) {
          const s16x4 lo = tr_read(vb + 16 * dt);
          const s16x4 hi = tr_read(vb + 16 * LDK + 16 * dt);
          const bf16x8 vf = (bf16x8){lo[0], lo[1], lo[2], lo[3], hi[0], hi[1], hi[2], hi[3]};
#pragma unroll
          for (int qt = 0; qt < NQT; ++qt) o[qt][dt] = __builtin_amdgcn_mfma_f32_16x16x32_bf16(vf, pfa[qt][kk], o[qt][dt], 0, 0, 0);
        }
      }
    }
  }
#pragma unroll
  for (int qt = 0; qt < NQT; ++qt) {
    float l = lrow[qt];
    l += __shfl_xor(l, 16); l += __shfl_xor(l, 32);
    const float inv = 1.0f / l;
    bf16_t* op = c.optr(wid, qt * 16 + l15) + 4 * quad;
#pragma unroll
    for (int dt = 0; dt < NDT; ++dt) { const f32x4 v = o[qt][dt] * inv; u32x2 w; w.x = cvtpk(v[0], v[1]); w.y = cvtpk(v[2], v[3]); *(u32x2*)(op + 16 * dt) = w; }
    if (quad == 0) c.store_lse(wid, qt * 16 + l15, mrow[qt] + __builtin_amdgcn_logf(l));
  }
}

struct CtxA {
  bf16_t* qbase; const bf16_t* kbase; int nt;
  __device__ __forceinline__ const bf16_t* qptr(int w, int ql) const { return qbase + (size_t)(64 * w + ql) * ZW; }
  __device__ __forceinline__ bf16_t* optr(int w, int ql) const { return qbase + (size_t)(64 * w + ql) * ZW; }
  __device__ __forceinline__ const bf16_t* kptr(int t, int r) const { return kbase + (size_t)(64 * t + r) * ZW; }
  __device__ __forceinline__ const bf16_t* vptr(int t, int r) const { return kbase + (size_t)(64 * t + r) * ZW + 128; }
  __device__ __forceinline__ int ntiles() const { return nt; }
  __device__ __forceinline__ bool active(int, int) const { return true; }
  __device__ __forceinline__ float score(int, int, int, int, float s) const { return s; }
  __device__ __forceinline__ void store_lse(int, int, float) const {}
};
struct CtxB {
  bf16_t* zs; float* lse; int d, r, L, i0, qcol, kcol, vcol; float slope_l2;
  __device__ __forceinline__ const bf16_t* qptr(int w, int ql) const { return zs + (size_t)((i0 + 32 * w + ql) * d + r) * ZW + qcol; }
  __device__ __forceinline__ bf16_t* optr(int w, int ql) const { return zs + (size_t)((i0 + 32 * w + ql) * d + r) * ZW + qcol; }
  __device__ __forceinline__ int kidx(int t, int row) const { int i = i0 - 64 + 64 * t + row; i = i < 0 ? 0 : i; return i > L - 1 ? L - 1 : i; }
  __device__ __forceinline__ const bf16_t* kptr(int t, int row) const { return zs + (size_t)(kidx(t, row) * d + r) * ZW + kcol; }
  __device__ __forceinline__ const bf16_t* vptr(int t, int row) const { return zs + (size_t)(kidx(t, row) * d + r) * ZW + vcol; }
  __device__ __forceinline__ int ntiles() const { return 4; }
  __device__ __forceinline__ bool active(int t, int w) const { return w < 2 ? (t < 3) : (t >= 1); }
  __device__ __forceinline__ float score(int t, int w, int ql, int kl, float s) const {
    const int qi = i0 + 32 * w + ql, ki = i0 - 64 + 64 * t + kl; int rel = ki - qi; rel = rel < 0 ? -rel : rel;
    const bool valid = (rel <= 64) && (ki >= 0) && (ki < L);
    return valid ? s * (0.125f * LOG2E) - slope_l2 * (float)rel : -1e30f;
  }
  __device__ __forceinline__ void store_lse(int w, int ql, float v) const { lse[i0 + 32 * w + ql] = v; }
};
struct CtxC {
  bf16_t* zs; const float* rpb; int R, r0, rb, hc;
  __device__ __forceinline__ const bf16_t* qptr(int w, int ql) const { return zs + (size_t)((r0 + (w >> 1)) * 64 + 32 * (w & 1) + ql) * ZW + hc; }
  __device__ __forceinline__ bf16_t* optr(int w, int ql) const { return zs + (size_t)((r0 + (w >> 1)) * 64 + 32 * (w & 1) + ql) * ZW + hc; }
  __device__ __forceinline__ int krow(int t) const { const int kr = rb + t; return kr > R - 1 ? R - 1 : kr; }
  __device__ __forceinline__ const bf16_t* kptr(int t, int row) const { return zs + (size_t)(krow(t) * 64 + row) * ZW + 1024 + hc; }
  __device__ __forceinline__ const bf16_t* vptr(int t, int row) const { return zs + (size_t)(krow(t) * 64 + row) * ZW + 2048 + hc; }
  __device__ __forceinline__ int ntiles() const { return 9; }
  __device__ __forceinline__ int rstart(int r) const { int rs = r - 4; rs = rs < 0 ? 0 : rs; return rs > R - 8 ? R - 8 : rs; }
  __device__ __forceinline__ bool active(int t, int w) const { const int r = r0 + (w >> 1), rs = rstart(r), kr = rb + t; return kr >= rs && kr < rs + 8; }
  __device__ __forceinline__ float score(int t, int w, int ql, int kl, float s) const {
    const int r = r0 + (w >> 1), cq = 32 * (w & 1) + ql, kr = rb + t;
    int cs = cq - 8; cs = cs < 0 ? 0 : cs; cs = cs > 48 ? 48 : cs;
    const bool valid = (kl >= cs) && (kl < cs + 16);
    const int idx = valid ? (kr - r + 7) * 31 + (kl - cq + 15) : 0;
    const float b = rpb[idx];
    return valid ? (s * 0.125f + b) * LOG2E : -1e30f;
  }
  __device__ __forceinline__ void store_lse(int, int, float) const {}
};
struct CtxX {
  bf16_t* qbase; const bf16_t* kv;
  __device__ __forceinline__ const bf16_t* qptr(int w, int ql) const { return qbase + (size_t)(16 * w + ql) * 1024; }
  __device__ __forceinline__ bf16_t* optr(int w, int ql) const { return qbase + (size_t)(16 * w + ql) * 1024; }
  __device__ __forceinline__ const bf16_t* kptr(int t, int row) const { return kv + (size_t)(32 * t + row) * 2048; }
  __device__ __forceinline__ const bf16_t* vptr(int t, int row) const { return kv + (size_t)(32 * t + row) * 2048 + 1024; }
  __device__ __forceinline__ int ntiles() const { return 8; }
  __device__ __forceinline__ bool active(int, int) const { return true; }
  __device__ __forceinline__ float score(int, int, int, int, float s) const { return s * (0.0625f * LOG2E); }
  __device__ __forceinline__ void store_lse(int, int, float) const {}
};

__device__ __forceinline__ void wt_tile(unsigned char* smem, const float* src, int K, int N, const float* gain, bf16_t* dst, int perm, int t) {
  float* tl = (float*)smem;
  const int nkt = K >> 6; const int rt = t / nkt, kt = t - rt * nkt; const int R0 = rt * 64, k0 = kt * 64;
  const int tid = get_tid(); const int rr = tid & 63;
  const int R = R0 + rr; int sc = R;
  if (perm) { const int T = R >> 8, within = R & 255, wc = within >> 7, n = (within & 127) >> 4, i = within & 15; sc = (n & 1) * DFF + 128 * T + 64 * wc + 16 * (n >> 1) + i; }
  __syncthreads();
#pragma unroll 4
  for (int i = 0; i < 16; ++i) {
    const int kk = (tid >> 6) + 4 * i;
    float v = src[(size_t)(k0 + kk) * N + sc];
    if (gain) v *= gain[k0 + kk];
    tl[kk * 65 + rr] = v;
  }
  __syncthreads();
  const int r2 = tid >> 2, kq = tid & 3;
  u32x4 w0, w1;
  w0.x = cvtpk(tl[(16 * kq + 0) * 65 + r2], tl[(16 * kq + 1) * 65 + r2]); w0.y = cvtpk(tl[(16 * kq + 2) * 65 + r2], tl[(16 * kq + 3) * 65 + r2]);
  w0.z = cvtpk(tl[(16 * kq + 4) * 65 + r2], tl[(16 * kq + 5) * 65 + r2]); w0.w = cvtpk(tl[(16 * kq + 6) * 65 + r2], tl[(16 * kq + 7) * 65 + r2]);
  w1.x = cvtpk(tl[(16 * kq + 8) * 65 + r2], tl[(16 * kq + 9) * 65 + r2]); w1.y = cvtpk(tl[(16 * kq + 10) * 65 + r2], tl[(16 * kq + 11) * 65 + r2]);
  w1.z = cvtpk(tl[(16 * kq + 12) * 65 + r2], tl[(16 * kq + 13) * 65 + r2]); w1.w = cvtpk(tl[(16 * kq + 14) * 65 + r2], tl[(16 * kq + 15) * 65 + r2]);
  bf16_t* dp = dst + ((size_t)((k0 + 16 * kq) >> 5) * N + (R0 + r2)) * 32 + ((16 * kq) & 31);
  *(u32x4*)dp = w0; *(u32x4*)(dp + 8) = w1;
}
__device__ __forceinline__ void wt_matrix(unsigned char* smem, const float* src, int K, int N, const float* gain, bf16_t* dst, int perm) {
  const int ntile = (K >> 6) * (N >> 6);
  for (int t = blockIdx.x; t < ntile; t += gridDim.x) wt_tile(smem, src, K, N, gain, dst, perm, t);
}

__device__ __forceinline__ void tile_seq(int tt, int& seqbase, int& qb, int& S) {
  if (tt < 256) { seqbase = (tt >> 4) * 2048; qb = tt & 15; S = 2048; }
  else { const int u = tt - 256; seqbase = NPROMPT + (u >> 7) * 16384; qb = u & 127; S = 16384; }
}

typedef const __attribute__((address_space(4))) Params* KParams;
__device__ __forceinline__ void run_phase(int ph, KParams kp, unsigned char* smem) {
  unsigned char* ws = kp->ws;
  bf16_t* Z = (bf16_t*)(ws + WS_Z);
  const int tid = get_tid();
  const int L = ph >= 10 ? 1 : 0;
  switch (ph) {
    case 0: {
      wt_matrix(smem, kp->w_in_ab, 1024, 3072, kp->g_mix, (bf16_t*)(ws + WS_WT_IN_AB), 0);
      wt_matrix(smem, kp->w_out_ab, 768, 1024, nullptr, (bf16_t*)(ws + WS_WT_OUT_AB), 0);
      wt_matrix(smem, kp->w_in_c, 1024, 3072, kp->g_mix + 1024, (bf16_t*)(ws + WS_WT_IN_C), 0);
      wt_matrix(smem, kp->w_out_c, 1024, 1024, nullptr, (bf16_t*)(ws + WS_WT_OUT_C), 0);
      for (int l = 0; l < 2; ++l) {
        wt_matrix(smem, kp->wq_x + (size_t)l * 1024 * 1024, 1024, 1024, kp->g_xattn + l * 1024, (bf16_t*)(ws + WS_WT_Q) + (size_t)l * 1024 * 1024, 0);
        wt_matrix(smem, kp->wkv_x + (size_t)l * 1024 * 2048, 1024, 2048, kp->g_mem + l * 1024, (bf16_t*)(ws + WS_WT_KV) + (size_t)l * 2048 * 1024, 0);
        wt_matrix(smem, kp->wo_x + (size_t)l * 1024 * 1024, 1024, 1024, nullptr, (bf16_t*)(ws + WS_WT_O) + (size_t)l * 1024 * 1024, 0);
        wt_matrix(smem, kp->w_gu + (size_t)l * 1024 * 5632, 1024, 5632, kp->g_ffn + l * 1024, (bf16_t*)(ws + WS_WT_GU) + (size_t)l * 5632 * 1024, 1);
        wt_matrix(smem, kp->w_down + (size_t)l * DFF * 1024, DFF, 1024, nullptr, (bf16_t*)(ws + WS_WT_DOWN) + (size_t)l * 1024 * DFF, 0);
      }
      const int gi = blockIdx.x * 256 + tid;
      if (gi < 4096) {
        const int pos = gi >> 4, f = gi & 15;
        const float inv_freq = exp2f(-(float)f * 0.83048202372184058696f);
        const float ang = (float)pos * inv_freq;
        float2 cs; cs.x = cosf(ang); cs.y = sinf(ang);
        ((float2*)(ws + WS_ROPE))[gi] = cs;
      }
    } break;
    case 1: {
      const int n_ab = 512 * 12, n_kv = 36 * 8;
      for (int t = blockIdx.x; t < n_ab + 2 * n_kv; t += gridDim.x) {
        if (t < n_ab) {
          int mt, nt; tile_map(t, 12, gridDim.x, mt, nt);
          EpiInAB e{Z, kp->g_qn, kp->g_kn, (const float2*)(ws + WS_ROPE)};
          gemm_tile<true>(smem, xin_row(kp->x_prompt, kp->x_sample, mt * 128), 1024, (const bf16_t*)(ws + WS_WT_IN_AB), 3072, 1024, e, mt * 128, nt * 256);
        } else {
          int u = t - n_ab; const int l = u / n_kv; u -= l * n_kv; const int mt = u >> 3, nt = u & 7;
          EpiStore<true> e{(bf16_t*)(ws + WS_KVMEM) + (size_t)l * 4608 * 2048, 2048};
          gemm_tile<true>(smem, mem_row(kp->mem_prompt, kp->mem_sample, mt * 128), 1024, (const bf16_t*)(ws + WS_WT_KV) + (size_t)l * 2048 * 1024, 2048, 1024, e, mt * 128, nt * 256);
        }
      }
    } break;
    case 2: {
      for (int it = blockIdx.x; it < 2048 + 6144; it += gridDim.x) {
        if (it < 2048) {
          int seqbase, qi, h, nt;
          if (gridDim.x == 512) {
            const int bid = blockIdx.x, i = it >> 9, xcd = bid & 7, l = (bid >> 3) + 64 * (i & 1);
            if (it < 1024) { const int g = xcd >> 1, id = l * 2 + (xcd & 1); qi = id >> 2; h = (g & 1) * 4 + (id & 3); seqbase = NPROMPT + (g >> 1) * 16384; nt = 256; }
            else { const int grp = xcd + 8 * (l >> 5), id = l & 31; qi = id >> 2; h = (grp & 1) * 4 + (id & 3); seqbase = (grp >> 1) * 2048; nt = 32; }
          } else if (it < 1024) { const int s = it >> 9, rem = it & 511; qi = rem >> 3; h = rem & 7; seqbase = NPROMPT + s * 16384; nt = 256; }
          else { const int a = it - 1024; const int s = a >> 6, rem = a & 63; qi = rem >> 3; h = rem & 7; seqbase = s * 2048; nt = 32; }
          CtxA c{Z + (size_t)(seqbase + 256 * qi) * ZW + h * 64, Z + (size_t)seqbase * ZW + 512 + (h >> 2) * 64, nt};
          attn_item<64, 64, 4, true>(smem, c);
        } else {
          const int b = it - 2048; const int h = b & 3, g = (b >> 2) % 3, tt = b / 12;
          int seqbase, qb, S; tile_seq(tt, seqbase, qb, S);
          const int d = g == 0 ? 1 : (g == 1 ? 4 : 16);
          const int Ls = S / d, nb = Ls >> 7; const int r = qb / nb, mblk = qb - r * nb;
          const float slope = exp2f(-8.0f * (float)(4 * g + h + 1) / 12.0f);
          CtxB c{Z + (size_t)seqbase * ZW, (float*)(ws + WS_LSE) + (size_t)(g * 4 + h) * NTOK + seqbase + r * Ls, d, r, Ls, mblk * 128,
                 768 + ((0 * 3 + g) * 4 + h) * 64, 768 + ((1 * 3 + g) * 4 + h) * 64, 768 + ((2 * 3 + g) * 4 + h) * 64, slope * (float)d * LOG2E};
          attn_item<64, 64, 2, true>(smem, c);
        }
      }
    } break;
    case 3: {
      const float* lse = (const float*)(ws + WS_LSE);
      for (int i = blockIdx.x * 256 + tid; i < NTOK * 32; i += gridDim.x * 256) {
        const int T = i >> 5, h = (i >> 3) & 3, c8 = i & 7;
        int sb, pos, lg;
        if (T < NPROMPT) { sb = T & ~2047; pos = T & 2047; lg = 11; } else { sb = NPROMPT + ((T - NPROMPT) & ~16383); pos = (T - NPROMPT) & 16383; lg = 14; }
        const float l0 = ld_agent_f32(lse + (size_t)(0 * 4 + h) * NTOK + sb + pos);
        const float l1 = ld_agent_f32(lse + (size_t)(1 * 4 + h) * NTOK + sb + ((pos & 3) << (lg - 2)) + (pos >> 2));
        const float l2 = ld_agent_f32(lse + (size_t)(2 * 4 + h) * NTOK + sb + ((pos & 15) << (lg - 4)) + (pos >> 4));
        const float mx = fmaxf(l0, fmaxf(l1, l2));
        float w0 = __builtin_amdgcn_exp2f(l0 - mx), w1 = __builtin_amdgcn_exp2f(l1 - mx), w2 = __builtin_amdgcn_exp2f(l2 - mx);
        const float inv = 1.0f / (w0 + w1 + w2); w0 *= inv; w1 *= inv; w2 *= inv;
        const bf16_t* zr = Z + (size_t)T * ZW;
        const u32x4 a = ld_agent_u32x4(zr + 768 + (0 * 4 + h) * 64 + c8 * 8), b = ld_agent_u32x4(zr + 768 + (1 * 4 + h) * 64 + c8 * 8), cc = ld_agent_u32x4(zr + 768 + (2 * 4 + h) * 64 + c8 * 8);
        u32x4 o;
#pragma unroll
        for (int k = 0; k < 4; ++k) {
          const float lo = w0 * bf2f((unsigned short)(a[k] & 0xffff)) + w1 * bf2f((unsigned short)(b[k] & 0xffff)) + w2 * bf2f((unsigned short)(cc[k] & 0xffff));
          const float hi = w0 * bf2f((unsigned short)(a[k] >> 16)) + w1 * bf2f((unsigned short)(b[k] >> 16)) + w2 * bf2f((unsigned short)(cc[k] >> 16));
          o[k] = cvtpk(lo, hi);
        }
        *(u32x4*)(Z + (size_t)T * ZW + 512 + h * 64 + c8 * 8) = o;
      }
    } break;
    case 4: case 7: case 9: case 12: case 15: case 17: {
      const bf16_t* A; int lda, K; const bf16_t* Bt;
      if (ph == 4) { A = Z; lda = ZW; K = 768; Bt = (const bf16_t*)(ws + WS_WT_OUT_AB); }
      else if (ph == 12) { A = Z; lda = ZW; K = 1024; Bt = (const bf16_t*)(ws + WS_WT_OUT_C); }
      else if (ph == 7 || ph == 15) { A = Z; lda = 1024; K = 1024; Bt = (const bf16_t*)(ws + WS_WT_O) + (size_t)L * 1024 * 1024; }
      else { A = Z; lda = DFF; K = DFF; Bt = (const bf16_t*)(ws + WS_WT_DOWN) + (size_t)L * 1024 * DFF; }
      for (int t = blockIdx.x; t < 512 * 4; t += gridDim.x) {
        int mt, nt; tile_map(t, 4, gridDim.x, mt, nt);
        EpiResid e{ph == 4 ? xin_row(kp->x_prompt, kp->x_sample, mt * 128) : kp->out + (size_t)mt * 128 * 1024, kp->out};
        gemm_tile<false>(smem, A + (size_t)mt * 128 * lda, lda, Bt, 1024, K, e, mt * 128, nt * 256);
      }
    } break;
    case 5: case 10: case 13: {
      const bf16_t* Bt; int NT, ldc;
      if (ph == 10) { Bt = (const bf16_t*)(ws + WS_WT_IN_C); NT = 12; ldc = ZW; }
      else { Bt = (const bf16_t*)(ws + WS_WT_Q) + (size_t)L * 1024 * 1024; NT = 4; ldc = 1024; }
      for (int t = blockIdx.x; t < 512 * NT; t += gridDim.x) {
        int mt, nt; tile_map(t, NT, gridDim.x, mt, nt);
        EpiStore<true> e{Z, ldc};
        gemm_tile<true>(smem, kp->out + (size_t)mt * 128 * 1024, 1024, Bt, NT * 256, 1024, e, mt * 128, nt * 256);
      }
    } break;
    case 6: case 14: {
      const bf16_t* kvm = (const bf16_t*)(ws + WS_KVMEM) + (size_t)L * 4608 * 2048;
      for (int it = blockIdx.x; it < 4096; it += gridDim.x) {
        int idx = it; if (gridDim.x == 512) idx = (blockIdx.x & 7) * 512 + (blockIdx.x >> 3) + 64 * (it >> 9);
        const int h = idx & 3, tile = idx >> 2, T0 = tile * 64;
        const int bidx = T0 < NPROMPT ? (T0 >> 11) : 16 + ((T0 - NPROMPT) >> 14);
        CtxX c{Z + (size_t)T0 * 1024 + h * 256, kvm + (size_t)bidx * 256 * 2048 + h * 256};
        attn_item<256, 32, 1, true>(smem, c);
      }
    } break;
    case 8: case 16: {
      const bf16_t* Bt = (const bf16_t*)(ws + WS_WT_GU) + (size_t)L * 5632 * 1024;
      for (int t = blockIdx.x; t < 512 * 22; t += gridDim.x) {
        int mt, nt; tile_map(t, 22, gridDim.x, mt, nt);
        EpiSwiGLU e{Z};
        gemm_tile<true>(smem, kp->out + (size_t)mt * 128 * 1024, 1024, Bt, 5632, 1024, e, mt * 128, nt * 256);
      }
    } break;
    case 11: {
      float* srpb = (float*)(smem + 2 * 64 * 72 * 2);
      for (int it = blockIdx.x; it < 8192; it += gridDim.x) {
        int h = it & 15, tt = it >> 4;
        if (gridDim.x == 512) { const int l = (blockIdx.x >> 3) + 64 * (it >> 9); h = 2 * (blockIdx.x & 7) + (l & 1); tt = l >> 1; }
        int seqbase, rp, S; tile_seq(tt, seqbase, rp, S);
        const int R = S >> 6, r0 = 2 * rp;
        int rb = r0 - 4; rb = rb < 0 ? 0 : rb; rb = rb > R - 8 ? R - 8 : rb;
        __syncthreads();
        for (int i = tid; i < 15 * 31; i += 256) srpb[i] = kp->rpb_c[h * 15 * 31 + i];
        CtxC c{Z + (size_t)seqbase * ZW, srpb, R, r0, rb, h * 64};
        attn_item<64, 64, 2, true>(smem, c);
      }
    } break;
    case 18: {
      const int lane = tid & 63, wv = blockIdx.x * 4 + (tid >> 6), nwv = gridDim.x * 4;
      for (int row = wv; row < NTOK; row += nwv) {
        float* xr = kp->out + (size_t)row * 1024;
        f32x4 v[4]; float s = 0.f;
#pragma unroll
        for (int i = 0; i < 4; ++i) { v[i] = ld_agent_f32x4(xr + i * 256 + lane * 4); s += v[i][0] * v[i][0] + v[i][1] * v[i][1] + v[i][2] * v[i][2] + v[i][3] * v[i][3]; }
        s += __shfl_xor(s, 1); s += __shfl_xor(s, 2); s += __shfl_xor(s, 4); s += __shfl_xor(s, 8); s += __shfl_xor(s, 16); s += __shfl_xor(s, 32);
        const float r = rsqrtf(s * (1.0f / 1024.0f) + EPS);
#pragma unroll
        for (int i = 0; i < 4; ++i) { const f32x4 g = *(const f32x4*)(kp->g_final + i * 256 + lane * 4); *(f32x4*)(xr + i * 256 + lane * 4) = v[i] * r * g; }
      }
    } break;
    default: break;
  }
}

constexpr int NPHASE = 19;

template <bool COOP>
__global__ void __launch_bounds__(256, 2) mega(Params p) {
  __shared__ __attribute__((aligned(16))) unsigned char smem[SMEM_BYTES];
  if constexpr (COOP) {
    cg::grid_group grid = cg::this_grid();
#define STEP(PH) { KParams kp = (KParams)__builtin_amdgcn_kernarg_segment_ptr(); asm volatile("" : "+s"(kp)); run_phase(PH, kp, smem); if (PH + 1 < NPHASE) grid.sync(); }
    STEP(0) STEP(1) STEP(2) STEP(3) STEP(4) STEP(5) STEP(6) STEP(7) STEP(8) STEP(9)
    STEP(10) STEP(11) STEP(12) STEP(13) STEP(14) STEP(15) STEP(16) STEP(17) STEP(18)
#undef STEP
  } else {
    for (int ph = p.phase_lo; ph < p.phase_hi; ++ph) {
      KParams kp = (KParams)__builtin_amdgcn_kernarg_segment_ptr();
      asm volatile("" : "+s"(kp));
      run_phase(ph, kp, smem);
    }
  }
}

extern "C" void kernel_launch(void* const* d_in, const int* in_sizes, int n_in, void* d_out, int out_size, void* d_ws, size_t ws_size, hipStream_t stream) {
  static int grid = 0;
  if (grid == 0) {
    if (n_in != 21 || ws_size < WS_END) { fprintf(stderr, "kernel_launch: n_in %d ws %zu (need %zu)\n", n_in, ws_size, (size_t)WS_END); grid = -1; return; }
    int dev = 0, cus = 0, per_cu = 0;
    hipGetDevice(&dev);
    hipDeviceGetAttribute(&cus, hipDeviceAttributeMultiprocessorCount, dev);
#if MULTI_LAUNCH
    hipOccupancyMaxActiveBlocksPerMultiprocessor(&per_cu, (const void*)mega<false>, 256, 0);
#else
    hipOccupancyMaxActiveBlocksPerMultiprocessor(&per_cu, (const void*)mega<true>, 256, 0);
#endif
    if (per_cu < 1) per_cu = 1;
    if (per_cu > 2) per_cu = 2;
    grid = cus * per_cu;
  }
  if (grid < 0) return;
  Params p{};
  p.x_prompt = (const float*)d_in[0]; p.x_sample = (const float*)d_in[1]; p.mem_prompt = (const float*)d_in[2]; p.mem_sample = (const float*)d_in[3];
  p.g_mix = (const float*)d_in[4]; p.w_in_ab = (const float*)d_in[5]; p.g_qn = (const float*)d_in[6]; p.g_kn = (const float*)d_in[7]; p.w_out_ab = (const float*)d_in[8];
  p.w_in_c = (const float*)d_in[9]; p.rpb_c = (const float*)d_in[10]; p.w_out_c = (const float*)d_in[11]; p.g_xattn = (const float*)d_in[12]; p.g_mem = (const float*)d_in[13];
  p.wq_x = (const float*)d_in[14]; p.wkv_x = (const float*)d_in[15]; p.wo_x = (const float*)d_in[16]; p.g_ffn = (const float*)d_in[17]; p.w_gu = (const float*)d_in[18]; p.w_down = (const float*)d_in[19];
  p.g_final = (const float*)d_in[20];
  p.out = (float*)d_out; p.ws = (unsigned char*)d_ws;
#if MULTI_LAUNCH
  for (int ph = 0; ph < NPHASE; ++ph) {
    p.phase_lo = ph; p.phase_hi = ph + 1;
    hipLaunchKernelGGL(mega<false>, dim3(grid), dim3(256), 0, stream, p);
  }
#else
  p.phase_lo = 0; p.phase_hi = NPHASE;
  void* args[] = {&p};
  hipError_t e = hipLaunchCooperativeKernel((const void*)mega<true>, dim3(grid), dim3(256), args, 0, stream);
  if (e != hipSuccess) fprintf(stderr, "cooperative launch failed: %s (grid %d)\n", hipGetErrorString(e), grid);
#endif
}
#ifdef DBG_RES
template <int PH> __global__ void __launch_bounds__(256, 2) mega_one(Params p) {
  __shared__ __attribute__((aligned(16))) unsigned char smem[SMEM_BYTES];
  run_phase(PH, (KParams)__builtin_amdgcn_kernarg_segment_ptr(), smem);
}
template __global__ void mega_one<0>(Params); template __global__ void mega_one<1>(Params); template __global__ void mega_one<2>(Params);
template __global__ void mega_one<3>(Params); template __global__ void mega_one<4>(Params); template __global__ void mega_one<5>(Params);
template __global__ void mega_one<6>(Params); template __global__ void mega_one<8>(Params); template __global__ void mega_one<11>(Params);
template __global__ void mega_one<18>(Params);
#endif
```

```cpp
#include <hip/hip_runtime.h>
#include <hip/hip_cooperative_groups.h>
#include <cstdint>
#include <cstdio>
namespace cg = cooperative_groups;

#ifndef MULTI_LAUNCH
#define MULTI_LAUNCH 0
#endif

typedef unsigned short bf16_t;
typedef short bf16x8 __attribute__((ext_vector_type(8)));
typedef short s16x4 __attribute__((ext_vector_type(4)));
typedef short v4i16_t __attribute__((ext_vector_type(4)));
typedef float f32x4 __attribute__((ext_vector_type(4)));
typedef float f32x2_t __attribute__((ext_vector_type(2)));
typedef __bf16 bf16x2_t __attribute__((ext_vector_type(2)));
typedef unsigned u32x4 __attribute__((ext_vector_type(4)));
typedef unsigned u32x2 __attribute__((ext_vector_type(2)));

#define LOG2E 1.4426950408889634f
constexpr int NTOK = 65536;
constexpr int NPROMPT = 32768;
constexpr int ZW = 3072;
constexpr int DFF = 2816;
constexpr float EPS = 1e-6f;

constexpr size_t WS_WT_IN_AB = 0;
constexpr size_t WS_WT_OUT_AB = WS_WT_IN_AB + (size_t)3072 * 1024 * 2;
constexpr size_t WS_WT_IN_C = WS_WT_OUT_AB + (size_t)1024 * 768 * 2;
constexpr size_t WS_WT_OUT_C = WS_WT_IN_C + (size_t)3072 * 1024 * 2;
constexpr size_t WS_WT_Q = WS_WT_OUT_C + (size_t)1024 * 1024 * 2;
constexpr size_t WS_WT_KV = WS_WT_Q + (size_t)2 * 1024 * 1024 * 2;
constexpr size_t WS_WT_O = WS_WT_KV + (size_t)2 * 2048 * 1024 * 2;
constexpr size_t WS_WT_GU = WS_WT_O + (size_t)2 * 1024 * 1024 * 2;
constexpr size_t WS_WT_DOWN = WS_WT_GU + (size_t)2 * 5632 * 1024 * 2;
constexpr size_t WS_KVMEM = WS_WT_DOWN + (size_t)2 * 1024 * 2816 * 2;
constexpr size_t WS_LSE = WS_KVMEM + (size_t)2 * 4608 * 2048 * 2;
constexpr size_t WS_ROPE = WS_LSE + (size_t)3 * 65536 * 4 * 4;
constexpr size_t WS_Z = WS_ROPE + (size_t)256 * 16 * 8;
constexpr size_t WS_END = WS_Z + (size_t)NTOK * ZW * 2;

constexpr int SMEM_BYTES = 2 * (128 + 256) * 40 * 2 + 512;

struct Params {
  const float* x_prompt; const float* x_sample; const float* mem_prompt; const float* mem_sample;
  const float* g_mix; const float* w_in_ab; const float* g_qn; const float* g_kn; const float* w_out_ab;
  const float* w_in_c; const float* rpb_c; const float* w_out_c; const float* g_xattn; const float* g_mem;
  const float* wq_x; const float* wkv_x; const float* wo_x; const float* g_ffn; const float* w_gu; const float* w_down;
  const float* g_final;
  float* out; unsigned char* ws;
  int phase_lo, phase_hi;
};

__device__ __forceinline__ int get_tid() { int t = threadIdx.x; asm volatile("" : "+v"(t)); return t; }
__device__ __forceinline__ unsigned cvtpk(float lo, float hi) { f32x2_t v = {lo, hi}; bf16x2_t b = __builtin_convertvector(v, bf16x2_t); return __builtin_bit_cast(unsigned, b); }
__device__ __forceinline__ float bf2f(unsigned short h) { return __uint_as_float(((unsigned)h) << 16); }
__device__ __forceinline__ s16x4 tr_read(const bf16_t* p) {
  return __builtin_bit_cast(s16x4, __builtin_amdgcn_ds_read_tr16_b64_v4i16((__attribute__((address_space(3))) v4i16_t*)p));
}
__device__ __forceinline__ const float* xin_row(const float* xp, const float* xs, int row) {
  return row < NPROMPT ? xp + (size_t)row * 1024 : xs + (size_t)(row - NPROMPT) * 1024;
}
__device__ __forceinline__ const float* mem_row(const float* mp, const float* ms, int row) {
  return row < 4096 ? mp + (size_t)row * 1024 : ms + (size_t)(row - 4096) * 1024;
}


__device__ __forceinline__ void ld16_sc1(u32x4& v, const void* p) { asm volatile("global_load_dwordx4 %0, %1, off sc1" : "=v"(v) : "v"(p) : "memory"); }
__device__ __forceinline__ void ld16_sc1(f32x4& v, const float* p) { asm volatile("global_load_dwordx4 %0, %1, off sc1" : "=v"(v) : "v"(p) : "memory"); }
__device__ __forceinline__ u32x4 ld_agent_u32x4(const void* p) {
  const unsigned long long a = __hip_atomic_load((const unsigned long long*)p, __ATOMIC_RELAXED, __HIP_MEMORY_SCOPE_AGENT);
  const unsigned long long b = __hip_atomic_load((const unsigned long long*)p + 1, __ATOMIC_RELAXED, __HIP_MEMORY_SCOPE_AGENT);
  return (u32x4){(unsigned)a, (unsigned)(a >> 32), (unsigned)b, (unsigned)(b >> 32)};
}
__device__ __forceinline__ float ld_agent_f32(const float* p) { return __uint_as_float(__hip_atomic_load((const unsigned*)p, __ATOMIC_RELAXED, __HIP_MEMORY_SCOPE_AGENT)); }
__device__ __forceinline__ f32x4 ld_agent_f32x4(const float* p) {
  const unsigned long long a = __hip_atomic_load((const unsigned long long*)p, __ATOMIC_RELAXED, __HIP_MEMORY_SCOPE_AGENT);
  const unsigned long long b = __hip_atomic_load((const unsigned long long*)p + 1, __ATOMIC_RELAXED, __HIP_MEMORY_SCOPE_AGENT);
  f32x4 v; v[0] = __uint_as_float((unsigned)a); v[1] = __uint_as_float((unsigned)(a >> 32)); v[2] = __uint_as_float((unsigned)b); v[3] = __uint_as_float((unsigned)(b >> 32)); return v;
}
__device__ __forceinline__ void tile_map(int t, int NT, int gdim, int& mt, int& nt) {
  if ((gdim & 7) == 0) { const int i = t / gdim, b = t - i * gdim; const int lt = (b >> 3) + (gdim >> 3) * i; const int ml = lt / NT; nt = lt - ml * NT; mt = (b & 7) + 8 * ml; }
  else { mt = t / NT; nt = t - mt * NT; }
}
constexpr int GLD = 40;
constexpr int G_STAGE = (128 + 256) * GLD;
template <bool AF32, class Epi>
__device__ __forceinline__ void gemm_tile(unsigned char* smem, const void* Ap, int lda, const bf16_t* WT, int N, int K, const Epi& epi, int m0, int n0) {
  const int tid = get_tid(), lane = tid & 63;
  const int wid = __builtin_amdgcn_readfirstlane(tid >> 6);
  const int wr = wid >> 1, wc = wid & 1, l15 = lane & 15, quad = lane >> 4;
  bf16_t* sbase = (bf16_t*)smem; float* sR = (float*)(smem + 2 * G_STAGE * 2);
  f32x4 acc[4][8];
#pragma unroll
  for (int m = 0; m < 4; ++m)
#pragma unroll
    for (int n = 0; n < 8; ++n) acc[m][n] = (f32x4){0.f, 0.f, 0.f, 0.f};
  float ss[4];
#pragma unroll
  for (int i = 0; i < 4; ++i) ss[i] = 0.f;
  f32x4 ra[4]; u32x4 rab[2]; u32x4 rb[4];
  const int nk = K >> 5;
  const float* Af = (const float*)Ap + (size_t)(tid >> 3) * lda + (tid & 7) * 4;
  const bf16_t* Ab = (const bf16_t*)Ap + (size_t)(tid >> 2) * lda + (tid & 3) * 8;
  const bf16_t* Bp = WT + (size_t)n0 * 32 + tid * 8;
  const size_t bstep = (size_t)N * 32;
  const int awf = (tid >> 3) * GLD + (tid & 7) * 4;
  const int awb = (tid >> 2) * GLD + (tid & 3) * 8;
#define G_LOAD(kt_) do { \
    if constexpr (AF32) { _Pragma("unroll") for (int i = 0; i < 4; ++i) ld16_sc1(ra[i], Af + (size_t)i * 32 * lda + (kt_) * 32); } \
    else { _Pragma("unroll") for (int i = 0; i < 2; ++i) ld16_sc1(rab[i], Ab + (size_t)i * 64 * lda + (kt_) * 32); } \
    _Pragma("unroll") for (int i = 0; i < 4; ++i) ld16_sc1(rb[i], Bp + (size_t)(kt_) * bstep + i * 2048); } while (0)
#define G_STORE(st_) do { bf16_t* sa_ = sbase + (st_) * G_STAGE; bf16_t* sb_ = sa_ + 128 * GLD; \
    if constexpr (AF32) { asm volatile("s_waitcnt vmcnt(0)" : "+v"(ra[0]), "+v"(ra[1]), "+v"(ra[2]), "+v"(ra[3]), "+v"(rb[0]), "+v"(rb[1]), "+v"(rb[2]), "+v"(rb[3]) :: "memory"); \
      _Pragma("unroll") for (int i = 0; i < 4; ++i) { const f32x4 v = ra[i]; \
        ss[i] += v[0] * v[0] + v[1] * v[1] + v[2] * v[2] + v[3] * v[3]; \
        u32x2 w; w.x = cvtpk(v[0], v[1]); w.y = cvtpk(v[2], v[3]); *(u32x2*)(sa_ + awf + i * 32 * GLD) = w; } } \
    else { asm volatile("s_waitcnt vmcnt(0)" : "+v"(rab[0]), "+v"(rab[1]), "+v"(rb[0]), "+v"(rb[1]), "+v"(rb[2]), "+v"(rb[3]) :: "memory"); \
      _Pragma("unroll") for (int i = 0; i < 2; ++i) *(u32x4*)(sa_ + awb + i * 64 * GLD) = rab[i]; } \
    _Pragma("unroll") for (int i = 0; i < 4; ++i) *(u32x4*)(sb_ + awb + i * 64 * GLD) = rb[i]; } while (0)
  G_LOAD(0);
  G_STORE(0);
  if (nk > 1) G_LOAD(1);
  __syncthreads();
  for (int kt = 0; kt < nk; ++kt) {
    const int cur = kt & 1;
    if (kt + 1 < nk) G_STORE(cur ^ 1);
    if (kt + 2 < nk) G_LOAD(kt + 2);
    const bf16_t* a_s = sbase + cur * G_STAGE + (wr * 64 + l15) * GLD + quad * 8;
    const bf16_t* b_s = sbase + cur * G_STAGE + 128 * GLD + (wc * 128 + l15) * GLD + quad * 8;
    __builtin_amdgcn_s_setprio(1);
    bf16x8 af[4];
#pragma unroll
    for (int m = 0; m < 4; ++m) af[m] = *(const bf16x8*)(a_s + m * 16 * GLD);
#pragma unroll
    for (int nh = 0; nh < 4; ++nh) {
      bf16x8 bfr[2];
#pragma unroll
      for (int n2 = 0; n2 < 2; ++n2) bfr[n2] = *(const bf16x8*)(b_s + (nh * 2 + n2) * 16 * GLD);
#pragma unroll
      for (int m = 0; m < 4; ++m)
#pragma unroll
        for (int n2 = 0; n2 < 2; ++n2) acc[m][nh * 2 + n2] = __builtin_amdgcn_mfma_f32_16x16x32_bf16(bfr[n2], af[m], acc[m][nh * 2 + n2], 0, 0, 0);
    }
    __builtin_amdgcn_s_setprio(0);
    __syncthreads();
  }
#undef G_LOAD
#undef G_STORE
  if constexpr (AF32) {
    const float invK = 1.0f / (float)K;
#pragma unroll
    for (int i = 0; i < 4; ++i) {
      float s = ss[i];
      s += __shfl_xor(s, 1); s += __shfl_xor(s, 2); s += __shfl_xor(s, 4);
      if ((tid & 7) == 0) sR[(tid >> 3) + 32 * i] = rsqrtf(s * invK + EPS);
    }
    __syncthreads();
  }
  epi(acc, m0, wr * 64, n0 + wc * 128, l15, quad, sR);
}

template <bool RS> struct EpiStore {
  bf16_t* C; int ldc;
  __device__ __forceinline__ void operator()(f32x4 (&acc)[4][8], int m0, int rl0, int cb, int l15, int quad, const float* sR) const {
#pragma unroll
    for (int m = 0; m < 4; ++m) {
      const int rl = rl0 + 16 * m + l15; const float rs = RS ? sR[rl] : 1.f;
      bf16_t* rp = C + (size_t)(m0 + rl) * ldc + cb + 4 * quad;
#pragma unroll
      for (int n = 0; n < 8; ++n) { const f32x4 v = acc[m][n] * rs; u32x2 w; w.x = cvtpk(v[0], v[1]); w.y = cvtpk(v[2], v[3]); *(u32x2*)(rp + 16 * n) = w; }
    }
  }
};
struct EpiInAB {
  bf16_t* Z; const float* gq; const float* gk; const float2* rope;
  __device__ __forceinline__ void operator()(f32x4 (&acc)[4][8], int m0, int rl0, int cb0, int l15, int quad, const float* sR) const {
#pragma unroll
    for (int hh = 0; hh < 2; ++hh) {
      const int cb = cb0 + 64 * hh;
      if (cb >= 640) {
#pragma unroll
        for (int m = 0; m < 4; ++m) {
          const int rl = rl0 + 16 * m + l15; const float rs = sR[rl];
          bf16_t* rp = Z + (size_t)(m0 + rl) * ZW + cb + 4 * quad;
#pragma unroll
          for (int n = 0; n < 4; ++n) { const f32x4 v = acc[m][4 * hh + n] * rs; u32x2 w; w.x = cvtpk(v[0], v[1]); w.y = cvtpk(v[2], v[3]); *(u32x2*)(rp + 16 * n) = w; }
        }
      } else {
        const float* g = cb < 512 ? gq : gk;
        const float qs = cb < 512 ? 0.125f * LOG2E : 1.0f;
        f32x4 gv[4];
#pragma unroll
        for (int n = 0; n < 4; ++n) gv[n] = *(const f32x4*)(g + 16 * n + 4 * quad) * qs;
#pragma unroll
        for (int m = 0; m < 4; ++m) {
          const int rl = rl0 + 16 * m + l15; const int row = m0 + rl; const float rs = sR[rl];
          f32x4 z[4]; float s2 = 0.f;
#pragma unroll
          for (int n = 0; n < 4; ++n) { z[n] = acc[m][4 * hh + n] * rs; s2 += z[n][0] * z[n][0] + z[n][1] * z[n][1] + z[n][2] * z[n][2] + z[n][3] * z[n][3]; }
          s2 += __shfl_xor(s2, 16); s2 += __shfl_xor(s2, 32);
          const float r = rsqrtf(s2 * (1.0f / 64.0f) + EPS);
          const int pos = row < NPROMPT ? (row & 2047) : (row & 16383);
          const int gr = pos >> 6, gc = pos & 63;
          bf16_t* rp = Z + (size_t)row * ZW + cb + 4 * quad;
#pragma unroll
          for (int n = 0; n < 4; ++n) {
            const int ap = (n < 2) ? gr : gc;
            const f32x4 zn = z[n] * r * gv[n];
            float2 c0, c1; { const unsigned long long w0 = __hip_atomic_load((const unsigned long long*)(rope + ap * 16 + ((8 * n + 2 * quad) & 15)), __ATOMIC_RELAXED, __HIP_MEMORY_SCOPE_AGENT), w1 = __hip_atomic_load((const unsigned long long*)(rope + ap * 16 + ((8 * n + 2 * quad + 1) & 15)), __ATOMIC_RELAXED, __HIP_MEMORY_SCOPE_AGENT); c0.x = __uint_as_float((unsigned)w0); c0.y = __uint_as_float((unsigned)(w0 >> 32)); c1.x = __uint_as_float((unsigned)w1); c1.y = __uint_as_float((unsigned)(w1 >> 32)); }
            const float o0 = zn[0] * c0.x - zn[1] * c0.y, o1 = zn[0] * c0.y + zn[1] * c0.x;
            const float o2 = zn[2] * c1.x - zn[3] * c1.y, o3 = zn[2] * c1.y + zn[3] * c1.x;
            u32x2 w; w.x = cvtpk(o0, o1); w.y = cvtpk(o2, o3); *(u32x2*)(rp + 16 * n) = w;
          }
        }
      }
    }
  }
};
struct EpiResid {
  const float* src_tile; float* dst;
  __device__ __forceinline__ void operator()(f32x4 (&acc)[4][8], int m0, int rl0, int cb, int l15, int quad, const float* sR) const {
#pragma unroll
    for (int m = 0; m < 4; ++m) {
      const int rl = rl0 + 16 * m + l15;
      const float* sp = src_tile + (size_t)rl * 1024 + cb + 4 * quad; float* dp = dst + (size_t)(m0 + rl) * 1024 + cb + 4 * quad;
#pragma unroll
      for (int n = 0; n < 8; ++n) { const f32x4 x = ld_agent_f32x4(sp + 16 * n); *(f32x4*)(dp + 16 * n) = x + acc[m][n]; }
    }
  }
};
struct EpiSwiGLU {
  bf16_t* H;
  __device__ __forceinline__ void operator()(f32x4 (&acc)[4][8], int m0, int rl0, int cb, int l15, int quad, const float* sR) const {
    const int hc0 = (cb >> 8) * 128 + ((cb >> 7) & 1) * 64 + 4 * quad;
#pragma unroll
    for (int m = 0; m < 4; ++m) {
      const int rl = rl0 + 16 * m + l15; const float rs = sR[rl];
      bf16_t* rp = H + (size_t)(m0 + rl) * DFF + hc0;
#pragma unroll
      for (int pp = 0; pp < 4; ++pp) {
        const f32x4 g = acc[m][2 * pp] * rs, u = acc[m][2 * pp + 1] * rs; float h[4];
#pragma unroll
        for (int j = 0; j < 4; ++j) h[j] = g[j] / (1.0f + __expf(-g[j])) * u[j];
        u32x2 w; w.x = cvtpk(h[0], h[1]); w.y = cvtpk(h[2], h[3]); *(u32x2*)(rp + 16 * pp) = w;
      }
    }
  }
};

template <int DH, int KT, int NQT, bool PF, class Ctx>
__device__ __forceinline__ void attn_item(unsigned char* smem, const Ctx& c) {
  constexpr int LDK = DH + 8, CH = DH / 8, NCH = KT * CH / 256, NKS = DH / 32, NK4 = KT / 16, NKK = KT / 32, NDT = DH / 16;
  bf16_t* sK = (bf16_t*)smem; bf16_t* sV = sK + KT * LDK;
  const int tid = get_tid(), lane = tid & 63;
  const int wid = __builtin_amdgcn_readfirstlane(tid >> 6);
  const int l15 = lane & 15, quad = lane >> 4;
  bf16x8 qf[NQT][NKS];
#pragma unroll
  for (int qt = 0; qt < NQT; ++qt) {
    const bf16_t* qp = c.qptr(wid, qt * 16 + l15);
#pragma unroll
    for (int ks = 0; ks < NKS; ++ks) qf[qt][ks] = __builtin_bit_cast(bf16x8, ld_agent_u32x4(qp + ks * 32 + quad * 8));
  }
  f32x4 o[NQT][NDT];
  float mrow[NQT], lrow[NQT];
#pragma unroll
  for (int qt = 0; qt < NQT; ++qt) {
    mrow[qt] = -1e30f; lrow[qt] = 0.f;
#pragma unroll
    for (int dt = 0; dt < NDT; ++dt) o[qt][dt] = (f32x4){0.f, 0.f, 0.f, 0.f};
  }
  const int nt = c.ntiles();
  u32x4 rk[NCH], rv[NCH];
  if constexpr (PF) {
#pragma unroll
    for (int i = 0; i < NCH; ++i) {
      const int ci = tid + 256 * i, row = ci / CH, ch = ci % CH;
      ld16_sc1(rk[i], c.kptr(0, row) + ch * 8); ld16_sc1(rv[i], c.vptr(0, row) + ch * 8);
    }
  }
  for (int t = 0; t < nt; ++t) {
    __syncthreads();
    if constexpr (PF) {
      static_assert(!PF || NCH == 2 || NCH == 4, "wait lists below are written for two or four chunks per matrix");
      if constexpr (NCH == 2) asm volatile("s_waitcnt vmcnt(0)" : "+v"(rk[0]), "+v"(rk[NCH - 1]), "+v"(rv[0]), "+v"(rv[NCH - 1]) :: "memory");
      else asm volatile("s_waitcnt vmcnt(0)" : "+v"(rk[0]), "+v"(rk[1]), "+v"(rk[NCH - 2]), "+v"(rk[NCH - 1]), "+v"(rv[0]), "+v"(rv[1]), "+v"(rv[NCH - 2]), "+v"(rv[NCH - 1]) :: "memory");
#pragma unroll
      for (int i = 0; i < NCH; ++i) {
        const int ci = tid + 256 * i, row = ci / CH, ch = ci % CH;
        *(u32x4*)(sK + row * LDK + ch * 8) = rk[i]; *(u32x4*)(sV + row * LDK + ch * 8) = rv[i];
      }
    } else {
#pragma unroll
      for (int i = 0; i < NCH; ++i) {
        const int ci = tid + 256 * i, row = ci / CH, ch = ci % CH;
        *(u32x4*)(sK + row * LDK + ch * 8) = ld_agent_u32x4(c.kptr(t, row) + ch * 8);
      }
#pragma unroll
      for (int i = 0; i < NCH; ++i) {
        const int ci = tid + 256 * i, row = ci / CH, ch = ci % CH;
        *(u32x4*)(sV + row * LDK + ch * 8) = ld_agent_u32x4(c.vptr(t, row) + ch * 8);
      }
    }
    __syncthreads();
    if constexpr (PF) {
      if (t + 1 < nt) {
#pragma unroll
        for (int i = 0; i < NCH; ++i) {
          const int ci = tid + 256 * i, row = ci / CH, ch = ci % CH;
          ld16_sc1(rk[i], c.kptr(t + 1, row) + ch * 8); ld16_sc1(rv[i], c.vptr(t + 1, row) + ch * 8);
        }
      }
    }
    if (c.active(t, wid)) {
      constexpr int QG = NQT < 2 ? NQT : 2;
      bf16x8 pfa[NQT][NKK];
#pragma unroll
      for (int g = 0; g < NQT; g += QG) {
        f32x4 s[QG][NK4];
#pragma unroll
        for (int q = 0; q < QG; ++q)
#pragma unroll
          for (int k4 = 0; k4 < NK4; ++k4) s[q][k4] = (f32x4){0.f, 0.f, 0.f, 0.f};
#pragma unroll
        for (int k4 = 0; k4 < NK4; ++k4)
#pragma unroll
          for (int ks = 0; ks < NKS; ++ks) {
            const bf16x8 kf = *(const bf16x8*)(sK + (16 * k4 + l15) * LDK + ks * 32 + quad * 8);
#pragma unroll
            for (int q = 0; q < QG; ++q) s[q][k4] = __builtin_amdgcn_mfma_f32_16x16x32_bf16(kf, qf[g + q][ks], s[q][k4], 0, 0, 0);
          }
#pragma unroll
        for (int q = 0; q < QG; ++q) {
          const int qt = g + q;
          float mx = -1e30f;
#pragma unroll
          for (int k4 = 0; k4 < NK4; ++k4)
#pragma unroll
            for (int j = 0; j < 4; ++j) { const float v = c.score(t, wid, qt * 16 + l15, 16 * k4 + 4 * quad + j, s[q][k4][j]); s[q][k4][j] = v; mx = fmaxf(mx, v); }
          mx = fmaxf(mx, __shfl_xor(mx, 16)); mx = fmaxf(mx, __shfl_xor(mx, 32));
          const float mnew = fmaxf(mrow[qt], mx);
          const float alpha = __builtin_amdgcn_exp2f(mrow[qt] - mnew);
          mrow[qt] = mnew;
          float psum = 0.f;
#pragma unroll
          for (int k4 = 0; k4 < NK4; ++k4)
#pragma unroll
            for (int j = 0; j < 4; ++j) { const float pv = __builtin_amdgcn_exp2f(s[q][k4][j] - mnew); s[q][k4][j] = pv; psum += pv; }
          lrow[qt] = lrow[qt] * alpha + psum;
#pragma unroll
          for (int dt = 0; dt < NDT; ++dt) o[qt][dt] *= alpha;
#pragma unroll
          for (int kk = 0; kk < NKK; ++kk) {
            u32x4 w;
            w.x = cvtpk(s[q][2 * kk][0], s[q][2 * kk][1]); w.y = cvtpk(s[q][2 * kk][2], s[q][2 * kk][3]);
            w.z = cvtpk(s[q][2 * kk + 1][0], s[q][2 * kk + 1][1]); w.w = cvtpk(s[q][2 * kk + 1][2], s[q][2 * kk + 1][3]);
            pfa[qt][kk] = __builtin_bit_cast(bf16x8, w);
          }
        }
      }
#pragma unroll
      for (int kk = 0; kk < NKK; ++kk) {
        const bf16_t* vb = sV + (32 * kk + 4 * quad + (l15 >> 2)) * LDK + 4 * (l15 & 3);
#pragma unroll
        for (int dt = 0; dt < NDT; ++dt) {
          const s16x4 lo = tr_read(vb + 16 * dt);
          const s16x4 hi = tr_read(vb + 16 * LDK + 16 * dt);
          const bf16x8 vf = (bf16x8){lo[0], lo[1], lo[2], lo[3], hi[0], hi[1], hi[2], hi[3]};
#pragma unroll
          for (int qt = 0; qt < NQT; ++qt) o[qt][dt] = __builtin_amdgcn_mfma_f32_16x16x32_bf16(vf, pfa[qt][kk], o[qt][dt], 0, 0, 0);
        }
      }
    }
  }
#pragma unroll
  for (int qt = 0; qt < NQT; ++qt) {
    float l = lrow[qt];
    l += __shfl_xor(l, 16); l += __shfl_xor(l, 32);
    const float inv = 1.0f / l;
    bf16_t* op = c.optr(wid, qt * 16 + l15) + 4 * quad;
#pragma unroll
    for (int dt = 0; dt < NDT; ++dt) { const f32x4 v = o[qt][dt] * inv; u32x2 w; w.x = cvtpk(v[0], v[1]); w.y = cvtpk(v[2], v[3]); *(u32x2*)(op + 16 * dt) = w; }
    if (quad == 0) c.store_lse(wid, qt * 16 + l15, mrow[qt] + __builtin_amdgcn_logf(l));
  }
}

struct CtxA {
  bf16_t* qbase; const bf16_t* kbase; int nt;
  __device__ __forceinline__ const bf16_t* qptr(int w, int ql) const { return qbase + (size_t)(64 * w + ql) * ZW; }
  __device__ __forceinline__ bf16_t* optr(int w, int ql) const { return qbase + (size_t)(64 * w + ql) * ZW; }
  __device__ __forceinline__ const bf16_t* kptr(int t, int r) const { return kbase + (size_t)(64 * t + r) * ZW; }
  __device__ __forceinline__ const bf16_t* vptr(int t, int r) const { return kbase + (size_t)(64 * t + r) * ZW + 128; }
  __device__ __forceinline__ int ntiles() const { return nt; }
  __device__ __forceinline__ bool active(int, int) const { return true; }
  __device__ __forceinline__ float score(int, int, int, int, float s) const { return s; }
  __device__ __forceinline__ void store_lse(int, int, float) const {}
};
struct CtxB {
  bf16_t* zs; float* lse; int d, r, L, i0, qcol, kcol, vcol; float slope_l2;
  __device__ __forceinline__ const bf16_t* qptr(int w, int ql) const { return zs + (size_t)((i0 + 32 * w + ql) * d + r) * ZW + qcol; }
  __device__ __forceinline__ bf16_t* optr(int w, int ql) const { return zs + (size_t)((i0 + 32 * w + ql) * d + r) * ZW + qcol; }
  __device__ __forceinline__ int kidx(int t, int row) const { int i = i0 - 64 + 64 * t + row; i = i < 0 ? 0 : i; return i > L - 1 ? L - 1 : i; }
  __device__ __forceinline__ const bf16_t* kptr(int t, int row) const { return zs + (size_t)(kidx(t, row) * d + r) * ZW + kcol; }
  __device__ __forceinline__ const bf16_t* vptr(int t, int row) const { return zs + (size_t)(kidx(t, row) * d + r) * ZW + vcol; }
  __device__ __forceinline__ int ntiles() const { return 4; }
  __device__ __forceinline__ bool active(int t, int w) const { return w < 2 ? (t < 3) : (t >= 1); }
  __device__ __forceinline__ float score(int t, int w, int ql, int kl, float s) const {
    const int qi = i0 + 32 * w + ql, ki = i0 - 64 + 64 * t + kl; int rel = ki - qi; rel = rel < 0 ? -rel : rel;
    const bool valid = (rel <= 64) && (ki >= 0) && (ki < L);
    return valid ? s * (0.125f * LOG2E) - slope_l2 * (float)rel : -1e30f;
  }
  __device__ __forceinline__ void store_lse(int w, int ql, float v) const { lse[i0 + 32 * w + ql] = v; }
};
struct CtxC {
  bf16_t* zs; const float* rpb; int R, r0, rb, hc;
  __device__ __forceinline__ const bf16_t* qptr(int w, int ql) const { return zs + (size_t)((r0 + w) * 64 + ql) * ZW + hc; }
  __device__ __forceinline__ bf16_t* optr(int w, int ql) const { return zs + (size_t)((r0 + w) * 64 + ql) * ZW + hc; }
  __device__ __forceinline__ int krow(int t) const { const int kr = rb + t; return kr > R - 1 ? R - 1 : kr; }
  __device__ __forceinline__ const bf16_t* kptr(int t, int row) const { return zs + (size_t)(krow(t) * 64 + row) * ZW + 1024 + hc; }
  __device__ __forceinline__ const bf16_t* vptr(int t, int row) const { return zs + (size_t)(krow(t) * 64 + row) * ZW + 2048 + hc; }
  __device__ __forceinline__ int ntiles() const { return 11; }
  __device__ __forceinline__ int rstart(int r) const { int rs = r - 4; rs = rs < 0 ? 0 : rs; return rs > R - 8 ? R - 8 : rs; }
  __device__ __forceinline__ bool active(int t, int w) const { const int r = r0 + w, rs = rstart(r), kr = rb + t; return kr >= rs && kr < rs + 8; }
  __device__ __forceinline__ float score(int t, int w, int ql, int kl, float s) const {
    const int r = r0 + w, cq = ql, kr = rb + t;
    int cs = cq - 8; cs = cs < 0 ? 0 : cs; cs = cs > 48 ? 48 : cs;
    const bool valid = (kl >= cs) && (kl < cs + 16);
    const int idx = valid ? (kr - r + 7) * 31 + (kl - cq + 15) : 0;
    const float b = rpb[idx];
    return valid ? (s * 0.125f + b) * LOG2E : -1e30f;
  }
  __device__ __forceinline__ void store_lse(int, int, float) const {}
};
struct CtxX {
  bf16_t* qbase; const bf16_t* kv;
  __device__ __forceinline__ const bf16_t* qptr(int w, int ql) const { return qbase + (size_t)(16 * w + ql) * 1024; }
  __device__ __forceinline__ bf16_t* optr(int w, int ql) const { return qbase + (size_t)(16 * w + ql) * 1024; }
  __device__ __forceinline__ const bf16_t* kptr(int t, int row) const { return kv + (size_t)(32 * t + row) * 2048; }
  __device__ __forceinline__ const bf16_t* vptr(int t, int row) const { return kv + (size_t)(32 * t + row) * 2048 + 1024; }
  __device__ __forceinline__ int ntiles() const { return 8; }
  __device__ __forceinline__ bool active(int, int) const { return true; }
  __device__ __forceinline__ float score(int, int, int, int, float s) const { return s * (0.0625f * LOG2E); }
  __device__ __forceinline__ void store_lse(int, int, float) const {}
};

__device__ __forceinline__ void wt_tile(unsigned char* smem, const float* src, int K, int N, const float* gain, bf16_t* dst, int perm, int t) {
  float* tl = (float*)smem;
  const int nkt = K >> 6; const int rt = t / nkt, kt = t - rt * nkt; const int R0 = rt * 64, k0 = kt * 64;
  const int tid = get_tid(); const int rr = tid & 63;
  const int R = R0 + rr; int sc = R;
  if (perm) { const int T = R >> 8, within = R & 255, wc = within >> 7, n = (within & 127) >> 4, i = within & 15; sc = (n & 1) * DFF + 128 * T + 64 * wc + 16 * (n >> 1) + i; }
  __syncthreads();
#pragma unroll 4
  for (int i = 0; i < 16; ++i) {
    const int kk = (tid >> 6) + 4 * i;
    float v = src[(size_t)(k0 + kk) * N + sc];
    if (gain) v *= gain[k0 + kk];
    tl[kk * 65 + rr] = v;
  }
  __syncthreads();
  const int r2 = tid >> 2, kq = tid & 3;
  u32x4 w0, w1;
  w0.x = cvtpk(tl[(16 * kq + 0) * 65 + r2], tl[(16 * kq + 1) * 65 + r2]); w0.y = cvtpk(tl[(16 * kq + 2) * 65 + r2], tl[(16 * kq + 3) * 65 + r2]);
  w0.z = cvtpk(tl[(16 * kq + 4) * 65 + r2], tl[(16 * kq + 5) * 65 + r2]); w0.w = cvtpk(tl[(16 * kq + 6) * 65 + r2], tl[(16 * kq + 7) * 65 + r2]);
  w1.x = cvtpk(tl[(16 * kq + 8) * 65 + r2], tl[(16 * kq + 9) * 65 + r2]); w1.y = cvtpk(tl[(16 * kq + 10) * 65 + r2], tl[(16 * kq + 11) * 65 + r2]);
  w1.z = cvtpk(tl[(16 * kq + 12) * 65 + r2], tl[(16 * kq + 13) * 65 + r2]); w1.w = cvtpk(tl[(16 * kq + 14) * 65 + r2], tl[(16 * kq + 15) * 65 + r2]);
  bf16_t* dp = dst + ((size_t)((k0 + 16 * kq) >> 5) * N + (R0 + r2)) * 32 + ((16 * kq) & 31);
  *(u32x4*)dp = w0; *(u32x4*)(dp + 8) = w1;
}
__device__ __forceinline__ void wt_matrix(unsigned char* smem, const float* src, int K, int N, const float* gain, bf16_t* dst, int perm) {
  const int ntile = (K >> 6) * (N >> 6);
  for (int t = blockIdx.x; t < ntile; t += gridDim.x) wt_tile(smem, src, K, N, gain, dst, perm, t);
}

__device__ __forceinline__ void tile_seq(int tt, int& seqbase, int& qb, int& S) {
  if (tt < 256) { seqbase = (tt >> 4) * 2048; qb = tt & 15; S = 2048; }
  else { const int u = tt - 256; seqbase = NPROMPT + (u >> 7) * 16384; qb = u & 127; S = 16384; }
}

typedef const __attribute__((address_space(4))) Params* KParams;
__device__ __forceinline__ void run_phase(int ph, KParams kp, unsigned char* smem) {
  unsigned char* ws = kp->ws;
  bf16_t* Z = (bf16_t*)(ws + WS_Z);
  const int tid = get_tid();
  const int L = ph >= 10 ? 1 : 0;
  switch (ph) {
    case 0: {
      wt_matrix(smem, kp->w_in_ab, 1024, 3072, kp->g_mix, (bf16_t*)(ws + WS_WT_IN_AB), 0);
      wt_matrix(smem, kp->w_out_ab, 768, 1024, nullptr, (bf16_t*)(ws + WS_WT_OUT_AB), 0);
      wt_matrix(smem, kp->w_in_c, 1024, 3072, kp->g_mix + 1024, (bf16_t*)(ws + WS_WT_IN_C), 0);
      wt_matrix(smem, kp->w_out_c, 1024, 1024, nullptr, (bf16_t*)(ws + WS_WT_OUT_C), 0);
      for (int l = 0; l < 2; ++l) {
        wt_matrix(smem, kp->wq_x + (size_t)l * 1024 * 1024, 1024, 1024, kp->g_xattn + l * 1024, (bf16_t*)(ws + WS_WT_Q) + (size_t)l * 1024 * 1024, 0);
        wt_matrix(smem, kp->wkv_x + (size_t)l * 1024 * 2048, 1024, 2048, kp->g_mem + l * 1024, (bf16_t*)(ws + WS_WT_KV) + (size_t)l * 2048 * 1024, 0);
        wt_matrix(smem, kp->wo_x + (size_t)l * 1024 * 1024, 1024, 1024, nullptr, (bf16_t*)(ws + WS_WT_O) + (size_t)l * 1024 * 1024, 0);
        wt_matrix(smem, kp->w_gu + (size_t)l * 1024 * 5632, 1024, 5632, kp->g_ffn + l * 1024, (bf16_t*)(ws + WS_WT_GU) + (size_t)l * 5632 * 1024, 1);
        wt_matrix(smem, kp->w_down + (size_t)l * DFF * 1024, DFF, 1024, nullptr, (bf16_t*)(ws + WS_WT_DOWN) + (size_t)l * 1024 * DFF, 0);
      }
      const int gi = blockIdx.x * 256 + tid;
      if (gi < 4096) {
        const int pos = gi >> 4, f = gi & 15;
        const float inv_freq = exp2f(-(float)f * 0.83048202372184058696f);
        const float ang = (float)pos * inv_freq;
        float2 cs; cs.x = cosf(ang); cs.y = sinf(ang);
        ((float2*)(ws + WS_ROPE))[gi] = cs;
      }
    } break;
    case 1: {
      const int n_ab = 512 * 12, n_kv = 36 * 8;
      for (int t = blockIdx.x; t < n_ab + 2 * n_kv; t += gridDim.x) {
        if (t < n_ab) {
          int mt, nt; tile_map(t, 12, gridDim.x, mt, nt);
          EpiInAB e{Z, kp->g_qn, kp->g_kn, (const float2*)(ws + WS_ROPE)};
          gemm_tile<true>(smem, xin_row(kp->x_prompt, kp->x_sample, mt * 128), 1024, (const bf16_t*)(ws + WS_WT_IN_AB), 3072, 1024, e, mt * 128, nt * 256);
        } else {
          int u = t - n_ab; const int l = u / n_kv; u -= l * n_kv; const int mt = u >> 3, nt = u & 7;
          EpiStore<true> e{(bf16_t*)(ws + WS_KVMEM) + (size_t)l * 4608 * 2048, 2048};
          gemm_tile<true>(smem, mem_row(kp->mem_prompt, kp->mem_sample, mt * 128), 1024, (const bf16_t*)(ws + WS_WT_KV) + (size_t)l * 2048 * 1024, 2048, 1024, e, mt * 128, nt * 256);
        }
      }
    } break;
    case 2: {
      for (int it = blockIdx.x; it < 2048 + 6144; it += gridDim.x) {
        if (it < 2048) {
          int seqbase, qi, h, nt;
          if (gridDim.x == 512) {
            const int bid = blockIdx.x, i = it >> 9, xcd = bid & 7, l = (bid >> 3) + 64 * (i & 1);
            if (it < 1024) { const int g = xcd >> 1, id = l * 2 + (xcd & 1); qi = id >> 2; h = (g & 1) * 4 + (id & 3); seqbase = NPROMPT + (g >> 1) * 16384; nt = 256; }
            else { const int grp = xcd + 8 * (l >> 5), id = l & 31; qi = id >> 2; h = (grp & 1) * 4 + (id & 3); seqbase = (grp >> 1) * 2048; nt = 32; }
          } else if (it < 1024) { const int s = it >> 9, rem = it & 511; qi = rem >> 3; h = rem & 7; seqbase = NPROMPT + s * 16384; nt = 256; }
          else { const int a = it - 1024; const int s = a >> 6, rem = a & 63; qi = rem >> 3; h = rem & 7; seqbase = s * 2048; nt = 32; }
          CtxA c{Z + (size_t)(seqbase + 256 * qi) * ZW + h * 64, Z + (size_t)seqbase * ZW + 512 + (h >> 2) * 64, nt};
          attn_item<64, 64, 4, true>(smem, c);
        } else {
          const int b = it - 2048; const int h = b & 3, g = (b >> 2) % 3, tt = b / 12;
          int seqbase, qb, S; tile_seq(tt, seqbase, qb, S);
          const int d = g == 0 ? 1 : (g == 1 ? 4 : 16);
          const int Ls = S / d, nb = Ls >> 7; const int r = qb / nb, mblk = qb - r * nb;
          const float slope = exp2f(-8.0f * (float)(4 * g + h + 1) / 12.0f);
          CtxB c{Z + (size_t)seqbase * ZW, (float*)(ws + WS_LSE) + (size_t)(g * 4 + h) * NTOK + seqbase + r * Ls, d, r, Ls, mblk * 128,
                 768 + ((0 * 3 + g) * 4 + h) * 64, 768 + ((1 * 3 + g) * 4 + h) * 64, 768 + ((2 * 3 + g) * 4 + h) * 64, slope * (float)d * LOG2E};
          attn_item<64, 64, 2, true>(smem, c);
        }
      }
    } break;
    case 3: {
      const float* lse = (const float*)(ws + WS_LSE);
      for (int i = blockIdx.x * 256 + tid; i < NTOK * 32; i += gridDim.x * 256) {
        const int T = i >> 5, h = (i >> 3) & 3, c8 = i & 7;
        int sb, pos, lg;
        if (T < NPROMPT) { sb = T & ~2047; pos = T & 2047; lg = 11; } else { sb = NPROMPT + ((T - NPROMPT) & ~16383); pos = (T - NPROMPT) & 16383; lg = 14; }
        const float l0 = ld_agent_f32(lse + (size_t)(0 * 4 + h) * NTOK + sb + pos);
        const float l1 = ld_agent_f32(lse + (size_t)(1 * 4 + h) * NTOK + sb + ((pos & 3) << (lg - 2)) + (pos >> 2));
        const float l2 = ld_agent_f32(lse + (size_t)(2 * 4 + h) * NTOK + sb + ((pos & 15) << (lg - 4)) + (pos >> 4));
        const float mx = fmaxf(l0, fmaxf(l1, l2));
        float w0 = __builtin_amdgcn_exp2f(l0 - mx), w1 = __builtin_amdgcn_exp2f(l1 - mx), w2 = __builtin_amdgcn_exp2f(l2 - mx);
        const float inv = 1.0f / (w0 + w1 + w2); w0 *= inv; w1 *= inv; w2 *= inv;
        const bf16_t* zr = Z + (size_t)T * ZW;
        const u32x4 a = ld_agent_u32x4(zr + 768 + (0 * 4 + h) * 64 + c8 * 8), b = ld_agent_u32x4(zr + 768 + (1 * 4 + h) * 64 + c8 * 8), cc = ld_agent_u32x4(zr + 768 + (2 * 4 + h) * 64 + c8 * 8);
        u32x4 o;
#pragma unroll
        for (int k = 0; k < 4; ++k) {
          const float lo = w0 * bf2f((unsigned short)(a[k] & 0xffff)) + w1 * bf2f((unsigned short)(b[k] & 0xffff)) + w2 * bf2f((unsigned short)(cc[k] & 0xffff));
          const float hi = w0 * bf2f((unsigned short)(a[k] >> 16)) + w1 * bf2f((unsigned short)(b[k] >> 16)) + w2 * bf2f((unsigned short)(cc[k] >> 16));
          o[k] = cvtpk(lo, hi);
        }
        *(u32x4*)(Z + (size_t)T * ZW + 512 + h * 64 + c8 * 8) = o;
      }
    } break;
    case 4: case 7: case 9: case 12: case 15: case 17: {
      const bf16_t* A; int lda, K; const bf16_t* Bt;
      if (ph == 4) { A = Z; lda = ZW; K = 768; Bt = (const bf16_t*)(ws + WS_WT_OUT_AB); }
      else if (ph == 12) { A = Z; lda = ZW; K = 1024; Bt = (const bf16_t*)(ws + WS_WT_OUT_C); }
      else if (ph == 7 || ph == 15) { A = Z; lda = 1024; K = 1024; Bt = (const bf16_t*)(ws + WS_WT_O) + (size_t)L * 1024 * 1024; }
      else { A = Z; lda = DFF; K = DFF; Bt = (const bf16_t*)(ws + WS_WT_DOWN) + (size_t)L * 1024 * DFF; }
      for (int t = blockIdx.x; t < 512 * 4; t += gridDim.x) {
        int mt, nt; tile_map(t, 4, gridDim.x, mt, nt);
        EpiResid e{ph == 4 ? xin_row(kp->x_prompt, kp->x_sample, mt * 128) : kp->out + (size_t)mt * 128 * 1024, kp->out};
        gemm_tile<false>(smem, A + (size_t)mt * 128 * lda, lda, Bt, 1024, K, e, mt * 128, nt * 256);
      }
    } break;
    case 5: case 10: case 13: {
      const bf16_t* Bt; int NT, ldc;
      if (ph == 10) { Bt = (const bf16_t*)(ws + WS_WT_IN_C); NT = 12; ldc = ZW; }
      else { Bt = (const bf16_t*)(ws + WS_WT_Q) + (size_t)L * 1024 * 1024; NT = 4; ldc = 1024; }
      for (int t = blockIdx.x; t < 512 * NT; t += gridDim.x) {
        int mt, nt; tile_map(t, NT, gridDim.x, mt, nt);
        EpiStore<true> e{Z, ldc};
        gemm_tile<true>(smem, kp->out + (size_t)mt * 128 * 1024, 1024, Bt, NT * 256, 1024, e, mt * 128, nt * 256);
      }
    } break;
    case 6: case 14: {
      const bf16_t* kvm = (const bf16_t*)(ws + WS_KVMEM) + (size_t)L * 4608 * 2048;
      for (int it = blockIdx.x; it < 4096; it += gridDim.x) {
        int idx = it; if (gridDim.x == 512) idx = (blockIdx.x & 7) * 512 + (blockIdx.x >> 3) + 64 * (it >> 9);
        const int h = idx & 3, tile = idx >> 2, T0 = tile * 64;
        const int bidx = T0 < NPROMPT ? (T0 >> 11) : 16 + ((T0 - NPROMPT) >> 14);
        CtxX c{Z + (size_t)T0 * 1024 + h * 256, kvm + (size_t)bidx * 256 * 2048 + h * 256};
        attn_item<256, 32, 1, true>(smem, c);
      }
    } break;
    case 8: case 16: {
      const bf16_t* Bt = (const bf16_t*)(ws + WS_WT_GU) + (size_t)L * 5632 * 1024;
      for (int t = blockIdx.x; t < 512 * 22; t += gridDim.x) {
        int mt, nt; tile_map(t, 22, gridDim.x, mt, nt);
        EpiSwiGLU e{Z};
        gemm_tile<true>(smem, kp->out + (size_t)mt * 128 * 1024, 1024, Bt, 5632, 1024, e, mt * 128, nt * 256);
      }
    } break;
    case 11: {
      float* srpb = (float*)(smem + 2 * 64 * 72 * 2);
      for (int it = blockIdx.x; it < 4096; it += gridDim.x) {
        int h = it & 15, t4 = it >> 4;
        if (gridDim.x == 512) { const int l = (blockIdx.x >> 3) + 64 * (it >> 9); h = 2 * (blockIdx.x & 7) + (l & 1); t4 = l >> 1; }
        int seqbase, rq, R;
        if (t4 < 128) { seqbase = (t4 >> 3) * 2048; rq = t4 & 7; R = 32; } else { const int u = t4 - 128; seqbase = NPROMPT + (u >> 6) * 16384; rq = u & 63; R = 256; }
        const int r0 = 4 * rq;
        int rb = r0 - 4; rb = rb < 0 ? 0 : rb; rb = rb > R - 8 ? R - 8 : rb;
        __syncthreads();
        for (int i = tid; i < 15 * 31; i += 256) srpb[i] = kp->rpb_c[h * 15 * 31 + i];
        CtxC c{Z + (size_t)seqbase * ZW, srpb, R, r0, rb, h * 64};
        attn_item<64, 64, 4, true>(smem, c);
      }
    } break;
    case 18: {
      const int lane = tid & 63, wv = blockIdx.x * 4 + (tid >> 6), nwv = gridDim.x * 4;
      for (int row = wv; row < NTOK; row += nwv) {
        float* xr = kp->out + (size_t)row * 1024;
        f32x4 v[4]; float s = 0.f;
#pragma unroll
        for (int i = 0; i < 4; ++i) { v[i] = ld_agent_f32x4(xr + i * 256 + lane * 4); s += v[i][0] * v[i][0] + v[i][1] * v[i][1] + v[i][2] * v[i][2] + v[i][3] * v[i][3]; }
        s += __shfl_xor(s, 1); s += __shfl_xor(s, 2); s += __shfl_xor(s, 4); s += __shfl_xor(s, 8); s += __shfl_xor(s, 16); s += __shfl_xor(s, 32);
        const float r = rsqrtf(s * (1.0f / 1024.0f) + EPS);
#pragma unroll
        for (int i = 0; i < 4; ++i) { const f32x4 g = *(const f32x4*)(kp->g_final + i * 256 + lane * 4); *(f32x4*)(xr + i * 256 + lane * 4) = v[i] * r * g; }
      }
    } break;
    default: break;
  }
}

constexpr int NPHASE = 19;

template <bool COOP>
__global__ void __launch_bounds__(256, 2) mega(Params p) {
  __shared__ __attribute__((aligned(16))) unsigned char smem[SMEM_BYTES];
  if constexpr (COOP) {
    cg::grid_group grid = cg::this_grid();
#define STEP(PH) { KParams kp = (KParams)__builtin_amdgcn_kernarg_segment_ptr(); asm volatile("" : "+s"(kp)); run_phase(PH, kp, smem); if (PH + 1 < NPHASE) grid.sync(); }
    STEP(0) STEP(1) STEP(2) STEP(3) STEP(4) STEP(5) STEP(6) STEP(7) STEP(8) STEP(9)
    STEP(10) STEP(11) STEP(12) STEP(13) STEP(14) STEP(15) STEP(16) STEP(17) STEP(18)
#undef STEP
  } else {
    for (int ph = p.phase_lo; ph < p.phase_hi; ++ph) {
      KParams kp = (KParams)__builtin_amdgcn_kernarg_segment_ptr();
      asm volatile("" : "+s"(kp));
      run_phase(ph, kp, smem);
    }
  }
}

extern "C" void kernel_launch(void* const* d_in, const int* in_sizes, int n_in, void* d_out, int out_size, void* d_ws, size_t ws_size, hipStream_t stream) {
  static int grid = 0;
  if (grid == 0) {
    if (n_in != 21 || ws_size < WS_END) { fprintf(stderr, "kernel_launch: n_in %d ws %zu (need %zu)\n", n_in, ws_size, (size_t)WS_END); grid = -1; return; }
    int dev = 0, cus = 0, per_cu = 0;
    hipGetDevice(&dev);
    hipDeviceGetAttribute(&cus, hipDeviceAttributeMultiprocessorCount, dev);
#if MULTI_LAUNCH
    hipOccupancyMaxActiveBlocksPerMultiprocessor(&per_cu, (const void*)mega<false>, 256, 0);
#else
    hipOccupancyMaxActiveBlocksPerMultiprocessor(&per_cu, (const void*)mega<true>, 256, 0);
#endif
    if (per_cu < 1) per_cu = 1;
    if (per_cu > 2) per_cu = 2;
    grid = cus * per_cu;
  }
  if (grid < 0) return;
  Params p{};
  p.x_prompt = (const float*)d_in[0]; p.x_sample = (const float*)d_in[1]; p.mem_prompt = (const float*)d_in[2]; p.mem_sample = (const float*)d_in[3];
  p.g_mix = (const float*)d_in[4]; p.w_in_ab = (const float*)d_in[5]; p.g_qn = (const float*)d_in[6]; p.g_kn = (const float*)d_in[7]; p.w_out_ab = (const float*)d_in[8];
  p.w_in_c = (const float*)d_in[9]; p.rpb_c = (const float*)d_in[10]; p.w_out_c = (const float*)d_in[11]; p.g_xattn = (const float*)d_in[12]; p.g_mem = (const float*)d_in[13];
  p.wq_x = (const float*)d_in[14]; p.wkv_x = (const float*)d_in[15]; p.wo_x = (const float*)d_in[16]; p.g_ffn = (const float*)d_in[17]; p.w_gu = (const float*)d_in[18]; p.w_down = (const float*)d_in[19];
  p.g_final = (const float*)d_in[20];
  p.out = (float*)d_out; p.ws = (unsigned char*)d_ws;
#if MULTI_LAUNCH
  for (int ph = 0; ph < NPHASE; ++ph) {
    p.phase_lo = ph; p.phase_hi = ph + 1;
    hipLaunchKernelGGL(mega<false>, dim3(grid), dim3(256), 0, stream, p);
  }
#else
  p.phase_lo = 0; p.phase_hi = NPHASE;
  void* args[] = {&p};
  hipError_t e = hipLaunchCooperativeKernel((const void*)mega<true>, dim3(grid), dim3(256), args, 0, stream);
  if (e != hipSuccess) fprintf(stderr, "cooperative launch failed: %s (grid %d)\n", hipGetErrorString(e), grid);
#endif
}
#ifdef DBG_RES
template <int PH> __global__ void __launch_bounds__(256, 2) mega_one(Params p) {
  __shared__ __attribute__((aligned(16))) unsigned char smem[SMEM_BYTES];
  run_phase(PH, (KParams)__builtin_amdgcn_kernarg_segment_ptr(), smem);
}
template __global__ void mega_one<0>(Params); template __global__ void mega_one<1>(Params); template __global__ void mega_one<2>(Params);
template __global__ void mega_one<3>(Params); template __global__ void mega_one<4>(Params); template __global__ void mega_one<5>(Params);
template __global__ void mega_one<6>(Params); template __global__ void mega_one<8>(Params); template __global__ void mega_one<11>(Params);
template __global__ void mega_one<18>(Params);
#endif
```

```cpp
#include <hip/hip_runtime.h>
#include <hip/hip_cooperative_groups.h>
#include <cstdint>
#include <cstdio>
namespace cg = cooperative_groups;

#ifndef MULTI_LAUNCH
#define MULTI_LAUNCH 0
#endif

typedef unsigned short bf16_t;
typedef short bf16x8 __attribute__((ext_vector_type(8)));
typedef short s16x4 __attribute__((ext_vector_type(4)));
typedef short v4i16_t __attribute__((ext_vector_type(4)));
typedef float f32x4 __attribute__((ext_vector_type(4)));
typedef float f32x2_t __attribute__((ext_vector_type(2)));
typedef __bf16 bf16x2_t __attribute__((ext_vector_type(2)));
typedef unsigned u32x4 __attribute__((ext_vector_type(4)));
typedef unsigned u32x2 __attribute__((ext_vector_type(2)));

#define LOG2E 1.4426950408889634f
constexpr int NTOK = 65536;
constexpr int NPROMPT = 32768;
constexpr int ZW = 3072;
constexpr int DFF = 2816;
constexpr float EPS = 1e-6f;

constexpr size_t WS_WT_IN_AB = 0;
constexpr size_t WS_WT_OUT_AB = WS_WT_IN_AB + (size_t)3072 * 1024 * 2;
constexpr size_t WS_WT_IN_C = WS_WT_OUT_AB + (size_t)1024 * 768 * 2;
constexpr size_t WS_WT_OUT_C = WS_WT_IN_C + (size_t)3072 * 1024 * 2;
constexpr size_t WS_WT_Q = WS_WT_OUT_C + (size_t)1024 * 1024 * 2;
constexpr size_t WS_WT_KV = WS_WT_Q + (size_t)2 * 1024 * 1024 * 2;
constexpr size_t WS_WT_O = WS_WT_KV + (size_t)2 * 2048 * 1024 * 2;
constexpr size_t WS_WT_GU = WS_WT_O + (size_t)2 * 1024 * 1024 * 2;
constexpr size_t WS_WT_DOWN = WS_WT_GU + (size_t)2 * 5632 * 1024 * 2;
constexpr size_t WS_KVMEM = WS_WT_DOWN + (size_t)2 * 1024 * 2816 * 2;
constexpr size_t WS_LSE = WS_KVMEM + (size_t)2 * 4608 * 2048 * 2;
constexpr size_t WS_ROPE = WS_LSE + (size_t)3 * 65536 * 4 * 4;
constexpr size_t WS_Z = WS_ROPE + (size_t)256 * 16 * 8;
constexpr size_t WS_END = WS_Z + (size_t)NTOK * ZW * 2;

constexpr int SMEM_BYTES = 2 * (128 + 256) * 40 * 2 + 512;

struct Params {
  const float* x_prompt; const float* x_sample; const float* mem_prompt; const float* mem_sample;
  const float* g_mix; const float* w_in_ab; const float* g_qn; const float* g_kn; const float* w_out_ab;
  const float* w_in_c; const float* rpb_c; const float* w_out_c; const float* g_xattn; const float* g_mem;
  const float* wq_x; const float* wkv_x; const float* wo_x; const float* g_ffn; const float* w_gu; const float* w_down;
  const float* g_final;
  float* out; unsigned char* ws;
  int phase_lo, phase_hi;
};

__device__ __forceinline__ int get_tid() { int t = threadIdx.x; asm volatile("" : "+v"(t)); return t; }
__device__ __forceinline__ unsigned cvtpk(float lo, float hi) { f32x2_t v = {lo, hi}; bf16x2_t b = __builtin_convertvector(v, bf16x2_t); return __builtin_bit_cast(unsigned, b); }
__device__ __forceinline__ float bf2f(unsigned short h) { return __uint_as_float(((unsigned)h) << 16); }
__device__ __forceinline__ s16x4 tr_read(const bf16_t* p) {
  return __builtin_bit_cast(s16x4, __builtin_amdgcn_ds_read_tr16_b64_v4i16((__attribute__((address_space(3))) v4i16_t*)p));
}
__device__ __forceinline__ const float* xin_row(const float* xp, const float* xs, int row) {
  return row < NPROMPT ? xp + (size_t)row * 1024 : xs + (size_t)(row - NPROMPT) * 1024;
}
__device__ __forceinline__ const float* mem_row(const float* mp, const float* ms, int row) {
  return row < 4096 ? mp + (size_t)row * 1024 : ms + (size_t)(row - 4096) * 1024;
}


__device__ __forceinline__ void ld16_sc1(u32x4& v, const void* p) { asm volatile("global_load_dwordx4 %0, %1, off sc1" : "=v"(v) : "v"(p) : "memory"); }
__device__ __forceinline__ void ld16_sc1(f32x4& v, const float* p) { asm volatile("global_load_dwordx4 %0, %1, off sc1" : "=v"(v) : "v"(p) : "memory"); }
__device__ __forceinline__ u32x4 ld_agent_u32x4(const void* p) {
  const unsigned long long a = __hip_atomic_load((const unsigned long long*)p, __ATOMIC_RELAXED, __HIP_MEMORY_SCOPE_AGENT);
  const unsigned long long b = __hip_atomic_load((const unsigned long long*)p + 1, __ATOMIC_RELAXED, __HIP_MEMORY_SCOPE_AGENT);
  return (u32x4){(unsigned)a, (unsigned)(a >> 32), (unsigned)b, (unsigned)(b >> 32)};
}
__device__ __forceinline__ float ld_agent_f32(const float* p) { return __uint_as_float(__hip_atomic_load((const unsigned*)p, __ATOMIC_RELAXED, __HIP_MEMORY_SCOPE_AGENT)); }
__device__ __forceinline__ f32x4 ld_agent_f32x4(const float* p) {
  const unsigned long long a = __hip_atomic_load((const unsigned long long*)p, __ATOMIC_RELAXED, __HIP_MEMORY_SCOPE_AGENT);
  const unsigned long long b = __hip_atomic_load((const unsigned long long*)p + 1, __ATOMIC_RELAXED, __HIP_MEMORY_SCOPE_AGENT);
  f32x4 v; v[0] = __uint_as_float((unsigned)a); v[1] = __uint_as_float((unsigned)(a >> 32)); v[2] = __uint_as_float((unsigned)b); v[3] = __uint_as_float((unsigned)(b >> 32)); return v;
}
__device__ __forceinline__ void tile_map(int t, int NT, int gdim, int& mt, int& nt) {
  if ((gdim & 7) == 0) { const int i = t / gdim, b = t - i * gdim; const int lt = (b >> 3) + (gdim >> 3) * i; const int ml = lt / NT; nt = lt - ml * NT; mt = (b & 7) + 8 * ml; }
  else { mt = t / NT; nt = t - mt * NT; }
}
constexpr int GLD = 40;
constexpr int G_STAGE = (128 + 256) * GLD;
template <bool AF32, class Epi>
__device__ __forceinline__ void gemm_tile(unsigned char* smem, const void* Ap, int lda, const bf16_t* WT, int N, int K, const Epi& epi, int m0, int n0) {
  const int tid = get_tid(), lane = tid & 63;
  const int wid = __builtin_amdgcn_readfirstlane(tid >> 6);
  const int wr = wid >> 1, wc = wid & 1, l15 = lane & 15, quad = lane >> 4;
  bf16_t* sbase = (bf16_t*)smem; float* sR = (float*)(smem + 2 * G_STAGE * 2);
  f32x4 acc[4][8];
#pragma unroll
  for (int m = 0; m < 4; ++m)
#pragma unroll
    for (int n = 0; n < 8; ++n) acc[m][n] = (f32x4){0.f, 0.f, 0.f, 0.f};
  float ss[4];
#pragma unroll
  for (int i = 0; i < 4; ++i) ss[i] = 0.f;
  f32x4 ra[4]; u32x4 rab[2]; u32x4 rb[4];
  const int nk = K >> 5;
  const float* Af = (const float*)Ap + (size_t)(tid >> 3) * lda + (tid & 7) * 4;
  const bf16_t* Ab = (const bf16_t*)Ap + (size_t)(tid >> 2) * lda + (tid & 3) * 8;
  const bf16_t* Bp = WT + (size_t)n0 * 32 + tid * 8;
  const size_t bstep = (size_t)N * 32;
  const int awf = (tid >> 3) * GLD + (tid & 7) * 4;
  const int awb = (tid >> 2) * GLD + (tid & 3) * 8;
#define G_LOAD(kt_) do { \
    if constexpr (AF32) { _Pragma("unroll") for (int i = 0; i < 4; ++i) ld16_sc1(ra[i], Af + (size_t)i * 32 * lda + (kt_) * 32); } \
    else { _Pragma("unroll") for (int i = 0; i < 2; ++i) ld16_sc1(rab[i], Ab + (size_t)i * 64 * lda + (kt_) * 32); } \
    _Pragma("unroll") for (int i = 0; i < 4; ++i) ld16_sc1(rb[i], Bp + (size_t)(kt_) * bstep + i * 2048); } while (0)
#define G_STORE(st_) do { bf16_t* sa_ = sbase + (st_) * G_STAGE; bf16_t* sb_ = sa_ + 128 * GLD; \
    if constexpr (AF32) { asm volatile("s_waitcnt vmcnt(0)" : "+v"(ra[0]), "+v"(ra[1]), "+v"(ra[2]), "+v"(ra[3]), "+v"(rb[0]), "+v"(rb[1]), "+v"(rb[2]), "+v"(rb[3]) :: "memory"); \
      _Pragma("unroll") for (int i = 0; i < 4; ++i) { const f32x4 v = ra[i]; \
        ss[i] += v[0] * v[0] + v[1] * v[1] + v[2] * v[2] + v[3] * v[3]; \
        u32x2 w; w.x = cvtpk(v[0], v[1]); w.y = cvtpk(v[2], v[3]); *(u32x2*)(sa_ + awf + i * 32 * GLD) = w; } } \
    else { asm volatile("s_waitcnt vmcnt(0)" : "+v"(rab[0]), "+v"(rab[1]), "+v"(rb[0]), "+v"(rb[1]), "+v"(rb[2]), "+v"(rb[3]) :: "memory"); \
      _Pragma("unroll") for (int i = 0; i < 2; ++i) *(u32x4*)(sa_ + awb + i * 64 * GLD) = rab[i]; } \
    _Pragma("unroll") for (int i = 0; i < 4; ++i) *(u32x4*)(sb_ + awb + i * 64 * GLD) = rb[i]; } while (0)
  G_LOAD(0);
  G_STORE(0);
  if (nk > 1) G_LOAD(1);
  __syncthreads();
  for (int kt = 0; kt < nk; ++kt) {
    const int cur = kt & 1;
    if (kt + 1 < nk) G_STORE(cur ^ 1);
    if (kt + 2 < nk) G_LOAD(kt + 2);
    const bf16_t* a_s = sbase + cur * G_STAGE + (wr * 64 + l15) * GLD + quad * 8;
    const bf16_t* b_s = sbase + cur * G_STAGE + 128 * GLD + (wc * 128 + l15) * GLD + quad * 8;
    __builtin_amdgcn_s_setprio(1);
    bf16x8 af[4];
#pragma unroll
    for (int m = 0; m < 4; ++m) af[m] = *(const bf16x8*)(a_s + m * 16 * GLD);
#pragma unroll
    for (int nh = 0; nh < 4; ++nh) {
      bf16x8 bfr[2];
#pragma unroll
      for (int n2 = 0; n2 < 2; ++n2) bfr[n2] = *(const bf16x8*)(b_s + (nh * 2 + n2) * 16 * GLD);
#pragma unroll
      for (int m = 0; m < 4; ++m)
#pragma unroll
        for (int n2 = 0; n2 < 2; ++n2) acc[m][nh * 2 + n2] = __builtin_amdgcn_mfma_f32_16x16x32_bf16(bfr[n2], af[m], acc[m][nh * 2 + n2], 0, 0, 0);
    }
    __builtin_amdgcn_s_setprio(0);
    __syncthreads();
  }
#undef G_LOAD
#undef G_STORE
  if constexpr (AF32) {
    const float invK = 1.0f / (float)K;
#pragma unroll
    for (int i = 0; i < 4; ++i) {
      float s = ss[i];
      s += __shfl_xor(s, 1); s += __shfl_xor(s, 2); s += __shfl_xor(s, 4);
      if ((tid & 7) == 0) sR[(tid >> 3) + 32 * i] = rsqrtf(s * invK + EPS);
    }
    __syncthreads();
  }
  epi(acc, m0, wr * 64, n0 + wc * 128, l15, quad, sR);
}

template <bool RS> struct EpiStore {
  bf16_t* C; int ldc;
  __device__ __forceinline__ void operator()(f32x4 (&acc)[4][8], int m0, int rl0, int cb, int l15, int quad, const float* sR) const {
#pragma unroll
    for (int m = 0; m < 4; ++m) {
      const int rl = rl0 + 16 * m + l15; const float rs = RS ? sR[rl] : 1.f;
      bf16_t* rp = C + (size_t)(m0 + rl) * ldc + cb + 4 * quad;
#pragma unroll
      for (int n = 0; n < 8; ++n) { const f32x4 v = acc[m][n] * rs; u32x2 w; w.x = cvtpk(v[0], v[1]); w.y = cvtpk(v[2], v[3]); *(u32x2*)(rp + 16 * n) = w; }
    }
  }
};
struct EpiInAB {
  bf16_t* Z; const float* gq; const float* gk; const float2* rope;
  __device__ __forceinline__ void operator()(f32x4 (&acc)[4][8], int m0, int rl0, int cb0, int l15, int quad, const float* sR) const {
#pragma unroll
    for (int hh = 0; hh < 2; ++hh) {
      const int cb = cb0 + 64 * hh;
      if (cb >= 640) {
#pragma unroll
        for (int m = 0; m < 4; ++m) {
          const int rl = rl0 + 16 * m + l15; const float rs = sR[rl];
          bf16_t* rp = Z + (size_t)(m0 + rl) * ZW + cb + 4 * quad;
#pragma unroll
          for (int n = 0; n < 4; ++n) { const f32x4 v = acc[m][4 * hh + n] * rs; u32x2 w; w.x = cvtpk(v[0], v[1]); w.y = cvtpk(v[2], v[3]); *(u32x2*)(rp + 16 * n) = w; }
        }
      } else {
        const float* g = cb < 512 ? gq : gk;
        const float qs = cb < 512 ? 0.125f * LOG2E : 1.0f;
        f32x4 gv[4];
#pragma unroll
        for (int n = 0; n < 4; ++n) gv[n] = *(const f32x4*)(g + 16 * n + 4 * quad) * qs;
#pragma unroll
        for (int m = 0; m < 4; ++m) {
          const int rl = rl0 + 16 * m + l15; const int row = m0 + rl; const float rs = sR[rl];
          f32x4 z[4]; float s2 = 0.f;
#pragma unroll
          for (int n = 0; n < 4; ++n) { z[n] = acc[m][4 * hh + n] * rs; s2 += z[n][0] * z[n][0] + z[n][1] * z[n][1] + z[n][2] * z[n][2] + z[n][3] * z[n][3]; }
          s2 += __shfl_xor(s2, 16); s2 += __shfl_xor(s2, 32);
          const float r = rsqrtf(s2 * (1.0f / 64.0f) + EPS);
          const int pos = row < NPROMPT ? (row & 2047) : (row & 16383);
          const int gr = pos >> 6, gc = pos & 63;
          bf16_t* rp = Z + (size_t)row * ZW + cb + 4 * quad;
#pragma unroll
          for (int n = 0; n < 4; ++n) {
            const int ap = (n < 2) ? gr : gc;
            const f32x4 zn = z[n] * r * gv[n];
            float2 c0, c1; { const unsigned long long w0 = __hip_atomic_load((const unsigned long long*)(rope + ap * 16 + ((8 * n + 2 * quad) & 15)), __ATOMIC_RELAXED, __HIP_MEMORY_SCOPE_AGENT), w1 = __hip_atomic_load((const unsigned long long*)(rope + ap * 16 + ((8 * n + 2 * quad + 1) & 15)), __ATOMIC_RELAXED, __HIP_MEMORY_SCOPE_AGENT); c0.x = __uint_as_float((unsigned)w0); c0.y = __uint_as_float((unsigned)(w0 >> 32)); c1.x = __uint_as_float((unsigned)w1); c1.y = __uint_as_float((unsigned)(w1 >> 32)); }
            const float o0 = zn[0] * c0.x - zn[1] * c0.y, o1 = zn[0] * c0.y + zn[1] * c0.x;
            const float o2 = zn[2] * c1.x - zn[3] * c1.y, o3 = zn[2] * c1.y + zn[3] * c1.x;
            u32x2 w; w.x = cvtpk(o0, o1); w.y = cvtpk(o2, o3); *(u32x2*)(rp + 16 * n) = w;
          }
        }
      }
    }
  }
};
struct EpiResid {
  const float* src_tile; float* dst;
  __device__ __forceinline__ void operator()(f32x4 (&acc)[4][8], int m0, int rl0, int cb, int l15, int quad, const float* sR) const {
#pragma unroll
    for (int m = 0; m < 4; ++m) {
      const int rl = rl0 + 16 * m + l15;
      const float* sp = src_tile + (size_t)rl * 1024 + cb + 4 * quad; float* dp = dst + (size_t)(m0 + rl) * 1024 + cb + 4 * quad;
#pragma unroll
      for (int n = 0; n < 8; ++n) { const f32x4 x = ld_agent_f32x4(sp + 16 * n); *(f32x4*)(dp + 16 * n) = x + acc[m][n]; }
    }
  }
};
struct EpiSwiGLU {
  bf16_t* H;
  __device__ __forceinline__ void operator()(f32x4 (&acc)[4][8], int m0, int rl0, int cb, int l15, int quad, const float* sR) const {
    const int hc0 = (cb >> 8) * 128 + ((cb >> 7) & 1) * 64 + 4 * quad;
#pragma unroll
    for (int m = 0; m < 4; ++m) {
      const int rl = rl0 + 16 * m + l15; const float rs = sR[rl];
      bf16_t* rp = H + (size_t)(m0 + rl) * DFF + hc0;
#pragma unroll
      for (int pp = 0; pp < 4; ++pp) {
        const f32x4 g = acc[m][2 * pp] * rs, u = acc[m][2 * pp + 1] * rs; float h[4];
#pragma unroll
        for (int j = 0; j < 4; ++j) h[j] = g[j] / (1.0f + __expf(-g[j])) * u[j];
        u32x2 w; w.x = cvtpk(h[0], h[1]); w.y = cvtpk(h[2], h[3]); *(u32x2*)(rp + 16 * pp) = w;
      }
    }
  }
};

template <int DH, int KT, int NQT, bool PF, class Ctx>
__device__ __forceinline__ void attn_item(unsigned char* smem, const Ctx& c) {
  constexpr int LDK = DH + 8, CH = DH / 8, NCH = KT * CH / 256, NKS = DH / 32, NK4 = KT / 16, NKK = KT / 32, NDT = DH / 16;
  bf16_t* sK = (bf16_t*)smem; bf16_t* sV = sK + KT * LDK;
  const int tid = get_tid(), lane = tid & 63;
  const int wid = __builtin_amdgcn_readfirstlane(tid >> 6);
  const int l15 = lane & 15, quad = lane >> 4;
  bf16x8 qf[NQT][NKS];
#pragma unroll
  for (int qt = 0; qt < NQT; ++qt) {
    const bf16_t* qp = c.qptr(wid, qt * 16 + l15);
#pragma unroll
    for (int ks = 0; ks < NKS; ++ks) qf[qt][ks] = __builtin_bit_cast(bf16x8, ld_agent_u32x4(qp + ks * 32 + quad * 8));
  }
  f32x4 o[NQT][NDT];
  float mrow[NQT], lrow[NQT];
#pragma unroll
  for (int qt = 0; qt < NQT; ++qt) {
    mrow[qt] = -1e30f; lrow[qt] = 0.f;
#pragma unroll
    for (int dt = 0; dt < NDT; ++dt) o[qt][dt] = (f32x4){0.f, 0.f, 0.f, 0.f};
  }
  const int nt = c.ntiles();
  u32x4 rk[NCH], rv[NCH];
  if constexpr (PF) {
#pragma unroll
    for (int i = 0; i < NCH; ++i) {
      const int ci = tid + 256 * i, row = ci / CH, ch = ci % CH;
      ld16_sc1(rk[i], c.kptr(0, row) + ch * 8); ld16_sc1(rv[i], c.vptr(0, row) + ch * 8);
    }
  }
  for (int t = 0; t < nt; ++t) {
    __syncthreads();
    if constexpr (PF) {
      static_assert(!PF || NCH == 2 || NCH == 4, "wait lists below are written for two or four chunks per matrix");
      if constexpr (NCH == 2) asm volatile("s_waitcnt vmcnt(0)" : "+v"(rk[0]), "+v"(rk[NCH - 1]), "+v"(rv[0]), "+v"(rv[NCH - 1]) :: "memory");
      else asm volatile("s_waitcnt vmcnt(0)" : "+v"(rk[0]), "+v"(rk[1]), "+v"(rk[NCH - 2]), "+v"(rk[NCH - 1]), "+v"(rv[0]), "+v"(rv[1]), "+v"(rv[NCH - 2]), "+v"(rv[NCH - 1]) :: "memory");
#pragma unroll
      for (int i = 0; i < NCH; ++i) {
        const int ci = tid + 256 * i, row = ci / CH, ch = ci % CH;
        *(u32x4*)(sK + row * LDK + ch * 8) = rk[i]; *(u32x4*)(sV + row * LDK + ch * 8) = rv[i];
      }
    } else {
#pragma unroll
      for (int i = 0; i < NCH; ++i) {
        const int ci = tid + 256 * i, row = ci / CH, ch = ci % CH;
        *(u32x4*)(sK + row * LDK + ch * 8) = ld_agent_u32x4(c.kptr(t, row) + ch * 8);
      }
#pragma unroll
      for (int i = 0; i < NCH; ++i) {
        const int ci = tid + 256 * i, row = ci / CH, ch = ci % CH;
        *(u32x4*)(sV + row * LDK + ch * 8) = ld_agent_u32x4(c.vptr(t, row) + ch * 8);
      }
    }
    __syncthreads();
    if constexpr (PF) {
      if (t + 1 < nt) {
#pragma unroll
        for (int i = 0; i < NCH; ++i) {
          const int ci = tid + 256 * i, row = ci / CH, ch = ci % CH;
          ld16_sc1(rk[i], c.kptr(t + 1, row) + ch * 8); ld16_sc1(rv[i], c.vptr(t + 1, row) + ch * 8);
        }
      }
    }
    if (c.active(t, wid)) {
      constexpr int QG = NQT < 2 ? NQT : 2;
      bf16x8 pfa[NQT][NKK];
#pragma unroll
      for (int g = 0; g < NQT; g += QG) {
        f32x4 s[QG][NK4];
#pragma unroll
        for (int q = 0; q < QG; ++q)
#pragma unroll
          for (int k4 = 0; k4 < NK4; ++k4) s[q][k4] = (f32x4){0.f, 0.f, 0.f, 0.f};
#pragma unroll
        for (int k4 = 0; k4 < NK4; ++k4)
#pragma unroll
          for (int ks = 0; ks < NKS; ++ks) {
            const bf16x8 kf = *(const bf16x8*)(sK + (16 * k4 + l15) * LDK + ks * 32 + quad * 8);
#pragma unroll
            for (int q = 0; q < QG; ++q) s[q][k4] = __builtin_amdgcn_mfma_f32_16x16x32_bf16(kf, qf[g + q][ks], s[q][k4], 0, 0, 0);
          }
#pragma unroll
        for (int q = 0; q < QG; ++q) {
          const int qt = g + q;
          float mx = -1e30f;
#pragma unroll
          for (int k4 = 0; k4 < NK4; ++k4)
#pragma unroll
            for (int j = 0; j < 4; ++j) { const float v = c.score(t, wid, qt * 16 + l15, 16 * k4 + 4 * quad + j, s[q][k4][j]); s[q][k4][j] = v; mx = fmaxf(mx, v); }
          mx = fmaxf(mx, __shfl_xor(mx, 16)); mx = fmaxf(mx, __shfl_xor(mx, 32));
          const float mnew = fmaxf(mrow[qt], mx);
          if (__any(mnew > mrow[qt])) {
            const float alpha = __builtin_amdgcn_exp2f(mrow[qt] - mnew);
            mrow[qt] = mnew;
            lrow[qt] *= alpha;
#pragma unroll
            for (int dt = 0; dt < NDT; ++dt) o[qt][dt] *= alpha;
          }
          float psum = 0.f;
#pragma unroll
          for (int k4 = 0; k4 < NK4; ++k4)
#pragma unroll
            for (int j = 0; j < 4; ++j) { const float pv = __builtin_amdgcn_exp2f(s[q][k4][j] - mnew); s[q][k4][j] = pv; psum += pv; }
          lrow[qt] += psum;
#pragma unroll
          for (int kk = 0; kk < NKK; ++kk) {
            u32x4 w;
            w.x = cvtpk(s[q][2 * kk][0], s[q][2 * kk][1]); w.y = cvtpk(s[q][2 * kk][2], s[q][2 * kk][3]);
            w.z = cvtpk(s[q][2 * kk + 1][0], s[q][2 * kk + 1][1]); w.w = cvtpk(s[q][2 * kk + 1][2], s[q][2 * kk + 1][3]);
            pfa[qt][kk] = __builtin_bit_cast(bf16x8, w);
          }
        }
      }
#pragma unroll
      for (int kk = 0; kk < NKK; ++kk) {
        const bf16_t* vb = sV + (32 * kk + 4 * quad + (l15 >> 2)) * LDK + 4 * (l15 & 3);
#pragma unroll
        for (int dt = 0; dt < NDT; ++dt) {
          const s16x4 lo = tr_read(vb + 16 * dt);
          const s16x4 hi = tr_read(vb + 16 * LDK + 16 * dt);
          const bf16x8 vf = (bf16x8){lo[0], lo[1], lo[2], lo[3], hi[0], hi[1], hi[2], hi[3]};
#pragma unroll
          for (int qt = 0; qt < NQT; ++qt) o[qt][dt] = __builtin_amdgcn_mfma_f32_16x16x32_bf16(vf, pfa[qt][kk], o[qt][dt], 0, 0, 0);
        }
      }
    }
  }
#pragma unroll
  for (int qt = 0; qt < NQT; ++qt) {
    float l = lrow[qt];
    l += __shfl_xor(l, 16); l += __shfl_xor(l, 32);
    const float inv = 1.0f / l;
    bf16_t* op = c.optr(wid, qt * 16 + l15) + 4 * quad;
#pragma unroll
    for (int dt = 0; dt < NDT; ++dt) { const f32x4 v = o[qt][dt] * inv; u32x2 w; w.x = cvtpk(v[0], v[1]); w.y = cvtpk(v[2], v[3]); *(u32x2*)(op + 16 * dt) = w; }
    if (quad == 0) c.store_lse(wid, qt * 16 + l15, mrow[qt] + __builtin_amdgcn_logf(l));
  }
}

struct CtxA {
  bf16_t* qbase; const bf16_t* kbase; int nt;
  __device__ __forceinline__ const bf16_t* qptr(int w, int ql) const { return qbase + (size_t)(64 * w + ql) * ZW; }
  __device__ __forceinline__ bf16_t* optr(int w, int ql) const { return qbase + (size_t)(64 * w + ql) * ZW; }
  __device__ __forceinline__ const bf16_t* kptr(int t, int r) const { return kbase + (size_t)(64 * t + r) * ZW; }
  __device__ __forceinline__ const bf16_t* vptr(int t, int r) const { return kbase + (size_t)(64 * t + r) * ZW + 128; }
  __device__ __forceinline__ int ntiles() const { return nt; }
  __device__ __forceinline__ bool active(int, int) const { return true; }
  __device__ __forceinline__ float score(int, int, int, int, float s) const { return s; }
  __device__ __forceinline__ void store_lse(int, int, float) const {}
};
struct CtxB {
  bf16_t* zs; float* lse; int d, r, L, i0, qcol, kcol, vcol; float slope_l2;
  __device__ __forceinline__ const bf16_t* qptr(int w, int ql) const { return zs + (size_t)((i0 + 32 * w + ql) * d + r) * ZW + qcol; }
  __device__ __forceinline__ bf16_t* optr(int w, int ql) const { return zs + (size_t)((i0 + 32 * w + ql) * d + r) * ZW + qcol; }
  __device__ __forceinline__ int kidx(int t, int row) const { int i = i0 - 64 + 64 * t + row; i = i < 0 ? 0 : i; return i > L - 1 ? L - 1 : i; }
  __device__ __forceinline__ const bf16_t* kptr(int t, int row) const { return zs + (size_t)(kidx(t, row) * d + r) * ZW + kcol; }
  __device__ __forceinline__ const bf16_t* vptr(int t, int row) const { return zs + (size_t)(kidx(t, row) * d + r) * ZW + vcol; }
  __device__ __forceinline__ int ntiles() const { return 4; }
  __device__ __forceinline__ bool active(int t, int w) const { return w < 2 ? (t < 3) : (t >= 1); }
  __device__ __forceinline__ float score(int t, int w, int ql, int kl, float s) const {
    const int qi = i0 + 32 * w + ql, ki = i0 - 64 + 64 * t + kl; int rel = ki - qi; rel = rel < 0 ? -rel : rel;
    const bool valid = (rel <= 64) && (ki >= 0) && (ki < L);
    return valid ? s * (0.125f * LOG2E) - slope_l2 * (float)rel : -1e30f;
  }
  __device__ __forceinline__ void store_lse(int w, int ql, float v) const { lse[i0 + 32 * w + ql] = v; }
};
struct CtxC {
  bf16_t* zs; const float* rpb; int R, r0, rb, hc;
  __device__ __forceinline__ const bf16_t* qptr(int w, int ql) const { return zs + (size_t)((r0 + w) * 64 + ql) * ZW + hc; }
  __device__ __forceinline__ bf16_t* optr(int w, int ql) const { return zs + (size_t)((r0 + w) * 64 + ql) * ZW + hc; }
  __device__ __forceinline__ int krow(int t) const { const int kr = rb + t; return kr > R - 1 ? R - 1 : kr; }
  __device__ __forceinline__ const bf16_t* kptr(int t, int row) const { return zs + (size_t)(krow(t) * 64 + row) * ZW + 1024 + hc; }
  __device__ __forceinline__ const bf16_t* vptr(int t, int row) const { return zs + (size_t)(krow(t) * 64 + row) * ZW + 2048 + hc; }
  __device__ __forceinline__ int ntiles() const { return 11; }
  __device__ __forceinline__ int rstart(int r) const { int rs = r - 4; rs = rs < 0 ? 0 : rs; return rs > R - 8 ? R - 8 : rs; }
  __device__ __forceinline__ bool active(int t, int w) const { const int r = r0 + w, rs = rstart(r), kr = rb + t; return kr >= rs && kr < rs + 8; }
  __device__ __forceinline__ float score(int t, int w, int ql, int kl, float s) const {
    const int r = r0 + w, cq = ql, kr = rb + t;
    int cs = cq - 8; cs = cs < 0 ? 0 : cs; cs = cs > 48 ? 48 : cs;
    const bool valid = (kl >= cs) && (kl < cs + 16);
    const int idx = valid ? (kr - r + 7) * 31 + (kl - cq + 15) : 0;
    const float b = rpb[idx];
    return valid ? (s * 0.125f + b) * LOG2E : -1e30f;
  }
  __device__ __forceinline__ void store_lse(int, int, float) const {}
};
struct CtxX {
  bf16_t* qbase; const bf16_t* kv;
  __device__ __forceinline__ const bf16_t* qptr(int w, int ql) const { return qbase + (size_t)(16 * w + ql) * 1024; }
  __device__ __forceinline__ bf16_t* optr(int w, int ql) const { return qbase + (size_t)(16 * w + ql) * 1024; }
  __device__ __forceinline__ const bf16_t* kptr(int t, int row) const { return kv + (size_t)(32 * t + row) * 2048; }
  __device__ __forceinline__ const bf16_t* vptr(int t, int row) const { return kv + (size_t)(32 * t + row) * 2048 + 1024; }
  __device__ __forceinline__ int ntiles() const { return 8; }
  __device__ __forceinline__ bool active(int, int) const { return true; }
  __device__ __forceinline__ float score(int, int, int, int, float s) const { return s * (0.0625f * LOG2E); }
  __device__ __forceinline__ void store_lse(int, int, float) const {}
};

__device__ __forceinline__ void wt_tile(unsigned char* smem, const float* src, int K, int N, const float* gain, bf16_t* dst, int perm, int t) {
  float* tl = (float*)smem;
  const int nkt = K >> 6; const int rt = t / nkt, kt = t - rt * nkt; const int R0 = rt * 64, k0 = kt * 64;
  const int tid = get_tid(); const int rr = tid & 63;
  const int R = R0 + rr; int sc = R;
  if (perm) { const int T = R >> 8, within = R & 255, wc = within >> 7, n = (within & 127) >> 4, i = within & 15; sc = (n & 1) * DFF + 128 * T + 64 * wc + 16 * (n >> 1) + i; }
  __syncthreads();
#pragma unroll 4
  for (int i = 0; i < 16; ++i) {
    const int kk = (tid >> 6) + 4 * i;
    float v = src[(size_t)(k0 + kk) * N + sc];
    if (gain) v *= gain[k0 + kk];
    tl[kk * 65 + rr] = v;
  }
  __syncthreads();
  const int r2 = tid >> 2, kq = tid & 3;
  u32x4 w0, w1;
  w0.x = cvtpk(tl[(16 * kq + 0) * 65 + r2], tl[(16 * kq + 1) * 65 + r2]); w0.y = cvtpk(tl[(16 * kq + 2) * 65 + r2], tl[(16 * kq + 3) * 65 + r2]);
  w0.z = cvtpk(tl[(16 * kq + 4) * 65 + r2], tl[(16 * kq + 5) * 65 + r2]); w0.w = cvtpk(tl[(16 * kq + 6) * 65 + r2], tl[(16 * kq + 7) * 65 + r2]);
  w1.x = cvtpk(tl[(16 * kq + 8) * 65 + r2], tl[(16 * kq + 9) * 65 + r2]); w1.y = cvtpk(tl[(16 * kq + 10) * 65 + r2], tl[(16 * kq + 11) * 65 + r2]);
  w1.z = cvtpk(tl[(16 * kq + 12) * 65 + r2], tl[(16 * kq + 13) * 65 + r2]); w1.w = cvtpk(tl[(16 * kq + 14) * 65 + r2], tl[(16 * kq + 15) * 65 + r2]);
  bf16_t* dp = dst + ((size_t)((k0 + 16 * kq) >> 5) * N + (R0 + r2)) * 32 + ((16 * kq) & 31);
  *(u32x4*)dp = w0; *(u32x4*)(dp + 8) = w1;
}
__device__ __forceinline__ void wt_matrix(unsigned char* smem, const float* src, int K, int N, const float* gain, bf16_t* dst, int perm) {
  const int ntile = (K >> 6) * (N >> 6);
  for (int t = blockIdx.x; t < ntile; t += gridDim.x) wt_tile(smem, src, K, N, gain, dst, perm, t);
}

__device__ __forceinline__ void tile_seq(int tt, int& seqbase, int& qb, int& S) {
  if (tt < 256) { seqbase = (tt >> 4) * 2048; qb = tt & 15; S = 2048; }
  else { const int u = tt - 256; seqbase = NPROMPT + (u >> 7) * 16384; qb = u & 127; S = 16384; }
}

typedef const __attribute__((address_space(4))) Params* KParams;
__device__ __forceinline__ void run_phase(int ph, KParams kp, unsigned char* smem) {
  unsigned char* ws = kp->ws;
  bf16_t* Z = (bf16_t*)(ws + WS_Z);
  const int tid = get_tid();
  const int L = ph >= 10 ? 1 : 0;
  switch (ph) {
    case 0: {
      wt_matrix(smem, kp->w_in_ab, 1024, 3072, kp->g_mix, (bf16_t*)(ws + WS_WT_IN_AB), 0);
      wt_matrix(smem, kp->w_out_ab, 768, 1024, nullptr, (bf16_t*)(ws + WS_WT_OUT_AB), 0);
      wt_matrix(smem, kp->w_in_c, 1024, 3072, kp->g_mix + 1024, (bf16_t*)(ws + WS_WT_IN_C), 0);
      wt_matrix(smem, kp->w_out_c, 1024, 1024, nullptr, (bf16_t*)(ws + WS_WT_OUT_C), 0);
      for (int l = 0; l < 2; ++l) {
        wt_matrix(smem, kp->wq_x + (size_t)l * 1024 * 1024, 1024, 1024, kp->g_xattn + l * 1024, (bf16_t*)(ws + WS_WT_Q) + (size_t)l * 1024 * 1024, 0);
        wt_matrix(smem, kp->wkv_x + (size_t)l * 1024 * 2048, 1024, 2048, kp->g_mem + l * 1024, (bf16_t*)(ws + WS_WT_KV) + (size_t)l * 2048 * 1024, 0);
        wt_matrix(smem, kp->wo_x + (size_t)l * 1024 * 1024, 1024, 1024, nullptr, (bf16_t*)(ws + WS_WT_O) + (size_t)l * 1024 * 1024, 0);
        wt_matrix(smem, kp->w_gu + (size_t)l * 1024 * 5632, 1024, 5632, kp->g_ffn + l * 1024, (bf16_t*)(ws + WS_WT_GU) + (size_t)l * 5632 * 1024, 1);
        wt_matrix(smem, kp->w_down + (size_t)l * DFF * 1024, DFF, 1024, nullptr, (bf16_t*)(ws + WS_WT_DOWN) + (size_t)l * 1024 * DFF, 0);
      }
      const int gi = blockIdx.x * 256 + tid;
      if (gi < 4096) {
        const int pos = gi >> 4, f = gi & 15;
        const float inv_freq = exp2f(-(float)f * 0.83048202372184058696f);
        const float ang = (float)pos * inv_freq;
        float2 cs; cs.x = cosf(ang); cs.y = sinf(ang);
        ((float2*)(ws + WS_ROPE))[gi] = cs;
      }
    } break;
    case 1: {
      const int n_ab = 512 * 12, n_kv = 36 * 8;
      for (int t = blockIdx.x; t < n_ab + 2 * n_kv; t += gridDim.x) {
        if (t < n_ab) {
          int mt, nt; tile_map(t, 12, gridDim.x, mt, nt);
          EpiInAB e{Z, kp->g_qn, kp->g_kn, (const float2*)(ws + WS_ROPE)};
          gemm_tile<true>(smem, xin_row(kp->x_prompt, kp->x_sample, mt * 128), 1024, (const bf16_t*)(ws + WS_WT_IN_AB), 3072, 1024, e, mt * 128, nt * 256);
        } else {
          int u = t - n_ab; const int l = u / n_kv; u -= l * n_kv; const int mt = u >> 3, nt = u & 7;
          EpiStore<true> e{(bf16_t*)(ws + WS_KVMEM) + (size_t)l * 4608 * 2048, 2048};
          gemm_tile<true>(smem, mem_row(kp->mem_prompt, kp->mem_sample, mt * 128), 1024, (const bf16_t*)(ws + WS_WT_KV) + (size_t)l * 2048 * 1024, 2048, 1024, e, mt * 128, nt * 256);
        }
      }
    } break;
    case 2: {
      for (int it = blockIdx.x; it < 2048 + 6144; it += gridDim.x) {
        if (it < 2048) {
          int seqbase, qi, h, nt;
          if (gridDim.x == 512) {
            const int bid = blockIdx.x, i = it >> 9, xcd = bid & 7, l = (bid >> 3) + 64 * (i & 1);
            if (it < 1024) { const int g = xcd >> 1, id = l * 2 + (xcd & 1); qi = id >> 2; h = (g & 1) * 4 + (id & 3); seqbase = NPROMPT + (g >> 1) * 16384; nt = 256; }
            else { const int grp = xcd + 8 * (l >> 5), id = l & 31; qi = id >> 2; h = (grp & 1) * 4 + (id & 3); seqbase = (grp >> 1) * 2048; nt = 32; }
          } else if (it < 1024) { const int s = it >> 9, rem = it & 511; qi = rem >> 3; h = rem & 7; seqbase = NPROMPT + s * 16384; nt = 256; }
          else { const int a = it - 1024; const int s = a >> 6, rem = a & 63; qi = rem >> 3; h = rem & 7; seqbase = s * 2048; nt = 32; }
          CtxA c{Z + (size_t)(seqbase + 256 * qi) * ZW + h * 64, Z + (size_t)seqbase * ZW + 512 + (h >> 2) * 64, nt};
          attn_item<64, 64, 4, true>(smem, c);
        } else {
          const int b = it - 2048; const int h = b & 3, g = (b >> 2) % 3, tt = b / 12;
          int seqbase, qb, S; tile_seq(tt, seqbase, qb, S);
          const int d = g == 0 ? 1 : (g == 1 ? 4 : 16);
          const int Ls = S / d, nb = Ls >> 7; const int r = qb / nb, mblk = qb - r * nb;
          const float slope = exp2f(-8.0f * (float)(4 * g + h + 1) / 12.0f);
          CtxB c{Z + (size_t)seqbase * ZW, (float*)(ws + WS_LSE) + (size_t)(g * 4 + h) * NTOK + seqbase + r * Ls, d, r, Ls, mblk * 128,
                 768 + ((0 * 3 + g) * 4 + h) * 64, 768 + ((1 * 3 + g) * 4 + h) * 64, 768 + ((2 * 3 + g) * 4 + h) * 64, slope * (float)d * LOG2E};
          attn_item<64, 64, 2, true>(smem, c);
        }
      }
    } break;
    case 3: {
      const float* lse = (const float*)(ws + WS_LSE);
      for (int i = blockIdx.x * 256 + tid; i < NTOK * 32; i += gridDim.x * 256) {
        const int T = i >> 5, h = (i >> 3) & 3, c8 = i & 7;
        int sb, pos, lg;
        if (T < NPROMPT) { sb = T & ~2047; pos = T & 2047; lg = 11; } else { sb = NPROMPT + ((T - NPROMPT) & ~16383); pos = (T - NPROMPT) & 16383; lg = 14; }
        const float l0 = ld_agent_f32(lse + (size_t)(0 * 4 + h) * NTOK + sb + pos);
        const float l1 = ld_agent_f32(lse + (size_t)(1 * 4 + h) * NTOK + sb + ((pos & 3) << (lg - 2)) + (pos >> 2));
        const float l2 = ld_agent_f32(lse + (size_t)(2 * 4 + h) * NTOK + sb + ((pos & 15) << (lg - 4)) + (pos >> 4));
        const float mx = fmaxf(l0, fmaxf(l1, l2));
        float w0 = __builtin_amdgcn_exp2f(l0 - mx), w1 = __builtin_amdgcn_exp2f(l1 - mx), w2 = __builtin_amdgcn_exp2f(l2 - mx);
        const float inv = 1.0f / (w0 + w1 + w2); w0 *= inv; w1 *= inv; w2 *= inv;
        const bf16_t* zr = Z + (size_t)T * ZW;
        const u32x4 a = ld_agent_u32x4(zr + 768 + (0 * 4 + h) * 64 + c8 * 8), b = ld_agent_u32x4(zr + 768 + (1 * 4 + h) * 64 + c8 * 8), cc = ld_agent_u32x4(zr + 768 + (2 * 4 + h) * 64 + c8 * 8);
        u32x4 o;
#pragma unroll
        for (int k = 0; k < 4; ++k) {
          const float lo = w0 * bf2f((unsigned short)(a[k] & 0xffff)) + w1 * bf2f((unsigned short)(b[k] & 0xffff)) + w2 * bf2f((unsigned short)(cc[k] & 0xffff));
          const float hi = w0 * bf2f((unsigned short)(a[k] >> 16)) + w1 * bf2f((unsigned short)(b[k] >> 16)) + w2 * bf2f((unsigned short)(cc[k] >> 16));
          o[k] = cvtpk(lo, hi);
        }
        *(u32x4*)(Z + (size_t)T * ZW + 512 + h * 64 + c8 * 8) = o;
      }
    } break;
    case 4: case 7: case 9: case 12: case 15: case 17: {
      const bf16_t* A; int lda, K; const bf16_t* Bt;
      if (ph == 4) { A = Z; lda = ZW; K = 768; Bt = (const bf16_t*)(ws + WS_WT_OUT_AB); }
      else if (ph == 12) { A = Z; lda = ZW; K = 1024; Bt = (const bf16_t*)(ws + WS_WT_OUT_C); }
      else if (ph == 7 || ph == 15) { A = Z; lda = 1024; K = 1024; Bt = (const bf16_t*)(ws + WS_WT_O) + (size_t)L * 1024 * 1024; }
      else { A = Z; lda = DFF; K = DFF; Bt = (const bf16_t*)(ws + WS_WT_DOWN) + (size_t)L * 1024 * DFF; }
      for (int t = blockIdx.x; t < 512 * 4; t += gridDim.x) {
        int mt, nt; tile_map(t, 4, gridDim.x, mt, nt);
        EpiResid e{ph == 4 ? xin_row(kp->x_prompt, kp->x_sample, mt * 128) : kp->out + (size_t)mt * 128 * 1024, kp->out};
        gemm_tile<false>(smem, A + (size_t)mt * 128 * lda, lda, Bt, 1024, K, e, mt * 128, nt * 256);
      }
    } break;
    case 5: case 10: case 13: {
      const bf16_t* Bt; int NT, ldc;
      if (ph == 10) { Bt = (const bf16_t*)(ws + WS_WT_IN_C); NT = 12; ldc = ZW; }
      else { Bt = (const bf16_t*)(ws + WS_WT_Q) + (size_t)L * 1024 * 1024; NT = 4; ldc = 1024; }
      for (int t = blockIdx.x; t < 512 * NT; t += gridDim.x) {
        int mt, nt; tile_map(t, NT, gridDim.x, mt, nt);
        EpiStore<true> e{Z, ldc};
        gemm_tile<true>(smem, kp->out + (size_t)mt * 128 * 1024, 1024, Bt, NT * 256, 1024, e, mt * 128, nt * 256);
      }
    } break;
    case 6: case 14: {
      const bf16_t* kvm = (const bf16_t*)(ws + WS_KVMEM) + (size_t)L * 4608 * 2048;
      for (int it = blockIdx.x; it < 4096; it += gridDim.x) {
        int idx = it; if (gridDim.x == 512) idx = (blockIdx.x & 7) * 512 + (blockIdx.x >> 3) + 64 * (it >> 9);
        const int h = idx & 3, tile = idx >> 2, T0 = tile * 64;
        const int bidx = T0 < NPROMPT ? (T0 >> 11) : 16 + ((T0 - NPROMPT) >> 14);
        CtxX c{Z + (size_t)T0 * 1024 + h * 256, kvm + (size_t)bidx * 256 * 2048 + h * 256};
        attn_item<256, 32, 1, true>(smem, c);
      }
    } break;
    case 8: case 16: {
      const bf16_t* Bt = (const bf16_t*)(ws + WS_WT_GU) + (size_t)L * 5632 * 1024;
      for (int t = blockIdx.x; t < 512 * 22; t += gridDim.x) {
        int mt, nt; tile_map(t, 22, gridDim.x, mt, nt);
        EpiSwiGLU e{Z};
        gemm_tile<true>(smem, kp->out + (size_t)mt * 128 * 1024, 1024, Bt, 5632, 1024, e, mt * 128, nt * 256);
      }
    } break;
    case 11: {
      float* srpb = (float*)(smem + 2 * 64 * 72 * 2);
      for (int it = blockIdx.x; it < 4096; it += gridDim.x) {
        int h = it & 15, t4 = it >> 4;
        if (gridDim.x == 512) { const int l = (blockIdx.x >> 3) + 64 * (it >> 9); h = 2 * (blockIdx.x & 7) + (l & 1); t4 = l >> 1; }
        int seqbase, rq, R;
        if (t4 < 128) { seqbase = (t4 >> 3) * 2048; rq = t4 & 7; R = 32; } else { const int u = t4 - 128; seqbase = NPROMPT + (u >> 6) * 16384; rq = u & 63; R = 256; }
        const int r0 = 4 * rq;
        int rb = r0 - 4; rb = rb < 0 ? 0 : rb; rb = rb > R - 8 ? R - 8 : rb;
        __syncthreads();
        for (int i = tid; i < 15 * 31; i += 256) srpb[i] = kp->rpb_c[h * 15 * 31 + i];
        CtxC c{Z + (size_t)seqbase * ZW, srpb, R, r0, rb, h * 64};
        attn_item<64, 64, 4, true>(smem, c);
      }
    } break;
    case 18: {
      const int lane = tid & 63, wv = blockIdx.x * 4 + (tid >> 6), nwv = gridDim.x * 4;
      for (int row = wv; row < NTOK; row += nwv) {
        float* xr = kp->out + (size_t)row * 1024;
        f32x4 v[4]; float s = 0.f;
#pragma unroll
        for (int i = 0; i < 4; ++i) { v[i] = ld_agent_f32x4(xr + i * 256 + lane * 4); s += v[i][0] * v[i][0] + v[i][1] * v[i][1] + v[i][2] * v[i][2] + v[i][3] * v[i][3]; }
        s += __shfl_xor(s, 1); s += __shfl_xor(s, 2); s += __shfl_xor(s, 4); s += __shfl_xor(s, 8); s += __shfl_xor(s, 16); s += __shfl_xor(s, 32);
        const float r = rsqrtf(s * (1.0f / 1024.0f) + EPS);
#pragma unroll
        for (int i = 0; i < 4; ++i) { const f32x4 g = *(const f32x4*)(kp->g_final + i * 256 + lane * 4); *(f32x4*)(xr + i * 256 + lane * 4) = v[i] * r * g; }
      }
    } break;
    default: break;
  }
}

constexpr int NPHASE = 19;

template <bool COOP>
__global__ void __launch_bounds__(256, 2) mega(Params p) {
  __shared__ __attribute__((aligned(16))) unsigned char smem[SMEM_BYTES];
  if constexpr (COOP) {
    cg::grid_group grid = cg::this_grid();
#define STEP(PH) { KParams kp = (KParams)__builtin_amdgcn_kernarg_segment_ptr(); asm volatile("" : "+s"(kp)); run_phase(PH, kp, smem); if (PH + 1 < NPHASE) grid.sync(); }
    STEP(0) STEP(1) STEP(2) STEP(3) STEP(4) STEP(5) STEP(6) STEP(7) STEP(8) STEP(9)
    STEP(10) STEP(11) STEP(12) STEP(13) STEP(14) STEP(15) STEP(16) STEP(17) STEP(18)
#undef STEP
  } else {
    for (int ph = p.phase_lo; ph < p.phase_hi; ++ph) {
      KParams kp = (KParams)__builtin_amdgcn_kernarg_segment_ptr();
      asm volatile("" : "+s"(kp));
      run_phase(ph, kp, smem);
    }
  }
}

extern "C" void kernel_launch(void* const* d_in, const int* in_sizes, int n_in, void* d_out, int out_size, void* d_ws, size_t ws_size, hipStream_t stream) {
  static int grid = 0;
  if (grid == 0) {
    if (n_in != 21 || ws_size < WS_END) { fprintf(stderr, "kernel_launch: n_in %d ws %zu (need %zu)\n", n_in, ws_size, (size_t)WS_END); grid = -1; return; }
    int dev = 0, cus = 0, per_cu = 0;
    hipGetDevice(&dev);
    hipDeviceGetAttribute(&cus, hipDeviceAttributeMultiprocessorCount, dev);
#if MULTI_LAUNCH
    hipOccupancyMaxActiveBlocksPerMultiprocessor(&per_cu, (const void*)mega<false>, 256, 0);
#else
    hipOccupancyMaxActiveBlocksPerMultiprocessor(&per_cu, (const void*)mega<true>, 256, 0);
#endif
    if (per_cu < 1) per_cu = 1;
    if (per_cu > 2) per_cu = 2;
    grid = cus * per_cu;
  }
  if (grid < 0) return;
  Params p{};
  p.x_prompt = (const float*)d_in[0]; p.x_sample = (const float*)d_in[1]; p.mem_prompt = (const float*)d_in[2]; p.mem_sample = (const float*)d_in[3];
  p.g_mix = (const float*)d_in[4]; p.w_in_ab = (const float*)d_in[5]; p.g_qn = (const float*)d_in[6]; p.g_kn = (const float*)d_in[7]; p.w_out_ab = (const float*)d_in[8];
  p.w_in_c = (const float*)d_in[9]; p.rpb_c = (const float*)d_in[10]; p.w_out_c = (const float*)d_in[11]; p.g_xattn = (const float*)d_in[12]; p.g_mem = (const float*)d_in[13];
  p.wq_x = (const float*)d_in[14]; p.wkv_x = (const float*)d_in[15]; p.wo_x = (const float*)d_in[16]; p.g_ffn = (const float*)d_in[17]; p.w_gu = (const float*)d_in[18]; p.w_down = (const float*)d_in[19];
  p.g_final = (const float*)d_in[20];
  p.out = (float*)d_out; p.ws = (unsigned char*)d_ws;
#if MULTI_LAUNCH
  for (int ph = 0; ph < NPHASE; ++ph) {
    p.phase_lo = ph; p.phase_hi = ph + 1;
    hipLaunchKernelGGL(mega<false>, dim3(grid), dim3(256), 0, stream, p);
  }
#else
  p.phase_lo = 0; p.phase_hi = NPHASE;
  void* args[] = {&p};
  hipError_t e = hipLaunchCooperativeKernel((const void*)mega<true>, dim3(grid), dim3(256), args, 0, stream);
  if (e != hipSuccess) fprintf(stderr, "cooperative launch failed: %s (grid %d)\n", hipGetErrorString(e), grid);
#endif
}
#ifdef DBG_RES
template <int PH> __global__ void __launch_bounds__(256, 2) mega_one(Params p) {
  __shared__ __attribute__((aligned(16))) unsigned char smem[SMEM_BYTES];
  run_phase(PH, (KParams)__builtin_amdgcn_kernarg_segment_ptr(), smem);
}
template __global__ void mega_one<0>(Params); template __global__ void mega_one<1>(Params); template __global__ void mega_one<2>(Params);
template __global__ void mega_one<3>(Params); template __global__ void mega_one<4>(Params); template __global__ void mega_one<5>(Params);
template __global__ void mega_one<6>(Params); template __global__ void mega_one<8>(Params); template __global__ void mega_one<11>(Params);
template __global__ void mega_one<18>(Params);
#endif
```

```cpp
#include <hip/hip_runtime.h>
#include <hip/hip_cooperative_groups.h>
#include <cstdint>
#include <cstdio>
namespace cg = cooperative_groups;

#ifndef MULTI_LAUNCH
#define MULTI_LAUNCH 0
#endif

typedef unsigned short bf16_t;
typedef short bf16x8 __attribute__((ext_vector_type(8)));
typedef short s16x4 __attribute__((ext_vector_type(4)));
typedef short v4i16_t __attribute__((ext_vector_type(4)));
typedef float f32x4 __attribute__((ext_vector_type(4)));
typedef float f32x2_t __attribute__((ext_vector_type(2)));
typedef __bf16 bf16x2_t __attribute__((ext_vector_type(2)));
typedef unsigned u32x4 __attribute__((ext_vector_type(4)));
typedef unsigned u32x2 __attribute__((ext_vector_type(2)));

#define LOG2E 1.4426950408889634f
constexpr int NTOK = 65536;
constexpr int NPROMPT = 32768;
constexpr int ZW = 3072;
constexpr int DFF = 2816;
constexpr float EPS = 1e-6f;

constexpr size_t WS_WT_IN_AB = 0;
constexpr size_t WS_WT_OUT_AB = WS_WT_IN_AB + (size_t)3072 * 1024 * 2;
constexpr size_t WS_WT_IN_C = WS_WT_OUT_AB + (size_t)1024 * 768 * 2;
constexpr size_t WS_WT_OUT_C = WS_WT_IN_C + (size_t)3072 * 1024 * 2;
constexpr size_t WS_WT_Q = WS_WT_OUT_C + (size_t)1024 * 1024 * 2;
constexpr size_t WS_WT_KV = WS_WT_Q + (size_t)2 * 1024 * 1024 * 2;
constexpr size_t WS_WT_O = WS_WT_KV + (size_t)2 * 2048 * 1024 * 2;
constexpr size_t WS_WT_GU = WS_WT_O + (size_t)2 * 1024 * 1024 * 2;
constexpr size_t WS_WT_DOWN = WS_WT_GU + (size_t)2 * 5632 * 1024 * 2;
constexpr size_t WS_KVMEM = WS_WT_DOWN + (size_t)2 * 1024 * 2816 * 2;
constexpr size_t WS_LSE = WS_KVMEM + (size_t)2 * 4608 * 2048 * 2;
constexpr size_t WS_ROPE = WS_LSE + (size_t)3 * 65536 * 4 * 4;
constexpr size_t WS_Z = WS_ROPE + (size_t)256 * 16 * 8;
constexpr size_t WS_END = WS_Z + (size_t)NTOK * ZW * 2;

constexpr int SMEM_BYTES = 2 * (128 + 256) * 40 * 2 + 512;

struct Params {
  const float* x_prompt; const float* x_sample; const float* mem_prompt; const float* mem_sample;
  const float* g_mix; const float* w_in_ab; const float* g_qn; const float* g_kn; const float* w_out_ab;
  const float* w_in_c; const float* rpb_c; const float* w_out_c; const float* g_xattn; const float* g_mem;
  const float* wq_x; const float* wkv_x; const float* wo_x; const float* g_ffn; const float* w_gu; const float* w_down;
  const float* g_final;
  float* out; unsigned char* ws;
  int phase_lo, phase_hi;
};

__device__ __forceinline__ int get_tid() { int t = threadIdx.x; asm volatile("" : "+v"(t)); return t; }
__device__ __forceinline__ unsigned cvtpk(float lo, float hi) { f32x2_t v = {lo, hi}; bf16x2_t b = __builtin_convertvector(v, bf16x2_t); return __builtin_bit_cast(unsigned, b); }
__device__ __forceinline__ float bf2f(unsigned short h) { return __uint_as_float(((unsigned)h) << 16); }
__device__ __forceinline__ s16x4 tr_read(const bf16_t* p) {
  return __builtin_bit_cast(s16x4, __builtin_amdgcn_ds_read_tr16_b64_v4i16((__attribute__((address_space(3))) v4i16_t*)p));
}
__device__ __forceinline__ const float* xin_row(const float* xp, const float* xs, int row) {
  return row < NPROMPT ? xp + (size_t)row * 1024 : xs + (size_t)(row - NPROMPT) * 1024;
}
__device__ __forceinline__ const float* mem_row(const float* mp, const float* ms, int row) {
  return row < 4096 ? mp + (size_t)row * 1024 : ms + (size_t)(row - 4096) * 1024;
}


__device__ __forceinline__ void ld16_sc1(u32x4& v, const void* p) { asm volatile("global_load_dwordx4 %0, %1, off sc1" : "=v"(v) : "v"(p) : "memory"); }
__device__ __forceinline__ void ld16_sc1(f32x4& v, const float* p) { asm volatile("global_load_dwordx4 %0, %1, off sc1" : "=v"(v) : "v"(p) : "memory"); }
__device__ __forceinline__ u32x4 ld_agent_u32x4(const void* p) {
  const unsigned long long a = __hip_atomic_load((const unsigned long long*)p, __ATOMIC_RELAXED, __HIP_MEMORY_SCOPE_AGENT);
  const unsigned long long b = __hip_atomic_load((const unsigned long long*)p + 1, __ATOMIC_RELAXED, __HIP_MEMORY_SCOPE_AGENT);
  return (u32x4){(unsigned)a, (unsigned)(a >> 32), (unsigned)b, (unsigned)(b >> 32)};
}
__device__ __forceinline__ float ld_agent_f32(const float* p) { return __uint_as_float(__hip_atomic_load((const unsigned*)p, __ATOMIC_RELAXED, __HIP_MEMORY_SCOPE_AGENT)); }
__device__ __forceinline__ f32x4 ld_agent_f32x4(const float* p) {
  const unsigned long long a = __hip_atomic_load((const unsigned long long*)p, __ATOMIC_RELAXED, __HIP_MEMORY_SCOPE_AGENT);
  const unsigned long long b = __hip_atomic_load((const unsigned long long*)p + 1, __ATOMIC_RELAXED, __HIP_MEMORY_SCOPE_AGENT);
  f32x4 v; v[0] = __uint_as_float((unsigned)a); v[1] = __uint_as_float((unsigned)(a >> 32)); v[2] = __uint_as_float((unsigned)b); v[3] = __uint_as_float((unsigned)(b >> 32)); return v;
}
__device__ __forceinline__ void tile_map(int t, int NT, int gdim, int& mt, int& nt) {
  if ((gdim & 7) == 0) { const int i = t / gdim, b = t - i * gdim; const int lt = (b >> 3) + (gdim >> 3) * i; const int ml = lt / NT; nt = lt - ml * NT; mt = (b & 7) + 8 * ml; }
  else { mt = t / NT; nt = t - mt * NT; }
}
constexpr int GLD = 40;
constexpr int G_STAGE = (128 + 256) * GLD;
template <bool AF32, class Epi>
__device__ __forceinline__ void gemm_tile(unsigned char* smem, const void* Ap, int lda, const bf16_t* WT, int N, int K, const Epi& epi, int m0, int n0) {
  const int tid = get_tid(), lane = tid & 63;
  const int wid = __builtin_amdgcn_readfirstlane(tid >> 6);
  const int wr = wid >> 1, wc = wid & 1, l15 = lane & 15, quad = lane >> 4;
  bf16_t* sbase = (bf16_t*)smem; float* sR = (float*)(smem + 2 * G_STAGE * 2);
  f32x4 acc[4][8];
#pragma unroll
  for (int m = 0; m < 4; ++m)
#pragma unroll
    for (int n = 0; n < 8; ++n) acc[m][n] = (f32x4){0.f, 0.f, 0.f, 0.f};
  float ss[4];
#pragma unroll
  for (int i = 0; i < 4; ++i) ss[i] = 0.f;
  f32x4 ra[4]; u32x4 rab[2]; u32x4 rb[4];
  const int nk = K >> 5;
  const float* Af = (const float*)Ap + (size_t)(tid >> 3) * lda + (tid & 7) * 4;
  const bf16_t* Ab = (const bf16_t*)Ap + (size_t)(tid >> 2) * lda + (tid & 3) * 8;
  const bf16_t* Bp = WT + (size_t)n0 * 32 + tid * 8;
  const size_t bstep = (size_t)N * 32;
  const int awf = (tid >> 3) * GLD + (tid & 7) * 4;
  const int awb = (tid >> 2) * GLD + (tid & 3) * 8;
#define G_LOAD(kt_) do { \
    if constexpr (AF32) { _Pragma("unroll") for (int i = 0; i < 4; ++i) ld16_sc1(ra[i], Af + (size_t)i * 32 * lda + (kt_) * 32); } \
    else { _Pragma("unroll") for (int i = 0; i < 2; ++i) ld16_sc1(rab[i], Ab + (size_t)i * 64 * lda + (kt_) * 32); } \
    _Pragma("unroll") for (int i = 0; i < 4; ++i) ld16_sc1(rb[i], Bp + (size_t)(kt_) * bstep + i * 2048); } while (0)
#define G_STORE(st_) do { bf16_t* sa_ = sbase + (st_) * G_STAGE; bf16_t* sb_ = sa_ + 128 * GLD; \
    if constexpr (AF32) { asm volatile("s_waitcnt vmcnt(0)" : "+v"(ra[0]), "+v"(ra[1]), "+v"(ra[2]), "+v"(ra[3]), "+v"(rb[0]), "+v"(rb[1]), "+v"(rb[2]), "+v"(rb[3]) :: "memory"); \
      _Pragma("unroll") for (int i = 0; i < 4; ++i) { const f32x4 v = ra[i]; \
        ss[i] += v[0] * v[0] + v[1] * v[1] + v[2] * v[2] + v[3] * v[3]; \
        u32x2 w; w.x = cvtpk(v[0], v[1]); w.y = cvtpk(v[2], v[3]); *(u32x2*)(sa_ + awf + i * 32 * GLD) = w; } } \
    else { asm volatile("s_waitcnt vmcnt(0)" : "+v"(rab[0]), "+v"(rab[1]), "+v"(rb[0]), "+v"(rb[1]), "+v"(rb[2]), "+v"(rb[3]) :: "memory"); \
      _Pragma("unroll") for (int i = 0; i < 2; ++i) *(u32x4*)(sa_ + awb + i * 64 * GLD) = rab[i]; } \
    _Pragma("unroll") for (int i = 0; i < 4; ++i) *(u32x4*)(sb_ + awb + i * 64 * GLD) = rb[i]; } while (0)
  G_LOAD(0);
  G_STORE(0);
  if (nk > 1) G_LOAD(1);
  __syncthreads();
  for (int kt = 0; kt < nk; ++kt) {
    const int cur = kt & 1;
    if (kt + 1 < nk) G_STORE(cur ^ 1);
    if (kt + 2 < nk) G_LOAD(kt + 2);
    const bf16_t* a_s = sbase + cur * G_STAGE + (wr * 64 + l15) * GLD + quad * 8;
    const bf16_t* b_s = sbase + cur * G_STAGE + 128 * GLD + (wc * 128 + l15) * GLD + quad * 8;
    __builtin_amdgcn_s_setprio(1);
    bf16x8 af[4];
#pragma unroll
    for (int m = 0; m < 4; ++m) af[m] = *(const bf16x8*)(a_s + m * 16 * GLD);
#pragma unroll
    for (int nh = 0; nh < 4; ++nh) {
      bf16x8 bfr[2];
#pragma unroll
      for (int n2 = 0; n2 < 2; ++n2) bfr[n2] = *(const bf16x8*)(b_s + (nh * 2 + n2) * 16 * GLD);
#pragma unroll
      for (int m = 0; m < 4; ++m)
#pragma unroll
        for (int n2 = 0; n2 < 2; ++n2) acc[m][nh * 2 + n2] = __builtin_amdgcn_mfma_f32_16x16x32_bf16(bfr[n2], af[m], acc[m][nh * 2 + n2], 0, 0, 0);
    }
    __builtin_amdgcn_s_setprio(0);
    __syncthreads();
  }
#undef G_LOAD
#undef G_STORE
  if constexpr (AF32) {
    const float invK = 1.0f / (float)K;
#pragma unroll
    for (int i = 0; i < 4; ++i) {
      float s = ss[i];
      s += __shfl_xor(s, 1); s += __shfl_xor(s, 2); s += __shfl_xor(s, 4);
      if ((tid & 7) == 0) sR[(tid >> 3) + 32 * i] = rsqrtf(s * invK + EPS);
    }
    __syncthreads();
  }
  epi(acc, m0, wr * 64, n0 + wc * 128, l15, quad, sR);
}

template <bool RS> struct EpiStore {
  bf16_t* C; int ldc;
  __device__ __forceinline__ void operator()(f32x4 (&acc)[4][8], int m0, int rl0, int cb, int l15, int quad, const float* sR) const {
#pragma unroll
    for (int m = 0; m < 4; ++m) {
      const int rl = rl0 + 16 * m + l15; const float rs = RS ? sR[rl] : 1.f;
      bf16_t* rp = C + (size_t)(m0 + rl) * ldc + cb + 4 * quad;
#pragma unroll
      for (int n = 0; n < 8; ++n) { const f32x4 v = acc[m][n] * rs; u32x2 w; w.x = cvtpk(v[0], v[1]); w.y = cvtpk(v[2], v[3]); *(u32x2*)(rp + 16 * n) = w; }
    }
  }
};
struct EpiInAB {
  bf16_t* Z; const float* gq; const float* gk; const float2* rope;
  __device__ __forceinline__ void operator()(f32x4 (&acc)[4][8], int m0, int rl0, int cb0, int l15, int quad, const float* sR) const {
#pragma unroll
    for (int hh = 0; hh < 2; ++hh) {
      const int cb = cb0 + 64 * hh;
      if (cb >= 640) {
#pragma unroll
        for (int m = 0; m < 4; ++m) {
          const int rl = rl0 + 16 * m + l15; const float rs = sR[rl];
          bf16_t* rp = Z + (size_t)(m0 + rl) * ZW + cb + 4 * quad;
#pragma unroll
          for (int n = 0; n < 4; ++n) { const f32x4 v = acc[m][4 * hh + n] * rs; u32x2 w; w.x = cvtpk(v[0], v[1]); w.y = cvtpk(v[2], v[3]); *(u32x2*)(rp + 16 * n) = w; }
        }
      } else {
        const float* g = cb < 512 ? gq : gk;
        const float qs = cb < 512 ? 0.125f * LOG2E : 1.0f;
        f32x4 gv[4];
#pragma unroll
        for (int n = 0; n < 4; ++n) gv[n] = *(const f32x4*)(g + 16 * n + 4 * quad) * qs;
#pragma unroll
        for (int m = 0; m < 4; ++m) {
          const int rl = rl0 + 16 * m + l15; const int row = m0 + rl; const float rs = sR[rl];
          f32x4 z[4]; float s2 = 0.f;
#pragma unroll
          for (int n = 0; n < 4; ++n) { z[n] = acc[m][4 * hh + n] * rs; s2 += z[n][0] * z[n][0] + z[n][1] * z[n][1] + z[n][2] * z[n][2] + z[n][3] * z[n][3]; }
          s2 += __shfl_xor(s2, 16); s2 += __shfl_xor(s2, 32);
          const float r = rsqrtf(s2 * (1.0f / 64.0f) + EPS);
          const int pos = row < NPROMPT ? (row & 2047) : (row & 16383);
          const int gr = pos >> 6, gc = pos & 63;
          bf16_t* rp = Z + (size_t)row * ZW + cb + 4 * quad;
#pragma unroll
          for (int n = 0; n < 4; ++n) {
            const int ap = (n < 2) ? gr : gc;
            const f32x4 zn = z[n] * r * gv[n];
            float2 c0, c1; { const unsigned long long w0 = __hip_atomic_load((const unsigned long long*)(rope + ap * 16 + ((8 * n + 2 * quad) & 15)), __ATOMIC_RELAXED, __HIP_MEMORY_SCOPE_AGENT), w1 = __hip_atomic_load((const unsigned long long*)(rope + ap * 16 + ((8 * n + 2 * quad + 1) & 15)), __ATOMIC_RELAXED, __HIP_MEMORY_SCOPE_AGENT); c0.x = __uint_as_float((unsigned)w0); c0.y = __uint_as_float((unsigned)(w0 >> 32)); c1.x = __uint_as_float((unsigned)w1); c1.y = __uint_as_float((unsigned)(w1 >> 32)); }
            const float o0 = zn[0] * c0.x - zn[1] * c0.y, o1 = zn[0] * c0.y + zn[1] * c0.x;
            const float o2 = zn[2] * c1.x - zn[3] * c1.y, o3 = zn[2] * c1.y + zn[3] * c1.x;
            u32x2 w; w.x = cvtpk(o0, o1); w.y = cvtpk(o2, o3); *(u32x2*)(rp + 16 * n) = w;
          }
        }
      }
    }
  }
};
struct EpiResid {
  const float* src_tile; float* dst;
  __device__ __forceinline__ void operator()(f32x4 (&acc)[4][8], int m0, int rl0, int cb, int l15, int quad, const float* sR) const {
#pragma unroll
    for (int m = 0; m < 4; ++m) {
      const int rl = rl0 + 16 * m + l15;
      const float* sp = src_tile + (size_t)rl * 1024 + cb + 4 * quad; float* dp = dst + (size_t)(m0 + rl) * 1024 + cb + 4 * quad;
#pragma unroll
      for (int n = 0; n < 8; ++n) { const f32x4 x = ld_agent_f32x4(sp + 16 * n); *(f32x4*)(dp + 16 * n) = x + acc[m][n]; }
    }
  }
};
struct EpiSwiGLU {
  bf16_t* H;
  __device__ __forceinline__ void operator()(f32x4 (&acc)[4][8], int m0, int rl0, int cb, int l15, int quad, const float* sR) const {
    const int hc0 = (cb >> 8) * 128 + ((cb >> 7) & 1) * 64 + 4 * quad;
#pragma unroll
    for (int m = 0; m < 4; ++m) {
      const int rl = rl0 + 16 * m + l15; const float rs = sR[rl];
      bf16_t* rp = H + (size_t)(m0 + rl) * DFF + hc0;
#pragma unroll
      for (int pp = 0; pp < 4; ++pp) {
        const f32x4 g = acc[m][2 * pp] * rs, u = acc[m][2 * pp + 1] * rs; float h[4];
#pragma unroll
        for (int j = 0; j < 4; ++j) h[j] = g[j] / (1.0f + __expf(-g[j])) * u[j];
        u32x2 w; w.x = cvtpk(h[0], h[1]); w.y = cvtpk(h[2], h[3]); *(u32x2*)(rp + 16 * pp) = w;
      }
    }
  }
};

template <int DH, int KT, int NQT, bool PF, class Ctx>
__device__ __forceinline__ void attn_item(unsigned char* smem, const Ctx& c) {
  constexpr int LDK = DH + 8, CH = DH / 8, NCH = KT * CH / 256, NKS = DH / 32, NK4 = KT / 16, NKK = KT / 32, NDT = DH / 16;
  bf16_t* sK = (bf16_t*)smem; bf16_t* sV = sK + KT * LDK;
  const int tid = get_tid(), lane = tid & 63;
  const int wid = __builtin_amdgcn_readfirstlane(tid >> 6);
  const int l15 = lane & 15, quad = lane >> 4;
  bf16x8 qf[NQT][NKS];
#pragma unroll
  for (int qt = 0; qt < NQT; ++qt) {
    const bf16_t* qp = c.qptr(wid, qt * 16 + l15);
#pragma unroll
    for (int ks = 0; ks < NKS; ++ks) qf[qt][ks] = __builtin_bit_cast(bf16x8, ld_agent_u32x4(qp + ks * 32 + quad * 8));
  }
  f32x4 o[NQT][NDT];
  float mrow[NQT], lrow[NQT];
#pragma unroll
  for (int qt = 0; qt < NQT; ++qt) {
    mrow[qt] = -1e30f; lrow[qt] = 0.f;
#pragma unroll
    for (int dt = 0; dt < NDT; ++dt) o[qt][dt] = (f32x4){0.f, 0.f, 0.f, 0.f};
  }
  const int nt = c.ntiles();
  u32x4 rk[NCH], rv[NCH];
  if constexpr (PF) {
#pragma unroll
    for (int i = 0; i < NCH; ++i) {
      const int ci = tid + 256 * i, row = ci / CH, ch = ci % CH;
      ld16_sc1(rk[i], c.kptr(0, row) + ch * 8); ld16_sc1(rv[i], c.vptr(0, row) + ch * 8);
    }
  }
  for (int t = 0; t < nt; ++t) {
    __syncthreads();
    if constexpr (PF) {
      static_assert(!PF || NCH == 2 || NCH == 4, "wait lists below are written for two or four chunks per matrix");
      if constexpr (NCH == 2) asm volatile("s_waitcnt vmcnt(0)" : "+v"(rk[0]), "+v"(rk[NCH - 1]), "+v"(rv[0]), "+v"(rv[NCH - 1]) :: "memory");
      else asm volatile("s_waitcnt vmcnt(0)" : "+v"(rk[0]), "+v"(rk[1]), "+v"(rk[NCH - 2]), "+v"(rk[NCH - 1]), "+v"(rv[0]), "+v"(rv[1]), "+v"(rv[NCH - 2]), "+v"(rv[NCH - 1]) :: "memory");
#pragma unroll
      for (int i = 0; i < NCH; ++i) {
        const int ci = tid + 256 * i, row = ci / CH, ch = ci % CH;
        *(u32x4*)(sK + row * LDK + ch * 8) = rk[i]; *(u32x4*)(sV + row * LDK + ch * 8) = rv[i];
      }
    } else {
#pragma unroll
      for (int i = 0; i < NCH; ++i) {
        const int ci = tid + 256 * i, row = ci / CH, ch = ci % CH;
        *(u32x4*)(sK + row * LDK + ch * 8) = ld_agent_u32x4(c.kptr(t, row) + ch * 8);
      }
#pragma unroll
      for (int i = 0; i < NCH; ++i) {
        const int ci = tid + 256 * i, row = ci / CH, ch = ci % CH;
        *(u32x4*)(sV + row * LDK + ch * 8) = ld_agent_u32x4(c.vptr(t, row) + ch * 8);
      }
    }
    __syncthreads();
    if constexpr (PF) {
      if (t + 1 < nt) {
#pragma unroll
        for (int i = 0; i < NCH; ++i) {
          const int ci = tid + 256 * i, row = ci / CH, ch = ci % CH;
          ld16_sc1(rk[i], c.kptr(t + 1, row) + ch * 8); ld16_sc1(rv[i], c.vptr(t + 1, row) + ch * 8);
        }
      }
    }
    if (c.active(t, wid)) {
      constexpr int QG = NQT < 2 ? NQT : 2;
      bf16x8 pfa[NQT][NKK];
#pragma unroll
      for (int g = 0; g < NQT; g += QG) {
        f32x4 s[QG][NK4];
#pragma unroll
        for (int q = 0; q < QG; ++q)
#pragma unroll
          for (int k4 = 0; k4 < NK4; ++k4) s[q][k4] = (f32x4){0.f, 0.f, 0.f, 0.f};
#pragma unroll
        for (int k4 = 0; k4 < NK4; ++k4)
#pragma unroll
          for (int ks = 0; ks < NKS; ++ks) {
            const bf16x8 kf = *(const bf16x8*)(sK + (16 * k4 + l15) * LDK + ks * 32 + quad * 8);
#pragma unroll
            for (int q = 0; q < QG; ++q) s[q][k4] = __builtin_amdgcn_mfma_f32_16x16x32_bf16(kf, qf[g + q][ks], s[q][k4], 0, 0, 0);
          }
#pragma unroll
        for (int q = 0; q < QG; ++q) {
          const int qt = g + q;
          float mx = -1e30f;
#pragma unroll
          for (int k4 = 0; k4 < NK4; ++k4)
#pragma unroll
            for (int j = 0; j < 4; ++j) { const float v = c.score(t, wid, qt * 16 + l15, 16 * k4 + 4 * quad + j, s[q][k4][j]); s[q][k4][j] = v; mx = fmaxf(mx, v); }
          mx = fmaxf(mx, __shfl_xor(mx, 16)); mx = fmaxf(mx, __shfl_xor(mx, 32));
          const float mnew = fmaxf(mrow[qt], mx);
          if (__any(mnew > mrow[qt])) {
            const float alpha = __builtin_amdgcn_exp2f(mrow[qt] - mnew);
            mrow[qt] = mnew;
            lrow[qt] *= alpha;
#pragma unroll
            for (int dt = 0; dt < NDT; ++dt) o[qt][dt] *= alpha;
          }
          float psum = 0.f;
#pragma unroll
          for (int k4 = 0; k4 < NK4; ++k4)
#pragma unroll
            for (int j = 0; j < 4; ++j) { const float pv = __builtin_amdgcn_exp2f(s[q][k4][j] - mnew); s[q][k4][j] = pv; psum += pv; }
          lrow[qt] += psum;
#pragma unroll
          for (int kk = 0; kk < NKK; ++kk) {
            u32x4 w;
            w.x = cvtpk(s[q][2 * kk][0], s[q][2 * kk][1]); w.y = cvtpk(s[q][2 * kk][2], s[q][2 * kk][3]);
            w.z = cvtpk(s[q][2 * kk + 1][0], s[q][2 * kk + 1][1]); w.w = cvtpk(s[q][2 * kk + 1][2], s[q][2 * kk + 1][3]);
            pfa[qt][kk] = __builtin_bit_cast(bf16x8, w);
          }
        }
      }
#pragma unroll
      for (int kk = 0; kk < NKK; ++kk) {
        const bf16_t* vb = sV + (32 * kk + 4 * quad + (l15 >> 2)) * LDK + 4 * (l15 & 3);
#pragma unroll
        for (int dt = 0; dt < NDT; ++dt) {
          const s16x4 lo = tr_read(vb + 16 * dt);
          const s16x4 hi = tr_read(vb + 16 * LDK + 16 * dt);
          const bf16x8 vf = (bf16x8){lo[0], lo[1], lo[2], lo[3], hi[0], hi[1], hi[2], hi[3]};
#pragma unroll
          for (int qt = 0; qt < NQT; ++qt) o[qt][dt] = __builtin_amdgcn_mfma_f32_16x16x32_bf16(vf, pfa[qt][kk], o[qt][dt], 0, 0, 0);
        }
      }
    }
  }
#pragma unroll
  for (int qt = 0; qt < NQT; ++qt) {
    float l = lrow[qt];
    l += __shfl_xor(l, 16); l += __shfl_xor(l, 32);
    const float inv = 1.0f / l;
    bf16_t* op = c.optr(wid, qt * 16 + l15) + 4 * quad;
#pragma unroll
    for (int dt = 0; dt < NDT; ++dt) { const f32x4 v = o[qt][dt] * inv; u32x2 w; w.x = cvtpk(v[0], v[1]); w.y = cvtpk(v[2], v[3]); *(u32x2*)(op + 16 * dt) = w; }
    if (quad == 0) c.store_lse(wid, qt * 16 + l15, mrow[qt] + __builtin_amdgcn_logf(l));
  }
}

struct CtxA {
  bf16_t* qbase; const bf16_t* kbase; int nt;
  __device__ __forceinline__ const bf16_t* qptr(int w, int ql) const { return qbase + (size_t)(64 * w + ql) * ZW; }
  __device__ __forceinline__ bf16_t* optr(int w, int ql) const { return qbase + (size_t)(64 * w + ql) * ZW; }
  __device__ __forceinline__ const bf16_t* kptr(int t, int r) const { return kbase + (size_t)(64 * t + r) * ZW; }
  __device__ __forceinline__ const bf16_t* vptr(int t, int r) const { return kbase + (size_t)(64 * t + r) * ZW + 128; }
  __device__ __forceinline__ int ntiles() const { return nt; }
  __device__ __forceinline__ bool active(int, int) const { return true; }
  __device__ __forceinline__ float score(int, int, int, int, float s) const { return s; }
  __device__ __forceinline__ void store_lse(int, int, float) const {}
};
struct CtxB {
  bf16_t* zs; float* lse; int d, r, L, i0, qcol, kcol, vcol; float slope_l2;
  __device__ __forceinline__ const bf16_t* qptr(int w, int ql) const { return zs + (size_t)((i0 + 32 * w + ql) * d + r) * ZW + qcol; }
  __device__ __forceinline__ bf16_t* optr(int w, int ql) const { return zs + (size_t)((i0 + 32 * w + ql) * d + r) * ZW + qcol; }
  __device__ __forceinline__ int kidx(int t, int row) const { int i = i0 - 64 + 64 * t + row; i = i < 0 ? 0 : i; return i > L - 1 ? L - 1 : i; }
  __device__ __forceinline__ const bf16_t* kptr(int t, int row) const { return zs + (size_t)(kidx(t, row) * d + r) * ZW + kcol; }
  __device__ __forceinline__ const bf16_t* vptr(int t, int row) const { return zs + (size_t)(kidx(t, row) * d + r) * ZW + vcol; }
  __device__ __forceinline__ int ntiles() const { return 4; }
  __device__ __forceinline__ bool active(int t, int w) const { return w < 2 ? (t < 3) : (t >= 1); }
  __device__ __forceinline__ float score(int t, int w, int ql, int kl, float s) const {
    const int qi = i0 + 32 * w + ql, ki = i0 - 64 + 64 * t + kl; int rel = ki - qi; rel = rel < 0 ? -rel : rel;
    const bool valid = (rel <= 64) && (ki >= 0) && (ki < L);
    return valid ? s * (0.125f * LOG2E) - slope_l2 * (float)rel : -1e30f;
  }
  __device__ __forceinline__ void store_lse(int w, int ql, float v) const { lse[i0 + 32 * w + ql] = v; }
};
struct CtxC {
  bf16_t* zs; const float* rpb; int R, r0, rb, hc;
  __device__ __forceinline__ const bf16_t* qptr(int w, int ql) const { return zs + (size_t)((r0 + w) * 64 + ql) * ZW + hc; }
  __device__ __forceinline__ bf16_t* optr(int w, int ql) const { return zs + (size_t)((r0 + w) * 64 + ql) * ZW + hc; }
  __device__ __forceinline__ int krow(int t) const { const int kr = rb + t; return kr > R - 1 ? R - 1 : kr; }
  __device__ __forceinline__ const bf16_t* kptr(int t, int row) const { return zs + (size_t)(krow(t) * 64 + row) * ZW + 1024 + hc; }
  __device__ __forceinline__ const bf16_t* vptr(int t, int row) const { return zs + (size_t)(krow(t) * 64 + row) * ZW + 2048 + hc; }
  __device__ __forceinline__ int ntiles() const { return 11; }
  __device__ __forceinline__ int rstart(int r) const { int rs = r - 4; rs = rs < 0 ? 0 : rs; return rs > R - 8 ? R - 8 : rs; }
  __device__ __forceinline__ bool active(int t, int w) const { const int r = r0 + w, rs = rstart(r), kr = rb + t; return kr >= rs && kr < rs + 8; }
  __device__ __forceinline__ float score(int t, int w, int ql, int kl, float s) const {
    const int r = r0 + w, cq = ql, kr = rb + t;
    int cs = cq - 8; cs = cs < 0 ? 0 : cs; cs = cs > 48 ? 48 : cs;
    const bool valid = (kl >= cs) && (kl < cs + 16);
    const int idx = valid ? (kr - r + 7) * 31 + (kl - cq + 15) : 0;
    const float b = rpb[idx];
    return valid ? (s * 0.125f + b) * LOG2E : -1e30f;
  }
  __device__ __forceinline__ void store_lse(int, int, float) const {}
};
struct CtxX {
  bf16_t* qbase; const bf16_t* kv;
  __device__ __forceinline__ const bf16_t* qptr(int w, int ql) const { return qbase + (size_t)(16 * w + ql) * 1024; }
  __device__ __forceinline__ bf16_t* optr(int w, int ql) const { return qbase + (size_t)(16 * w + ql) * 1024; }
  __device__ __forceinline__ const bf16_t* kptr(int t, int row) const { return kv + (size_t)(32 * t + row) * 2048; }
  __device__ __forceinline__ const bf16_t* vptr(int t, int row) const { return kv + (size_t)(32 * t + row) * 2048 + 1024; }
  __device__ __forceinline__ int ntiles() const { return 8; }
  __device__ __forceinline__ bool active(int, int) const { return true; }
  __device__ __forceinline__ float score(int, int, int, int, float s) const { return s * (0.0625f * LOG2E); }
  __device__ __forceinline__ void store_lse(int, int, float) const {}
};

__device__ __forceinline__ void wt_tile(unsigned char* smem, const float* src, int K, int N, const float* gain, bf16_t* dst, int perm, int t) {
  float* tl = (float*)smem;
  const int nkt = K >> 6; const int rt = t / nkt, kt = t - rt * nkt; const int R0 = rt * 64, k0 = kt * 64;
  const int tid = get_tid(); const int rr = tid & 63;
  const int R = R0 + rr; int sc = R;
  if (perm) { const int T = R >> 8, within = R & 255, wc = within >> 7, n = (within & 127) >> 4, i = within & 15; sc = (n & 1) * DFF + 128 * T + 64 * wc + 16 * (n >> 1) + i; }
  __syncthreads();
#pragma unroll 4
  for (int i = 0; i < 16; ++i) {
    const int kk = (tid >> 6) + 4 * i;
    float v = src[(size_t)(k0 + kk) * N + sc];
    if (gain) v *= gain[k0 + kk];
    tl[kk * 65 + rr] = v;
  }
  __syncthreads();
  const int r2 = tid >> 2, kq = tid & 3;
  u32x4 w0, w1;
  w0.x = cvtpk(tl[(16 * kq + 0) * 65 + r2], tl[(16 * kq + 1) * 65 + r2]); w0.y = cvtpk(tl[(16 * kq + 2) * 65 + r2], tl[(16 * kq + 3) * 65 + r2]);
  w0.z = cvtpk(tl[(16 * kq + 4) * 65 + r2], tl[(16 * kq + 5) * 65 + r2]); w0.w = cvtpk(tl[(16 * kq + 6) * 65 + r2], tl[(16 * kq + 7) * 65 + r2]);
  w1.x = cvtpk(tl[(16 * kq + 8) * 65 + r2], tl[(16 * kq + 9) * 65 + r2]); w1.y = cvtpk(tl[(16 * kq + 10) * 65 + r2], tl[(16 * kq + 11) * 65 + r2]);
  w1.z = cvtpk(tl[(16 * kq + 12) * 65 + r2], tl[(16 * kq + 13) * 65 + r2]); w1.w = cvtpk(tl[(16 * kq + 14) * 65 + r2], tl[(16 * kq + 15) * 65 + r2]);
  bf16_t* dp = dst + ((size_t)((k0 + 16 * kq) >> 5) * N + (R0 + r2)) * 32 + ((16 * kq) & 31);
  *(u32x4*)dp = w0; *(u32x4*)(dp + 8) = w1;
}
__device__ __forceinline__ void wt_matrix(unsigned char* smem, const float* src, int K, int N, const float* gain, bf16_t* dst, int perm) {
  const int ntile = (K >> 6) * (N >> 6);
  for (int t = blockIdx.x; t < ntile; t += gridDim.x) wt_tile(smem, src, K, N, gain, dst, perm, t);
}

__device__ __forceinline__ void tile_seq(int tt, int& seqbase, int& qb, int& S) {
  if (tt < 256) { seqbase = (tt >> 4) * 2048; qb = tt & 15; S = 2048; }
  else { const int u = tt - 256; seqbase = NPROMPT + (u >> 7) * 16384; qb = u & 127; S = 16384; }
}

typedef const __attribute__((address_space(4))) Params* KParams;
__device__ __forceinline__ void run_phase(int ph, KParams kp, unsigned char* smem) {
  unsigned char* ws = kp->ws;
  bf16_t* Z = (bf16_t*)(ws + WS_Z);
  const int tid = get_tid();
  const int L = ph >= 10 ? 1 : 0;
  switch (ph) {
    case 0: {
      wt_matrix(smem, kp->w_in_ab, 1024, 3072, kp->g_mix, (bf16_t*)(ws + WS_WT_IN_AB), 0);
      wt_matrix(smem, kp->w_out_ab, 768, 1024, nullptr, (bf16_t*)(ws + WS_WT_OUT_AB), 0);
      wt_matrix(smem, kp->w_in_c, 1024, 3072, kp->g_mix + 1024, (bf16_t*)(ws + WS_WT_IN_C), 0);
      wt_matrix(smem, kp->w_out_c, 1024, 1024, nullptr, (bf16_t*)(ws + WS_WT_OUT_C), 0);
      for (int l = 0; l < 2; ++l) {
        wt_matrix(smem, kp->wq_x + (size_t)l * 1024 * 1024, 1024, 1024, kp->g_xattn + l * 1024, (bf16_t*)(ws + WS_WT_Q) + (size_t)l * 1024 * 1024, 0);
        wt_matrix(smem, kp->wkv_x + (size_t)l * 1024 * 2048, 1024, 2048, kp->g_mem + l * 1024, (bf16_t*)(ws + WS_WT_KV) + (size_t)l * 2048 * 1024, 0);
        wt_matrix(smem, kp->wo_x + (size_t)l * 1024 * 1024, 1024, 1024, nullptr, (bf16_t*)(ws + WS_WT_O) + (size_t)l * 1024 * 1024, 0);
        wt_matrix(smem, kp->w_gu + (size_t)l * 1024 * 5632, 1024, 5632, kp->g_ffn + l * 1024, (bf16_t*)(ws + WS_WT_GU) + (size_t)l * 5632 * 1024, 1);
        wt_matrix(smem, kp->w_down + (size_t)l * DFF * 1024, DFF, 1024, nullptr, (bf16_t*)(ws + WS_WT_DOWN) + (size_t)l * 1024 * DFF, 0);
      }
      const int gi = blockIdx.x * 256 + tid;
      if (gi < 4096) {
        const int pos = gi >> 4, f = gi & 15;
        const float inv_freq = exp2f(-(float)f * 0.83048202372184058696f);
        const float ang = (float)pos * inv_freq;
        float2 cs; cs.x = cosf(ang); cs.y = sinf(ang);
        ((float2*)(ws + WS_ROPE))[gi] = cs;
      }
    } break;
    case 1: {
      const int n_ab = 512 * 12, n_kv = 36 * 8;
      for (int t = blockIdx.x; t < n_ab + 2 * n_kv; t += gridDim.x) {
        if (t < n_ab) {
          int mt, nt; tile_map(t, 12, gridDim.x, mt, nt);
          EpiInAB e{Z, kp->g_qn, kp->g_kn, (const float2*)(ws + WS_ROPE)};
          gemm_tile<true>(smem, xin_row(kp->x_prompt, kp->x_sample, mt * 128), 1024, (const bf16_t*)(ws + WS_WT_IN_AB), 3072, 1024, e, mt * 128, nt * 256);
        } else {
          int u = t - n_ab; const int l = u / n_kv; u -= l * n_kv; const int mt = u >> 3, nt = u & 7;
          EpiStore<true> e{(bf16_t*)(ws + WS_KVMEM) + (size_t)l * 4608 * 2048, 2048};
          gemm_tile<true>(smem, mem_row(kp->mem_prompt, kp->mem_sample, mt * 128), 1024, (const bf16_t*)(ws + WS_WT_KV) + (size_t)l * 2048 * 1024, 2048, 1024, e, mt * 128, nt * 256);
        }
      }
    } break;
    case 2: {
      for (int it = blockIdx.x; it < 2048 + 6144; it += gridDim.x) {
        if (it < 2048) {
          int seqbase, qi, h, nt;
          if (gridDim.x == 512) {
            const int bid = blockIdx.x, i = it >> 9, xcd = bid & 7, l = (bid >> 3) + 64 * (i & 1);
            if (it < 1024) { const int g = xcd >> 1, id = l * 2 + (xcd & 1); qi = id >> 2; h = (g & 1) * 4 + (id & 3); seqbase = NPROMPT + (g >> 1) * 16384; nt = 256; }
            else { const int grp = xcd + 8 * (l >> 5), id = l & 31; qi = id >> 2; h = (grp & 1) * 4 + (id & 3); seqbase = (grp >> 1) * 2048; nt = 32; }
          } else if (it < 1024) { const int s = it >> 9, rem = it & 511; qi = rem >> 3; h = rem & 7; seqbase = NPROMPT + s * 16384; nt = 256; }
          else { const int a = it - 1024; const int s = a >> 6, rem = a & 63; qi = rem >> 3; h = rem & 7; seqbase = s * 2048; nt = 32; }
          CtxA c{Z + (size_t)(seqbase + 256 * qi) * ZW + h * 64, Z + (size_t)seqbase * ZW + 512 + (h >> 2) * 64, nt};
          attn_item<64, 64, 4, true>(smem, c);
        } else {
          const int b = it - 2048; const int h = b & 3, g = (b >> 2) % 3, tt = b / 12;
          int seqbase, qb, S; tile_seq(tt, seqbase, qb, S);
          const int d = g == 0 ? 1 : (g == 1 ? 4 : 16);
          const int Ls = S / d, nb = Ls >> 7; const int r = qb / nb, mblk = qb - r * nb;
          const float slope = exp2f(-8.0f * (float)(4 * g + h + 1) / 12.0f);
          CtxB c{Z + (size_t)seqbase * ZW, (float*)(ws + WS_LSE) + (size_t)(g * 4 + h) * NTOK + seqbase + r * Ls, d, r, Ls, mblk * 128,
                 768 + ((0 * 3 + g) * 4 + h) * 64, 768 + ((1 * 3 + g) * 4 + h) * 64, 768 + ((2 * 3 + g) * 4 + h) * 64, slope * (float)d * LOG2E};
          attn_item<64, 64, 2, true>(smem, c);
        }
      }
    } break;
    case 3: {
      const float* lse = (const float*)(ws + WS_LSE);
      for (int i = blockIdx.x * 256 + tid; i < NTOK * 32; i += gridDim.x * 256) {
        const int T = i >> 5, h = (i >> 3) & 3, c8 = i & 7;
        int sb, pos, lg;
        if (T < NPROMPT) { sb = T & ~2047; pos = T & 2047; lg = 11; } else { sb = NPROMPT + ((T - NPROMPT) & ~16383); pos = (T - NPROMPT) & 16383; lg = 14; }
        const float l0 = ld_agent_f32(lse + (size_t)(0 * 4 + h) * NTOK + sb + pos);
        const float l1 = ld_agent_f32(lse + (size_t)(1 * 4 + h) * NTOK + sb + ((pos & 3) << (lg - 2)) + (pos >> 2));
        const float l2 = ld_agent_f32(lse + (size_t)(2 * 4 + h) * NTOK + sb + ((pos & 15) << (lg - 4)) + (pos >> 4));
        const float mx = fmaxf(l0, fmaxf(l1, l2));
        float w0 = __builtin_amdgcn_exp2f(l0 - mx), w1 = __builtin_amdgcn_exp2f(l1 - mx), w2 = __builtin_amdgcn_exp2f(l2 - mx);
        const float inv = 1.0f / (w0 + w1 + w2); w0 *= inv; w1 *= inv; w2 *= inv;
        const bf16_t* zr = Z + (size_t)T * ZW;
        const u32x4 a = ld_agent_u32x4(zr + 768 + (0 * 4 + h) * 64 + c8 * 8), b = ld_agent_u32x4(zr + 768 + (1 * 4 + h) * 64 + c8 * 8), cc = ld_agent_u32x4(zr + 768 + (2 * 4 + h) * 64 + c8 * 8);
        u32x4 o;
#pragma unroll
        for (int k = 0; k < 4; ++k) {
          const float lo = w0 * bf2f((unsigned short)(a[k] & 0xffff)) + w1 * bf2f((unsigned short)(b[k] & 0xffff)) + w2 * bf2f((unsigned short)(cc[k] & 0xffff));
          const float hi = w0 * bf2f((unsigned short)(a[k] >> 16)) + w1 * bf2f((unsigned short)(b[k] >> 16)) + w2 * bf2f((unsigned short)(cc[k] >> 16));
          o[k] = cvtpk(lo, hi);
        }
        *(u32x4*)(Z + (size_t)T * ZW + 512 + h * 64 + c8 * 8) = o;
      }
    } break;
    case 4: case 7: case 9: case 12: case 15: case 17: {
      const bf16_t* A; int lda, K; const bf16_t* Bt;
      if (ph == 4) { A = Z; lda = ZW; K = 768; Bt = (const bf16_t*)(ws + WS_WT_OUT_AB); }
      else if (ph == 12) { A = Z; lda = ZW; K = 1024; Bt = (const bf16_t*)(ws + WS_WT_OUT_C); }
      else if (ph == 7 || ph == 15) { A = Z; lda = 1024; K = 1024; Bt = (const bf16_t*)(ws + WS_WT_O) + (size_t)L * 1024 * 1024; }
      else { A = Z; lda = DFF; K = DFF; Bt = (const bf16_t*)(ws + WS_WT_DOWN) + (size_t)L * 1024 * DFF; }
      for (int t = blockIdx.x; t < 512 * 4; t += gridDim.x) {
        int mt, nt; tile_map(t, 4, gridDim.x, mt, nt);
        EpiResid e{ph == 4 ? xin_row(kp->x_prompt, kp->x_sample, mt * 128) : kp->out + (size_t)mt * 128 * 1024, kp->out};
        gemm_tile<false>(smem, A + (size_t)mt * 128 * lda, lda, Bt, 1024, K, e, mt * 128, nt * 256);
      }
    } break;
    case 5: case 10: case 13: {
      const bf16_t* Bt; int NT, ldc;
      if (ph == 10) { Bt = (const bf16_t*)(ws + WS_WT_IN_C); NT = 12; ldc = ZW; }
      else { Bt = (const bf16_t*)(ws + WS_WT_Q) + (size_t)L * 1024 * 1024; NT = 4; ldc = 1024; }
      for (int t = blockIdx.x; t < 512 * NT; t += gridDim.x) {
        int mt, nt; tile_map(t, NT, gridDim.x, mt, nt);
        EpiStore<true> e{Z, ldc};
        gemm_tile<true>(smem, kp->out + (size_t)mt * 128 * 1024, 1024, Bt, NT * 256, 1024, e, mt * 128, nt * 256);
      }
    } break;
    case 6: case 14: {
      const bf16_t* kvm = (const bf16_t*)(ws + WS_KVMEM) + (size_t)L * 4608 * 2048;
      for (int it = blockIdx.x; it < 4096; it += gridDim.x) {
        int idx = it; if (gridDim.x == 512) idx = (blockIdx.x & 7) * 512 + (blockIdx.x >> 3) + 64 * (it >> 9);
        const int h = idx & 3, tile = idx >> 2, T0 = tile * 64;
        const int bidx = T0 < NPROMPT ? (T0 >> 11) : 16 + ((T0 - NPROMPT) >> 14);
        CtxX c{Z + (size_t)T0 * 1024 + h * 256, kvm + (size_t)bidx * 256 * 2048 + h * 256};
        attn_item<256, 32, 1, true>(smem, c);
      }
    } break;
    case 8: case 16: {
      const bf16_t* Bt = (const bf16_t*)(ws + WS_WT_GU) + (size_t)L * 5632 * 1024;
      for (int t = blockIdx.x; t < 512 * 22; t += gridDim.x) {
        int mt, nt; tile_map(t, 22, gridDim.x, mt, nt);
        EpiSwiGLU e{Z};
        gemm_tile<true>(smem, kp->out + (size_t)mt * 128 * 1024, 1024, Bt, 5632, 1024, e, mt * 128, nt * 256);
      }
    } break;
    case 11: {
      float* srpb = (float*)(smem + 2 * 64 * 72 * 2);
      for (int it = blockIdx.x; it < 4096; it += gridDim.x) {
        int h = it & 15, t4 = it >> 4;
        if (gridDim.x == 512) { const int l = (blockIdx.x >> 3) + 64 * (it >> 9); h = 2 * (blockIdx.x & 7) + (l & 1); t4 = l >> 1; }
        int seqbase, rq, R;
        if (t4 < 128) { seqbase = (t4 >> 3) * 2048; rq = t4 & 7; R = 32; } else { const int u = t4 - 128; seqbase = NPROMPT + (u >> 6) * 16384; rq = u & 63; R = 256; }
        const int r0 = 4 * rq;
        int rb = r0 - 4; rb = rb < 0 ? 0 : rb; rb = rb > R - 8 ? R - 8 : rb;
        __syncthreads();
        for (int i = tid; i < 15 * 31; i += 256) srpb[i] = kp->rpb_c[h * 15 * 31 + i];
        CtxC c{Z + (size_t)seqbase * ZW, srpb, R, r0, rb, h * 64};
        attn_item<64, 64, 4, true>(smem, c);
      }
    } break;
    case 18: {
      const int lane = tid & 63, wv = blockIdx.x * 4 + (tid >> 6), nwv = gridDim.x * 4;
      for (int row = wv; row < NTOK; row += nwv) {
        float* xr = kp->out + (size_t)row * 1024;
        f32x4 v[4]; float s = 0.f;
#pragma unroll
        for (int i = 0; i < 4; ++i) { v[i] = ld_agent_f32x4(xr + i * 256 + lane * 4); s += v[i][0] * v[i][0] + v[i][1] * v[i][1] + v[i][2] * v[i][2] + v[i][3] * v[i][3]; }
        s += __shfl_xor(s, 1); s += __shfl_xor(s, 2); s += __shfl_xor(s, 4); s += __shfl_xor(s, 8); s += __shfl_xor(s, 16); s += __shfl_xor(s, 32);
        const float r = rsqrtf(s * (1.0f / 1024.0f) + EPS);
#pragma unroll
        for (int i = 0; i < 4; ++i) { const f32x4 g = *(const f32x4*)(kp->g_final + i * 256 + lane * 4); *(f32x4*)(xr + i * 256 + lane * 4) = v[i] * r * g; }
      }
    } break;
    default: break;
  }
}

constexpr int NPHASE = 19;
constexpr size_t WS_BAR = WS_END + 65536;

__device__ __forceinline__ void xcd_grid_barrier(unsigned* st) {
  __syncthreads();
  if (threadIdx.x == 0) {
    __threadfence();
    const unsigned nb = gridDim.x;
    const unsigned ng = (nb & 7u) == 0u ? 8u : 1u, grp = ng == 8u ? (blockIdx.x & 7u) : 0u, per = nb / ng;
    const unsigned gen = __hip_atomic_load(st + 32 * 9, __ATOMIC_RELAXED, __HIP_MEMORY_SCOPE_AGENT);
    if (__hip_atomic_fetch_add(st + 32 * grp, 1u, __ATOMIC_RELAXED, __HIP_MEMORY_SCOPE_AGENT) == per - 1u) {
      __hip_atomic_store(st + 32 * grp, 0u, __ATOMIC_RELAXED, __HIP_MEMORY_SCOPE_AGENT);
      if (__hip_atomic_fetch_add(st + 32 * 8, 1u, __ATOMIC_RELEASE, __HIP_MEMORY_SCOPE_AGENT) == ng - 1u) {
        __hip_atomic_store(st + 32 * 8, 0u, __ATOMIC_RELAXED, __HIP_MEMORY_SCOPE_AGENT);
        __hip_atomic_fetch_add(st + 32 * 9, 1u, __ATOMIC_RELEASE, __HIP_MEMORY_SCOPE_AGENT);
      }
    }
    while (__hip_atomic_load(st + 32 * 9, __ATOMIC_RELAXED, __HIP_MEMORY_SCOPE_AGENT) == gen) __builtin_amdgcn_s_sleep(1);
    __threadfence();
  }
  __syncthreads();
}

template <bool COOP>
__global__ void __launch_bounds__(256, 2) mega(Params p) {
  __shared__ __attribute__((aligned(16))) unsigned char smem[SMEM_BYTES];
  if constexpr (COOP) {
    cg::grid_group grid = cg::this_grid();
#define STEP(PH) { KParams kp = (KParams)__builtin_amdgcn_kernarg_segment_ptr(); asm volatile("" : "+s"(kp)); run_phase(PH, kp, smem); if (PH + 1 < NPHASE) { if (PH == 0) grid.sync(); else xcd_grid_barrier((unsigned*)(kp->ws + WS_BAR)); } }
    STEP(0) STEP(1) STEP(2) STEP(3) STEP(4) STEP(5) STEP(6) STEP(7) STEP(8) STEP(9)
    STEP(10) STEP(11) STEP(12) STEP(13) STEP(14) STEP(15) STEP(16) STEP(17) STEP(18)
#undef STEP
  } else {
    for (int ph = p.phase_lo; ph < p.phase_hi; ++ph) {
      KParams kp = (KParams)__builtin_amdgcn_kernarg_segment_ptr();
      asm volatile("" : "+s"(kp));
      run_phase(ph, kp, smem);
    }
  }
}

extern "C" void kernel_launch(void* const* d_in, const int* in_sizes, int n_in, void* d_out, int out_size, void* d_ws, size_t ws_size, hipStream_t stream) {
  static int grid = 0;
  if (grid == 0) {
    if (n_in != 21 || ws_size < WS_BAR + 2048) { fprintf(stderr, "kernel_launch: n_in %d ws %zu (need %zu)\n", n_in, ws_size, (size_t)WS_END); grid = -1; return; }
    int dev = 0, cus = 0, per_cu = 0;
    hipGetDevice(&dev);
    hipDeviceGetAttribute(&cus, hipDeviceAttributeMultiprocessorCount, dev);
#if MULTI_LAUNCH
    hipOccupancyMaxActiveBlocksPerMultiprocessor(&per_cu, (const void*)mega<false>, 256, 0);
#else
    hipOccupancyMaxActiveBlocksPerMultiprocessor(&per_cu, (const void*)mega<true>, 256, 0);
#endif
    if (per_cu < 1) per_cu = 1;
    if (per_cu > 2) per_cu = 2;
    grid = cus * per_cu;
  }
  if (grid < 0) return;
  Params p{};
  p.x_prompt = (const float*)d_in[0]; p.x_sample = (const float*)d_in[1]; p.mem_prompt = (const float*)d_in[2]; p.mem_sample = (const float*)d_in[3];
  p.g_mix = (const float*)d_in[4]; p.w_in_ab = (const float*)d_in[5]; p.g_qn = (const float*)d_in[6]; p.g_kn = (const float*)d_in[7]; p.w_out_ab = (const float*)d_in[8];
  p.w_in_c = (const float*)d_in[9]; p.rpb_c = (const float*)d_in[10]; p.w_out_c = (const float*)d_in[11]; p.g_xattn = (const float*)d_in[12]; p.g_mem = (const float*)d_in[13];
  p.wq_x = (const float*)d_in[14]; p.wkv_x = (const float*)d_in[15]; p.wo_x = (const float*)d_in[16]; p.g_ffn = (const float*)d_in[17]; p.w_gu = (const float*)d_in[18]; p.w_down = (const float*)d_in[19];
  p.g_final = (const float*)d_in[20];
  p.out = (float*)d_out; p.ws = (unsigned char*)d_ws;
#if MULTI_LAUNCH
  for (int ph = 0; ph < NPHASE; ++ph) {
    p.phase_lo = ph; p.phase_hi = ph + 1;
    hipLaunchKernelGGL(mega<false>, dim3(grid), dim3(256), 0, stream, p);
  }
#else
  p.phase_lo = 0; p.phase_hi = NPHASE;
  void* args[] = {&p};
  hipMemsetAsync((unsigned char*)d_ws + WS_BAR, 0, 2048, stream);
  hipError_t e = hipLaunchCooperativeKernel((const void*)mega<true>, dim3(grid), dim3(256), args, 0, stream);
  if (e != hipSuccess) fprintf(stderr, "cooperative launch failed: %s (grid %d)\n", hipGetErrorString(e), grid);
#endif
}
#ifdef DBG_RES
template <int PH> __global__ void __launch_bounds__(256, 2) mega_one(Params p) {
  __shared__ __attribute__((aligned(16))) unsigned char smem[SMEM_BYTES];
  run_phase(PH, (KParams)__builtin_amdgcn_kernarg_segment_ptr(), smem);
}
template __global__ void mega_one<0>(Params); template __global__ void mega_one<1>(Params); template __global__ void mega_one<2>(Params);
template __global__ void mega_one<3>(Params); template __global__ void mega_one<4>(Params); template __global__ void mega_one<5>(Params);
template __global__ void mega_one<6>(Params); template __global__ void mega_one<8>(Params); template __global__ void mega_one<11>(Params);
template __global__ void mega_one<18>(Params);
#endif
```

```cpp
#include <hip/hip_runtime.h>
#include <hip/hip_cooperative_groups.h>
#include <cstdint>
#include <cstdio>
namespace cg = cooperative_groups;

#ifndef MULTI_LAUNCH
#define MULTI_LAUNCH 0
#endif

typedef unsigned short bf16_t;
typedef short bf16x8 __attribute__((ext_vector_type(8)));
typedef short s16x4 __attribute__((ext_vector_type(4)));
typedef short v4i16_t __attribute__((ext_vector_type(4)));
typedef float f32x4 __attribute__((ext_vector_type(4)));
typedef float f32x2_t __attribute__((ext_vector_type(2)));
typedef __bf16 bf16x2_t __attribute__((ext_vector_type(2)));
typedef unsigned u32x4 __attribute__((ext_vector_type(4)));
typedef unsigned u32x2 __attribute__((ext_vector_type(2)));

#define LOG2E 1.4426950408889634f
constexpr int NTOK = 65536;
constexpr int NPROMPT = 32768;
constexpr int ZW = 3072;
constexpr int DFF = 2816;
constexpr float EPS = 1e-6f;

constexpr size_t WS_WT_IN_AB = 0;
constexpr size_t WS_WT_OUT_AB = WS_WT_IN_AB + (size_t)3072 * 1024 * 2;
constexpr size_t WS_WT_IN_C = WS_WT_OUT_AB + (size_t)1024 * 768 * 2;
constexpr size_t WS_WT_OUT_C = WS_WT_IN_C + (size_t)3072 * 1024 * 2;
constexpr size_t WS_WT_Q = WS_WT_OUT_C + (size_t)1024 * 1024 * 2;
constexpr size_t WS_WT_KV = WS_WT_Q + (size_t)2 * 1024 * 1024 * 2;
constexpr size_t WS_WT_O = WS_WT_KV + (size_t)2 * 2048 * 1024 * 2;
constexpr size_t WS_WT_GU = WS_WT_O + (size_t)2 * 1024 * 1024 * 2;
constexpr size_t WS_WT_DOWN = WS_WT_GU + (size_t)2 * 5632 * 1024 * 2;
constexpr size_t WS_KVMEM = WS_WT_DOWN + (size_t)2 * 1024 * 2816 * 2;
constexpr size_t WS_LSE = WS_KVMEM + (size_t)2 * 4608 * 2048 * 2;
constexpr size_t WS_ROPE = WS_LSE + (size_t)3 * 65536 * 4 * 4;
constexpr size_t WS_Z = WS_ROPE + (size_t)256 * 16 * 8;
constexpr size_t WS_END = WS_Z + (size_t)NTOK * ZW * 2;

constexpr int SMEM_BYTES = 2 * (128 + 256) * 40 * 2 + 512;

struct Params {
  const float* x_prompt; const float* x_sample; const float* mem_prompt; const float* mem_sample;
  const float* g_mix; const float* w_in_ab; const float* g_qn; const float* g_kn; const float* w_out_ab;
  const float* w_in_c; const float* rpb_c; const float* w_out_c; const float* g_xattn; const float* g_mem;
  const float* wq_x; const float* wkv_x; const float* wo_x; const float* g_ffn; const float* w_gu; const float* w_down;
  const float* g_final;
  float* out; unsigned char* ws;
  int phase_lo, phase_hi;
};

__device__ __forceinline__ int get_tid() { int t = threadIdx.x; asm volatile("" : "+v"(t)); return t; }
__device__ __forceinline__ unsigned cvtpk(float lo, float hi) { f32x2_t v = {lo, hi}; bf16x2_t b = __builtin_convertvector(v, bf16x2_t); return __builtin_bit_cast(unsigned, b); }
__device__ __forceinline__ float bf2f(unsigned short h) { return __uint_as_float(((unsigned)h) << 16); }
__device__ __forceinline__ s16x4 tr_read(const bf16_t* p) {
  return __builtin_bit_cast(s16x4, __builtin_amdgcn_ds_read_tr16_b64_v4i16((__attribute__((address_space(3))) v4i16_t*)p));
}
__device__ __forceinline__ const float* xin_row(const float* xp, const float* xs, int row) {
  return row < NPROMPT ? xp + (size_t)row * 1024 : xs + (size_t)(row - NPROMPT) * 1024;
}
__device__ __forceinline__ const float* mem_row(const float* mp, const float* ms, int row) {
  return row < 4096 ? mp + (size_t)row * 1024 : ms + (size_t)(row - 4096) * 1024;
}


__device__ __forceinline__ void ld16_sc1(u32x4& v, const void* p) { asm volatile("global_load_dwordx4 %0, %1, off sc1" : "=v"(v) : "v"(p) : "memory"); }
__device__ __forceinline__ void ld16_sc1(f32x4& v, const float* p) { asm volatile("global_load_dwordx4 %0, %1, off sc1" : "=v"(v) : "v"(p) : "memory"); }
__device__ __forceinline__ u32x4 ld_agent_u32x4(const void* p) {
  const unsigned long long a = __hip_atomic_load((const unsigned long long*)p, __ATOMIC_RELAXED, __HIP_MEMORY_SCOPE_AGENT);
  const unsigned long long b = __hip_atomic_load((const unsigned long long*)p + 1, __ATOMIC_RELAXED, __HIP_MEMORY_SCOPE_AGENT);
  return (u32x4){(unsigned)a, (unsigned)(a >> 32), (unsigned)b, (unsigned)(b >> 32)};
}
__device__ __forceinline__ float ld_agent_f32(const float* p) { return __uint_as_float(__hip_atomic_load((const unsigned*)p, __ATOMIC_RELAXED, __HIP_MEMORY_SCOPE_AGENT)); }
__device__ __forceinline__ f32x4 ld_agent_f32x4(const float* p) {
  const unsigned long long a = __hip_atomic_load((const unsigned long long*)p, __ATOMIC_RELAXED, __HIP_MEMORY_SCOPE_AGENT);
  const unsigned long long b = __hip_atomic_load((const unsigned long long*)p + 1, __ATOMIC_RELAXED, __HIP_MEMORY_SCOPE_AGENT);
  f32x4 v; v[0] = __uint_as_float((unsigned)a); v[1] = __uint_as_float((unsigned)(a >> 32)); v[2] = __uint_as_float((unsigned)b); v[3] = __uint_as_float((unsigned)(b >> 32)); return v;
}
__device__ __forceinline__ void tile_map(int t, int NT, int gdim, int& mt, int& nt) {
  if ((gdim & 7) == 0) {
    const int i = t / gdim, b = t - i * gdim; const int lt = (b >> 3) + (gdim >> 3) * i;
    const int mg = lt / (8 * NT), r = lt - mg * 8 * NT, c = r >> 6, r2 = r & 63;
    nt = 8 * c + (r2 >> 3); mt = (b & 7) + 8 * (8 * mg + (r2 & 7)); }
  else { mt = t / NT; nt = t - mt * NT; }
}
constexpr int GLD = 40;
constexpr int G_STAGE = (128 + 256) * GLD;
template <bool AF32, class Epi>
__device__ __forceinline__ void gemm_tile(unsigned char* smem, const void* Ap, int lda, const bf16_t* WT, int N, int K, const Epi& epi, int m0, int n0) {
  const int tid = get_tid(), lane = tid & 63;
  const int wid = __builtin_amdgcn_readfirstlane(tid >> 6);
  const int wr = wid >> 1, wc = wid & 1, l15 = lane & 15, quad = lane >> 4;
  bf16_t* sbase = (bf16_t*)smem; float* sR = (float*)(smem + 2 * G_STAGE * 2);
  f32x4 acc[4][8];
#pragma unroll
  for (int m = 0; m < 4; ++m)
#pragma unroll
    for (int n = 0; n < 8; ++n) acc[m][n] = (f32x4){0.f, 0.f, 0.f, 0.f};
  float ss[4];
#pragma unroll
  for (int i = 0; i < 4; ++i) ss[i] = 0.f;
  f32x4 ra[4]; u32x4 rab[2]; u32x4 rb[4];
  const int nk = K >> 5;
  const float* Af = (const float*)Ap + (size_t)(tid >> 3) * lda + (tid & 7) * 4;
  const bf16_t* Ab = (const bf16_t*)Ap + (size_t)(tid >> 2) * lda + (tid & 3) * 8;
  const bf16_t* Bp = WT + (size_t)n0 * 32 + tid * 8;
  const size_t bstep = (size_t)N * 32;
  const int awf = (tid >> 3) * GLD + (tid & 7) * 4;
  const int awb = (tid >> 2) * GLD + (tid & 3) * 8;
#define G_LOAD(kt_) do { \
    if constexpr (AF32) { _Pragma("unroll") for (int i = 0; i < 4; ++i) ld16_sc1(ra[i], Af + (size_t)i * 32 * lda + (kt_) * 32); } \
    else { _Pragma("unroll") for (int i = 0; i < 2; ++i) ld16_sc1(rab[i], Ab + (size_t)i * 64 * lda + (kt_) * 32); } \
    _Pragma("unroll") for (int i = 0; i < 4; ++i) ld16_sc1(rb[i], Bp + (size_t)(kt_) * bstep + i * 2048); } while (0)
#define G_STORE(st_) do { bf16_t* sa_ = sbase + (st_) * G_STAGE; bf16_t* sb_ = sa_ + 128 * GLD; \
    if constexpr (AF32) { asm volatile("s_waitcnt vmcnt(0)" : "+v"(ra[0]), "+v"(ra[1]), "+v"(ra[2]), "+v"(ra[3]), "+v"(rb[0]), "+v"(rb[1]), "+v"(rb[2]), "+v"(rb[3]) :: "memory"); \
      _Pragma("unroll") for (int i = 0; i < 4; ++i) { const f32x4 v = ra[i]; \
        ss[i] += v[0] * v[0] + v[1] * v[1] + v[2] * v[2] + v[3] * v[3]; \
        u32x2 w; w.x = cvtpk(v[0], v[1]); w.y = cvtpk(v[2], v[3]); *(u32x2*)(sa_ + awf + i * 32 * GLD) = w; } } \
    else { asm volatile("s_waitcnt vmcnt(0)" : "+v"(rab[0]), "+v"(rab[1]), "+v"(rb[0]), "+v"(rb[1]), "+v"(rb[2]), "+v"(rb[3]) :: "memory"); \
      _Pragma("unroll") for (int i = 0; i < 2; ++i) *(u32x4*)(sa_ + awb + i * 64 * GLD) = rab[i]; } \
    _Pragma("unroll") for (int i = 0; i < 4; ++i) *(u32x4*)(sb_ + awb + i * 64 * GLD) = rb[i]; } while (0)
  G_LOAD(0);
  G_STORE(0);
  if (nk > 1) G_LOAD(1);
  __syncthreads();
  for (int kt = 0; kt < nk; ++kt) {
    const int cur = kt & 1;
    if (kt + 1 < nk) G_STORE(cur ^ 1);
    if (kt + 2 < nk) G_LOAD(kt + 2);
    const bf16_t* a_s = sbase + cur * G_STAGE + (wr * 64 + l15) * GLD + quad * 8;
    const bf16_t* b_s = sbase + cur * G_STAGE + 128 * GLD + (wc * 128 + l15) * GLD + quad * 8;
    __builtin_amdgcn_s_setprio(1);
    bf16x8 af[4];
#pragma unroll
    for (int m = 0; m < 4; ++m) af[m] = *(const bf16x8*)(a_s + m * 16 * GLD);
#pragma unroll
    for (int nh = 0; nh < 4; ++nh) {
      bf16x8 bfr[2];
#pragma unroll
      for (int n2 = 0; n2 < 2; ++n2) bfr[n2] = *(const bf16x8*)(b_s + (nh * 2 + n2) * 16 * GLD);
#pragma unroll
      for (int m = 0; m < 4; ++m)
#pragma unroll
        for (int n2 = 0; n2 < 2; ++n2) acc[m][nh * 2 + n2] = __builtin_amdgcn_mfma_f32_16x16x32_bf16(bfr[n2], af[m], acc[m][nh * 2 + n2], 0, 0, 0);
    }
    __builtin_amdgcn_s_setprio(0);
    __syncthreads();
  }
#undef G_LOAD
#undef G_STORE
  if constexpr (AF32) {
    const float invK = 1.0f / (float)K;
#pragma unroll
    for (int i = 0; i < 4; ++i) {
      float s = ss[i];
      s += __shfl_xor(s, 1); s += __shfl_xor(s, 2); s += __shfl_xor(s, 4);
      if ((tid & 7) == 0) sR[(tid >> 3) + 32 * i] = rsqrtf(s * invK + EPS);
    }
    __syncthreads();
  }
  epi(acc, m0, wr * 64, n0 + wc * 128, l15, quad, sR);
}

template <bool RS> struct EpiStore {
  bf16_t* C; int ldc;
  __device__ __forceinline__ void operator()(f32x4 (&acc)[4][8], int m0, int rl0, int cb, int l15, int quad, const float* sR) const {
#pragma unroll
    for (int m = 0; m < 4; ++m) {
      const int rl = rl0 + 16 * m + l15; const float rs = RS ? sR[rl] : 1.f;
      bf16_t* rp = C + (size_t)(m0 + rl) * ldc + cb + 4 * quad;
#pragma unroll
      for (int n = 0; n < 8; ++n) { const f32x4 v = acc[m][n] * rs; u32x2 w; w.x = cvtpk(v[0], v[1]); w.y = cvtpk(v[2], v[3]); *(u32x2*)(rp + 16 * n) = w; }
    }
  }
};
struct EpiInAB {
  bf16_t* Z; const float* gq; const float* gk; const float2* rope;
  __device__ __forceinline__ void operator()(f32x4 (&acc)[4][8], int m0, int rl0, int cb0, int l15, int quad, const float* sR) const {
#pragma unroll
    for (int hh = 0; hh < 2; ++hh) {
      const int cb = cb0 + 64 * hh;
      if (cb >= 640) {
#pragma unroll
        for (int m = 0; m < 4; ++m) {
          const int rl = rl0 + 16 * m + l15; const float rs = sR[rl];
          bf16_t* rp = Z + (size_t)(m0 + rl) * ZW + cb + 4 * quad;
#pragma unroll
          for (int n = 0; n < 4; ++n) { const f32x4 v = acc[m][4 * hh + n] * rs; u32x2 w; w.x = cvtpk(v[0], v[1]); w.y = cvtpk(v[2], v[3]); *(u32x2*)(rp + 16 * n) = w; }
        }
      } else {
        const float* g = cb < 512 ? gq : gk;
        const float qs = cb < 512 ? 0.125f * LOG2E : 1.0f;
        f32x4 gv[4];
#pragma unroll
        for (int n = 0; n < 4; ++n) gv[n] = *(const f32x4*)(g + 16 * n + 4 * quad) * qs;
#pragma unroll
        for (int m = 0; m < 4; ++m) {
          const int rl = rl0 + 16 * m + l15; const int row = m0 + rl; const float rs = sR[rl];
          f32x4 z[4]; float s2 = 0.f;
#pragma unroll
          for (int n = 0; n < 4; ++n) { z[n] = acc[m][4 * hh + n] * rs; s2 += z[n][0] * z[n][0] + z[n][1] * z[n][1] + z[n][2] * z[n][2] + z[n][3] * z[n][3]; }
          s2 += __shfl_xor(s2, 16); s2 += __shfl_xor(s2, 32);
          const float r = rsqrtf(s2 * (1.0f / 64.0f) + EPS);
          const int pos = row < NPROMPT ? (row & 2047) : (row & 16383);
          const int gr = pos >> 6, gc = pos & 63;
          bf16_t* rp = Z + (size_t)row * ZW + cb + 4 * quad;
#pragma unroll
          for (int n = 0; n < 4; ++n) {
            const int ap = (n < 2) ? gr : gc;
            const f32x4 zn = z[n] * r * gv[n];
            float2 c0, c1; { const unsigned long long w0 = __hip_atomic_load((const unsigned long long*)(rope + ap * 16 + ((8 * n + 2 * quad) & 15)), __ATOMIC_RELAXED, __HIP_MEMORY_SCOPE_AGENT), w1 = __hip_atomic_load((const unsigned long long*)(rope + ap * 16 + ((8 * n + 2 * quad + 1) & 15)), __ATOMIC_RELAXED, __HIP_MEMORY_SCOPE_AGENT); c0.x = __uint_as_float((unsigned)w0); c0.y = __uint_as_float((unsigned)(w0 >> 32)); c1.x = __uint_as_float((unsigned)w1); c1.y = __uint_as_float((unsigned)(w1 >> 32)); }
            const float o0 = zn[0] * c0.x - zn[1] * c0.y, o1 = zn[0] * c0.y + zn[1] * c0.x;
            const float o2 = zn[2] * c1.x - zn[3] * c1.y, o3 = zn[2] * c1.y + zn[3] * c1.x;
            u32x2 w; w.x = cvtpk(o0, o1); w.y = cvtpk(o2, o3); *(u32x2*)(rp + 16 * n) = w;
          }
        }
      }
    }
  }
};
struct EpiResid {
  const float* src_tile; float* dst;
  __device__ __forceinline__ void operator()(f32x4 (&acc)[4][8], int m0, int rl0, int cb, int l15, int quad, const float* sR) const {
#pragma unroll
    for (int m = 0; m < 4; ++m) {
      const int rl = rl0 + 16 * m + l15;
      const float* sp = src_tile + (size_t)rl * 1024 + cb + 4 * quad; float* dp = dst + (size_t)(m0 + rl) * 1024 + cb + 4 * quad;
#pragma unroll
      for (int n = 0; n < 8; ++n) { const f32x4 x = ld_agent_f32x4(sp + 16 * n); *(f32x4*)(dp + 16 * n) = x + acc[m][n]; }
    }
  }
};
struct EpiSwiGLU {
  bf16_t* H;
  __device__ __forceinline__ void operator()(f32x4 (&acc)[4][8], int m0, int rl0, int cb, int l15, int quad, const float* sR) const {
    const int hc0 = (cb >> 8) * 128 + ((cb >> 7) & 1) * 64 + 4 * quad;
#pragma unroll
    for (int m = 0; m < 4; ++m) {
      const int rl = rl0 + 16 * m + l15; const float rs = sR[rl];
      bf16_t* rp = H + (size_t)(m0 + rl) * DFF + hc0;
#pragma unroll
      for (int pp = 0; pp < 4; ++pp) {
        const f32x4 g = acc[m][2 * pp] * rs, u = acc[m][2 * pp + 1] * rs; float h[4];
#pragma unroll
        for (int j = 0; j < 4; ++j) h[j] = g[j] / (1.0f + __expf(-g[j])) * u[j];
        u32x2 w; w.x = cvtpk(h[0], h[1]); w.y = cvtpk(h[2], h[3]); *(u32x2*)(rp + 16 * pp) = w;
      }
    }
  }
};

template <int DH, int KT, int NQT, bool PF, class Ctx>
__device__ __forceinline__ void attn_item(unsigned char* smem, const Ctx& c) {
  constexpr int LDK = DH + 8, CH = DH / 8, NCH = KT * CH / 256, NKS = DH / 32, NK4 = KT / 16, NKK = KT / 32, NDT = DH / 16;
  bf16_t* sK = (bf16_t*)smem; bf16_t* sV = sK + KT * LDK;
  const int tid = get_tid(), lane = tid & 63;
  const int wid = __builtin_amdgcn_readfirstlane(tid >> 6);
  const int l15 = lane & 15, quad = lane >> 4;
  bf16x8 qf[NQT][NKS];
#pragma unroll
  for (int qt = 0; qt < NQT; ++qt) {
    const bf16_t* qp = c.qptr(wid, qt * 16 + l15);
#pragma unroll
    for (int ks = 0; ks < NKS; ++ks) qf[qt][ks] = __builtin_bit_cast(bf16x8, ld_agent_u32x4(qp + ks * 32 + quad * 8));
  }
  f32x4 o[NQT][NDT];
  float mrow[NQT], lrow[NQT];
#pragma unroll
  for (int qt = 0; qt < NQT; ++qt) {
    mrow[qt] = -1e30f; lrow[qt] = 0.f;
#pragma unroll
    for (int dt = 0; dt < NDT; ++dt) o[qt][dt] = (f32x4){0.f, 0.f, 0.f, 0.f};
  }
  const int nt = c.ntiles();
  u32x4 rk[NCH], rv[NCH];
  if constexpr (PF) {
#pragma unroll
    for (int i = 0; i < NCH; ++i) {
      const int ci = tid + 256 * i, row = ci / CH, ch = ci % CH;
      ld16_sc1(rk[i], c.kptr(0, row) + ch * 8); ld16_sc1(rv[i], c.vptr(0, row) + ch * 8);
    }
  }
  for (int t = 0; t < nt; ++t) {
    __syncthreads();
    if constexpr (PF) {
      static_assert(!PF || NCH == 2 || NCH == 4, "wait lists below are written for two or four chunks per matrix");
      if constexpr (NCH == 2) asm volatile("s_waitcnt vmcnt(0)" : "+v"(rk[0]), "+v"(rk[NCH - 1]), "+v"(rv[0]), "+v"(rv[NCH - 1]) :: "memory");
      else asm volatile("s_waitcnt vmcnt(0)" : "+v"(rk[0]), "+v"(rk[1]), "+v"(rk[NCH - 2]), "+v"(rk[NCH - 1]), "+v"(rv[0]), "+v"(rv[1]), "+v"(rv[NCH - 2]), "+v"(rv[NCH - 1]) :: "memory");
#pragma unroll
      for (int i = 0; i < NCH; ++i) {
        const int ci = tid + 256 * i, row = ci / CH, ch = ci % CH;
        *(u32x4*)(sK + row * LDK + ch * 8) = rk[i]; *(u32x4*)(sV + row * LDK + ch * 8) = rv[i];
      }
    } else {
#pragma unroll
      for (int i = 0; i < NCH; ++i) {
        const int ci = tid + 256 * i, row = ci / CH, ch = ci % CH;
        *(u32x4*)(sK + row * LDK + ch * 8) = ld_agent_u32x4(c.kptr(t, row) + ch * 8);
      }
#pragma unroll
      for (int i = 0; i < NCH; ++i) {
        const int ci = tid + 256 * i, row = ci / CH, ch = ci % CH;
        *(u32x4*)(sV + row * LDK + ch * 8) = ld_agent_u32x4(c.vptr(t, row) + ch * 8);
      }
    }
    __syncthreads();
    if constexpr (PF) {
      if (t + 1 < nt) {
#pragma unroll
        for (int i = 0; i < NCH; ++i) {
          const int ci = tid + 256 * i, row = ci / CH, ch = ci % CH;
          ld16_sc1(rk[i], c.kptr(t + 1, row) + ch * 8); ld16_sc1(rv[i], c.vptr(t + 1, row) + ch * 8);
        }
      }
    }
    if (c.active(t, wid)) {
      constexpr int QG = NQT < 2 ? NQT : 2;
      bf16x8 pfa[NQT][NKK];
#pragma unroll
      for (int g = 0; g < NQT; g += QG) {
        f32x4 s[QG][NK4];
#pragma unroll
        for (int q = 0; q < QG; ++q)
#pragma unroll
          for (int k4 = 0; k4 < NK4; ++k4) s[q][k4] = (f32x4){0.f, 0.f, 0.f, 0.f};
#pragma unroll
        for (int k4 = 0; k4 < NK4; ++k4)
#pragma unroll
          for (int ks = 0; ks < NKS; ++ks) {
            const bf16x8 kf = *(const bf16x8*)(sK + (16 * k4 + l15) * LDK + ks * 32 + quad * 8);
#pragma unroll
            for (int q = 0; q < QG; ++q) s[q][k4] = __builtin_amdgcn_mfma_f32_16x16x32_bf16(kf, qf[g + q][ks], s[q][k4], 0, 0, 0);
          }
#pragma unroll
        for (int q = 0; q < QG; ++q) {
          const int qt = g + q;
          float mx = -1e30f;
#pragma unroll
          for (int k4 = 0; k4 < NK4; ++k4)
#pragma unroll
            for (int j = 0; j < 4; ++j) { const float v = c.score(t, wid, qt * 16 + l15, 16 * k4 + 4 * quad + j, s[q][k4][j]); s[q][k4][j] = v; mx = fmaxf(mx, v); }
          mx = fmaxf(mx, __shfl_xor(mx, 16)); mx = fmaxf(mx, __shfl_xor(mx, 32));
          const float mnew = fmaxf(mrow[qt], mx);
          if (__any(mnew > mrow[qt])) {
            const float alpha = __builtin_amdgcn_exp2f(mrow[qt] - mnew);
            mrow[qt] = mnew;
            lrow[qt] *= alpha;
#pragma unroll
            for (int dt = 0; dt < NDT; ++dt) o[qt][dt] *= alpha;
          }
          float psum = 0.f;
#pragma unroll
          for (int k4 = 0; k4 < NK4; ++k4)
#pragma unroll
            for (int j = 0; j < 4; ++j) { const float pv = __builtin_amdgcn_exp2f(s[q][k4][j] - mnew); s[q][k4][j] = pv; psum += pv; }
          lrow[qt] += psum;
#pragma unroll
          for (int kk = 0; kk < NKK; ++kk) {
            u32x4 w;
            w.x = cvtpk(s[q][2 * kk][0], s[q][2 * kk][1]); w.y = cvtpk(s[q][2 * kk][2], s[q][2 * kk][3]);
            w.z = cvtpk(s[q][2 * kk + 1][0], s[q][2 * kk + 1][1]); w.w = cvtpk(s[q][2 * kk + 1][2], s[q][2 * kk + 1][3]);
            pfa[qt][kk] = __builtin_bit_cast(bf16x8, w);
          }
        }
      }
#pragma unroll
      for (int kk = 0; kk < NKK; ++kk) {
        const bf16_t* vb = sV + (32 * kk + 4 * quad + (l15 >> 2)) * LDK + 4 * (l15 & 3);
#pragma unroll
        for (int dt = 0; dt < NDT; ++dt) {
          const s16x4 lo = tr_read(vb + 16 * dt);
          const s16x4 hi = tr_read(vb + 16 * LDK + 16 * dt);
          const bf16x8 vf = (bf16x8){lo[0], lo[1], lo[2], lo[3], hi[0], hi[1], hi[2], hi[3]};
#pragma unroll
          for (int qt = 0; qt < NQT; ++qt) o[qt][dt] = __builtin_amdgcn_mfma_f32_16x16x32_bf16(vf, pfa[qt][kk], o[qt][dt], 0, 0, 0);
        }
      }
    }
  }
#pragma unroll
  for (int qt = 0; qt < NQT; ++qt) {
    float l = lrow[qt];
    l += __shfl_xor(l, 16); l += __shfl_xor(l, 32);
    const float inv = 1.0f / l;
    bf16_t* op = c.optr(wid, qt * 16 + l15) + 4 * quad;
#pragma unroll
    for (int dt = 0; dt < NDT; ++dt) { const f32x4 v = o[qt][dt] * inv; u32x2 w; w.x = cvtpk(v[0], v[1]); w.y = cvtpk(v[2], v[3]); *(u32x2*)(op + 16 * dt) = w; }
    if (quad == 0) c.store_lse(wid, qt * 16 + l15, mrow[qt] + __builtin_amdgcn_logf(l));
  }
}

struct CtxA {
  bf16_t* qbase; const bf16_t* kbase; int nt;
  __device__ __forceinline__ const bf16_t* qptr(int w, int ql) const { return qbase + (size_t)(64 * w + ql) * ZW; }
  __device__ __forceinline__ bf16_t* optr(int w, int ql) const { return qbase + (size_t)(64 * w + ql) * ZW; }
  __device__ __forceinline__ const bf16_t* kptr(int t, int r) const { return kbase + (size_t)(64 * t + r) * ZW; }
  __device__ __forceinline__ const bf16_t* vptr(int t, int r) const { return kbase + (size_t)(64 * t + r) * ZW + 128; }
  __device__ __forceinline__ int ntiles() const { return nt; }
  __device__ __forceinline__ bool active(int, int) const { return true; }
  __device__ __forceinline__ float score(int, int, int, int, float s) const { return s; }
  __device__ __forceinline__ void store_lse(int, int, float) const {}
};
struct CtxB {
  bf16_t* zs; float* lse; int d, r, L, i0, qcol, kcol, vcol; float slope_l2;
  __device__ __forceinline__ const bf16_t* qptr(int w, int ql) const { return zs + (size_t)((i0 + 32 * w + ql) * d + r) * ZW + qcol; }
  __device__ __forceinline__ bf16_t* optr(int w, int ql) const { return zs + (size_t)((i0 + 32 * w + ql) * d + r) * ZW + qcol; }
  __device__ __forceinline__ int kidx(int t, int row) const { int i = i0 - 64 + 64 * t + row; i = i < 0 ? 0 : i; return i > L - 1 ? L - 1 : i; }
  __device__ __forceinline__ const bf16_t* kptr(int t, int row) const { return zs + (size_t)(kidx(t, row) * d + r) * ZW + kcol; }
  __device__ __forceinline__ const bf16_t* vptr(int t, int row) const { return zs + (size_t)(kidx(t, row) * d + r) * ZW + vcol; }
  __device__ __forceinline__ int ntiles() const { return 4; }
  __device__ __forceinline__ bool active(int t, int w) const { return w < 2 ? (t < 3) : (t >= 1); }
  __device__ __forceinline__ float score(int t, int w, int ql, int kl, float s) const {
    const int qi = i0 + 32 * w + ql, ki = i0 - 64 + 64 * t + kl; int rel = ki - qi; rel = rel < 0 ? -rel : rel;
    const bool valid = (rel <= 64) && (ki >= 0) && (ki < L);
    return valid ? s * (0.125f * LOG2E) - slope_l2 * (float)rel : -1e30f;
  }
  __device__ __forceinline__ void store_lse(int w, int ql, float v) const { lse[i0 + 32 * w + ql] = v; }
};
struct CtxC {
  bf16_t* zs; const float* rpb; int R, r0, rb, hc;
  __device__ __forceinline__ const bf16_t* qptr(int w, int ql) const { return zs + (size_t)((r0 + w) * 64 + ql) * ZW + hc; }
  __device__ __forceinline__ bf16_t* optr(int w, int ql) const { return zs + (size_t)((r0 + w) * 64 + ql) * ZW + hc; }
  __device__ __forceinline__ int krow(int t) const { const int kr = rb + t; return kr > R - 1 ? R - 1 : kr; }
  __device__ __forceinline__ const bf16_t* kptr(int t, int row) const { return zs + (size_t)(krow(t) * 64 + row) * ZW + 1024 + hc; }
  __device__ __forceinline__ const bf16_t* vptr(int t, int row) const { return zs + (size_t)(krow(t) * 64 + row) * ZW + 2048 + hc; }
  __device__ __forceinline__ int ntiles() const { return 11; }
  __device__ __forceinline__ int rstart(int r) const { int rs = r - 4; rs = rs < 0 ? 0 : rs; return rs > R - 8 ? R - 8 : rs; }
  __device__ __forceinline__ bool active(int t, int w) const { const int r = r0 + w, rs = rstart(r), kr = rb + t; return kr >= rs && kr < rs + 8; }
  __device__ __forceinline__ float score(int t, int w, int ql, int kl, float s) const {
    const int r = r0 + w, cq = ql, kr = rb + t;
    int cs = cq - 8; cs = cs < 0 ? 0 : cs; cs = cs > 48 ? 48 : cs;
    const bool valid = (kl >= cs) && (kl < cs + 16);
    const int idx = valid ? (kr - r + 7) * 31 + (kl - cq + 15) : 0;
    const float b = rpb[idx];
    return valid ? (s * 0.125f + b) * LOG2E : -1e30f;
  }
  __device__ __forceinline__ void store_lse(int, int, float) const {}
};
struct CtxX {
  bf16_t* qbase; const bf16_t* kv;
  __device__ __forceinline__ const bf16_t* qptr(int w, int ql) const { return qbase + (size_t)(16 * w + ql) * 1024; }
  __device__ __forceinline__ bf16_t* optr(int w, int ql) const { return qbase + (size_t)(16 * w + ql) * 1024; }
  __device__ __forceinline__ const bf16_t* kptr(int t, int row) const { return kv + (size_t)(32 * t + row) * 2048; }
  __device__ __forceinline__ const bf16_t* vptr(int t, int row) const { return kv + (size_t)(32 * t + row) * 2048 + 1024; }
  __device__ __forceinline__ int ntiles() const { return 8; }
  __device__ __forceinline__ bool active(int, int) const { return true; }
  __device__ __forceinline__ float score(int, int, int, int, float s) const { return s * (0.0625f * LOG2E); }
  __device__ __forceinline__ void store_lse(int, int, float) const {}
};

__device__ __forceinline__ void wt_tile(unsigned char* smem, const float* src, int K, int N, const float* gain, bf16_t* dst, int perm, int t) {
  float* tl = (float*)smem;
  const int nkt = K >> 6; const int rt = t / nkt, kt = t - rt * nkt; const int R0 = rt * 64, k0 = kt * 64;
  const int tid = get_tid(); const int rr = tid & 63;
  const int R = R0 + rr; int sc = R;
  if (perm) { const int T = R >> 8, within = R & 255, wc = within >> 7, n = (within & 127) >> 4, i = within & 15; sc = (n & 1) * DFF + 128 * T + 64 * wc + 16 * (n >> 1) + i; }
  __syncthreads();
#pragma unroll 4
  for (int i = 0; i < 16; ++i) {
    const int kk = (tid >> 6) + 4 * i;
    float v = src[(size_t)(k0 + kk) * N + sc];
    if (gain) v *= gain[k0 + kk];
    tl[kk * 65 + rr] = v;
  }
  __syncthreads();
  const int r2 = tid >> 2, kq = tid & 3;
  u32x4 w0, w1;
  w0.x = cvtpk(tl[(16 * kq + 0) * 65 + r2], tl[(16 * kq + 1) * 65 + r2]); w0.y = cvtpk(tl[(16 * kq + 2) * 65 + r2], tl[(16 * kq + 3) * 65 + r2]);
  w0.z = cvtpk(tl[(16 * kq + 4) * 65 + r2], tl[(16 * kq + 5) * 65 + r2]); w0.w = cvtpk(tl[(16 * kq + 6) * 65 + r2], tl[(16 * kq + 7) * 65 + r2]);
  w1.x = cvtpk(tl[(16 * kq + 8) * 65 + r2], tl[(16 * kq + 9) * 65 + r2]); w1.y = cvtpk(tl[(16 * kq + 10) * 65 + r2], tl[(16 * kq + 11) * 65 + r2]);
  w1.z = cvtpk(tl[(16 * kq + 12) * 65 + r2], tl[(16 * kq + 13) * 65 + r2]); w1.w = cvtpk(tl[(16 * kq + 14) * 65 + r2], tl[(16 * kq + 15) * 65 + r2]);
  bf16_t* dp = dst + ((size_t)((k0 + 16 * kq) >> 5) * N + (R0 + r2)) * 32 + ((16 * kq) & 31);
  *(u32x4*)dp = w0; *(u32x4*)(dp + 8) = w1;
}
__device__ __forceinline__ void wt_matrix(unsigned char* smem, const float* src, int K, int N, const float* gain, bf16_t* dst, int perm) {
  const int ntile = (K >> 6) * (N >> 6);
  for (int t = blockIdx.x; t < ntile; t += gridDim.x) wt_tile(smem, src, K, N, gain, dst, perm, t);
}

__device__ __forceinline__ void tile_seq(int tt, int& seqbase, int& qb, int& S) {
  if (tt < 256) { seqbase = (tt >> 4) * 2048; qb = tt & 15; S = 2048; }
  else { const int u = tt - 256; seqbase = NPROMPT + (u >> 7) * 16384; qb = u & 127; S = 16384; }
}

typedef const __attribute__((address_space(4))) Params* KParams;
__device__ __forceinline__ void run_phase(int ph, KParams kp, unsigned char* smem) {
  unsigned char* ws = kp->ws;
  bf16_t* Z = (bf16_t*)(ws + WS_Z);
  const int tid = get_tid();
  const int L = ph >= 10 ? 1 : 0;
  switch (ph) {
    case 0: {
      wt_matrix(smem, kp->w_in_ab, 1024, 3072, kp->g_mix, (bf16_t*)(ws + WS_WT_IN_AB), 0);
      wt_matrix(smem, kp->w_out_ab, 768, 1024, nullptr, (bf16_t*)(ws + WS_WT_OUT_AB), 0);
      wt_matrix(smem, kp->w_in_c, 1024, 3072, kp->g_mix + 1024, (bf16_t*)(ws + WS_WT_IN_C), 0);
      wt_matrix(smem, kp->w_out_c, 1024, 1024, nullptr, (bf16_t*)(ws + WS_WT_OUT_C), 0);
      for (int l = 0; l < 2; ++l) {
        wt_matrix(smem, kp->wq_x + (size_t)l * 1024 * 1024, 1024, 1024, kp->g_xattn + l * 1024, (bf16_t*)(ws + WS_WT_Q) + (size_t)l * 1024 * 1024, 0);
        wt_matrix(smem, kp->wkv_x + (size_t)l * 1024 * 2048, 1024, 2048, kp->g_mem + l * 1024, (bf16_t*)(ws + WS_WT_KV) + (size_t)l * 2048 * 1024, 0);
        wt_matrix(smem, kp->wo_x + (size_t)l * 1024 * 1024, 1024, 1024, nullptr, (bf16_t*)(ws + WS_WT_O) + (size_t)l * 1024 * 1024, 0);
        wt_matrix(smem, kp->w_gu + (size_t)l * 1024 * 5632, 1024, 5632, kp->g_ffn + l * 1024, (bf16_t*)(ws + WS_WT_GU) + (size_t)l * 5632 * 1024, 1);
        wt_matrix(smem, kp->w_down + (size_t)l * DFF * 1024, DFF, 1024, nullptr, (bf16_t*)(ws + WS_WT_DOWN) + (size_t)l * 1024 * DFF, 0);
      }
      const int gi = blockIdx.x * 256 + tid;
      if (gi < 4096) {
        const int pos = gi >> 4, f = gi & 15;
        const float inv_freq = exp2f(-(float)f * 0.83048202372184058696f);
        const float ang = (float)pos * inv_freq;
        float2 cs; cs.x = cosf(ang); cs.y = sinf(ang);
        ((float2*)(ws + WS_ROPE))[gi] = cs;
      }
    } break;
    case 1: {
      const int n_ab = 512 * 12, n_kv = 36 * 8;
      for (int t = blockIdx.x; t < n_ab + 2 * n_kv; t += gridDim.x) {
        if (t < n_ab) {
          int mt, nt; tile_map(t, 12, gridDim.x, mt, nt);
          EpiInAB e{Z, kp->g_qn, kp->g_kn, (const float2*)(ws + WS_ROPE)};
          gemm_tile<true>(smem, xin_row(kp->x_prompt, kp->x_sample, mt * 128), 1024, (const bf16_t*)(ws + WS_WT_IN_AB), 3072, 1024, e, mt * 128, nt * 256);
        } else {
          int u = t - n_ab; const int l = u / n_kv; u -= l * n_kv; const int mt = u >> 3, nt = u & 7;
          EpiStore<true> e{(bf16_t*)(ws + WS_KVMEM) + (size_t)l * 4608 * 2048, 2048};
          gemm_tile<true>(smem, mem_row(kp->mem_prompt, kp->mem_sample, mt * 128), 1024, (const bf16_t*)(ws + WS_WT_KV) + (size_t)l * 2048 * 1024, 2048, 1024, e, mt * 128, nt * 256);
        }
      }
    } break;
    case 2: {
      for (int it = blockIdx.x; it < 2048 + 6144; it += gridDim.x) {
        if (it < 2048) {
          int seqbase, qi, h, nt;
          if (gridDim.x == 512) {
            const int bid = blockIdx.x, i = it >> 9, xcd = bid & 7, l = (bid >> 3) + 64 * (i & 1);
            if (it < 1024) { const int g = xcd >> 1, id = l * 2 + (xcd & 1); qi = id >> 2; h = (g & 1) * 4 + (id & 3); seqbase = NPROMPT + (g >> 1) * 16384; nt = 256; }
            else { const int grp = xcd + 8 * (l >> 5), id = l & 31; qi = id >> 2; h = (grp & 1) * 4 + (id & 3); seqbase = (grp >> 1) * 2048; nt = 32; }
          } else if (it < 1024) { const int s = it >> 9, rem = it & 511; qi = rem >> 3; h = rem & 7; seqbase = NPROMPT + s * 16384; nt = 256; }
          else { const int a = it - 1024; const int s = a >> 6, rem = a & 63; qi = rem >> 3; h = rem & 7; seqbase = s * 2048; nt = 32; }
          CtxA c{Z + (size_t)(seqbase + 256 * qi) * ZW + h * 64, Z + (size_t)seqbase * ZW + 512 + (h >> 2) * 64, nt};
          attn_item<64, 64, 4, true>(smem, c);
        } else {
          const int b = it - 2048; const int h = b & 3, g = (b >> 2) % 3, tt = b / 12;
          int seqbase, qb, S; tile_seq(tt, seqbase, qb, S);
          const int d = g == 0 ? 1 : (g == 1 ? 4 : 16);
          const int Ls = S / d, nb = Ls >> 7; const int r = qb / nb, mblk = qb - r * nb;
          const float slope = exp2f(-8.0f * (float)(4 * g + h + 1) / 12.0f);
          CtxB c{Z + (size_t)seqbase * ZW, (float*)(ws + WS_LSE) + (size_t)(g * 4 + h) * NTOK + seqbase + r * Ls, d, r, Ls, mblk * 128,
                 768 + ((0 * 3 + g) * 4 + h) * 64, 768 + ((1 * 3 + g) * 4 + h) * 64, 768 + ((2 * 3 + g) * 4 + h) * 64, slope * (float)d * LOG2E};
          attn_item<64, 64, 2, true>(smem, c);
        }
      }
    } break;
    case 3: {
      const float* lse = (const float*)(ws + WS_LSE);
      for (int i = blockIdx.x * 256 + tid; i < NTOK * 32; i += gridDim.x * 256) {
        const int T = i >> 5, h = (i >> 3) & 3, c8 = i & 7;
        int sb, pos, lg;
        if (T < NPROMPT) { sb = T & ~2047; pos = T & 2047; lg = 11; } else { sb = NPROMPT + ((T - NPROMPT) & ~16383); pos = (T - NPROMPT) & 16383; lg = 14; }
        const float l0 = ld_agent_f32(lse + (size_t)(0 * 4 + h) * NTOK + sb + pos);
        const float l1 = ld_agent_f32(lse + (size_t)(1 * 4 + h) * NTOK + sb + ((pos & 3) << (lg - 2)) + (pos >> 2));
        const float l2 = ld_agent_f32(lse + (size_t)(2 * 4 + h) * NTOK + sb + ((pos & 15) << (lg - 4)) + (pos >> 4));
        const float mx = fmaxf(l0, fmaxf(l1, l2));
        float w0 = __builtin_amdgcn_exp2f(l0 - mx), w1 = __builtin_amdgcn_exp2f(l1 - mx), w2 = __builtin_amdgcn_exp2f(l2 - mx);
        const float inv = 1.0f / (w0 + w1 + w2); w0 *= inv; w1 *= inv; w2 *= inv;
        const bf16_t* zr = Z + (size_t)T * ZW;
        const u32x4 a = ld_agent_u32x4(zr + 768 + (0 * 4 + h) * 64 + c8 * 8), b = ld_agent_u32x4(zr + 768 + (1 * 4 + h) * 64 + c8 * 8), cc = ld_agent_u32x4(zr + 768 + (2 * 4 + h) * 64 + c8 * 8);
        u32x4 o;
#pragma unroll
        for (int k = 0; k < 4; ++k) {
          const float lo = w0 * bf2f((unsigned short)(a[k] & 0xffff)) + w1 * bf2f((unsigned short)(b[k] & 0xffff)) + w2 * bf2f((unsigned short)(cc[k] & 0xffff));
          const float hi = w0 * bf2f((unsigned short)(a[k] >> 16)) + w1 * bf2f((unsigned short)(b[k] >> 16)) + w2 * bf2f((unsigned short)(cc[k] >> 16));
          o[k] = cvtpk(lo, hi);
        }
        *(u32x4*)(Z + (size_t)T * ZW + 512 + h * 64 + c8 * 8) = o;
      }
    } break;
    case 4: case 7: case 9: case 12: case 15: case 17: {
      const bf16_t* A; int lda, K; const bf16_t* Bt;
      if (ph == 4) { A = Z; lda = ZW; K = 768; Bt = (const bf16_t*)(ws + WS_WT_OUT_AB); }
      else if (ph == 12) { A = Z; lda = ZW; K = 1024; Bt = (const bf16_t*)(ws + WS_WT_OUT_C); }
      else if (ph == 7 || ph == 15) { A = Z; lda = 1024; K = 1024; Bt = (const bf16_t*)(ws + WS_WT_O) + (size_t)L * 1024 * 1024; }
      else { A = Z; lda = DFF; K = DFF; Bt = (const bf16_t*)(ws + WS_WT_DOWN) + (size_t)L * 1024 * DFF; }
      for (int t = blockIdx.x; t < 512 * 4; t += gridDim.x) {
        int mt, nt; tile_map(t, 4, gridDim.x, mt, nt);
        EpiResid e{ph == 4 ? xin_row(kp->x_prompt, kp->x_sample, mt * 128) : kp->out + (size_t)mt * 128 * 1024, kp->out};
        gemm_tile<false>(smem, A + (size_t)mt * 128 * lda, lda, Bt, 1024, K, e, mt * 128, nt * 256);
      }
    } break;
    case 5: case 10: case 13: {
      const bf16_t* Bt; int NT, ldc;
      if (ph == 10) { Bt = (const bf16_t*)(ws + WS_WT_IN_C); NT = 12; ldc = ZW; }
      else { Bt = (const bf16_t*)(ws + WS_WT_Q) + (size_t)L * 1024 * 1024; NT = 4; ldc = 1024; }
      for (int t = blockIdx.x; t < 512 * NT; t += gridDim.x) {
        int mt, nt; tile_map(t, NT, gridDim.x, mt, nt);
        EpiStore<true> e{Z, ldc};
        gemm_tile<true>(smem, kp->out + (size_t)mt * 128 * 1024, 1024, Bt, NT * 256, 1024, e, mt * 128, nt * 256);
      }
    } break;
    case 6: case 14: {
      const bf16_t* kvm = (const bf16_t*)(ws + WS_KVMEM) + (size_t)L * 4608 * 2048;
      for (int it = blockIdx.x; it < 4096; it += gridDim.x) {
        int idx = it; if (gridDim.x == 512) idx = (blockIdx.x & 7) * 512 + (blockIdx.x >> 3) + 64 * (it >> 9);
        const int h = idx & 3, tile = idx >> 2, T0 = tile * 64;
        const int bidx = T0 < NPROMPT ? (T0 >> 11) : 16 + ((T0 - NPROMPT) >> 14);
        CtxX c{Z + (size_t)T0 * 1024 + h * 256, kvm + (size_t)bidx * 256 * 2048 + h * 256};
        attn_item<256, 32, 1, true>(smem, c);
      }
    } break;
    case 8: case 16: {
      const bf16_t* Bt = (const bf16_t*)(ws + WS_WT_GU) + (size_t)L * 5632 * 1024;
      for (int t = blockIdx.x; t < 512 * 22; t += gridDim.x) {
        int mt, nt; tile_map(t, 22, gridDim.x, mt, nt);
        EpiSwiGLU e{Z};
        gemm_tile<true>(smem, kp->out + (size_t)mt * 128 * 1024, 1024, Bt, 5632, 1024, e, mt * 128, nt * 256);
      }
    } break;
    case 11: {
      float* srpb = (float*)(smem + 2 * 64 * 72 * 2);
      for (int it = blockIdx.x; it < 4096; it += gridDim.x) {
        int h = it & 15, t4 = it >> 4;
        if (gridDim.x == 512) { const int l = (blockIdx.x >> 3) + 64 * (it >> 9); h = 2 * (blockIdx.x & 7) + (l & 1); t4 = l >> 1; }
        int seqbase, rq, R;
        if (t4 < 128) { seqbase = (t4 >> 3) * 2048; rq = t4 & 7; R = 32; } else { const int u = t4 - 128; seqbase = NPROMPT + (u >> 6) * 16384; rq = u & 63; R = 256; }
        const int r0 = 4 * rq;
        int rb = r0 - 4; rb = rb < 0 ? 0 : rb; rb = rb > R - 8 ? R - 8 : rb;
        __syncthreads();
        for (int i = tid; i < 15 * 31; i += 256) srpb[i] = kp->rpb_c[h * 15 * 31 + i];
        CtxC c{Z + (size_t)seqbase * ZW, srpb, R, r0, rb, h * 64};
        attn_item<64, 64, 4, true>(smem, c);
      }
    } break;
    case 18: {
      const int lane = tid & 63, wv = blockIdx.x * 4 + (tid >> 6), nwv = gridDim.x * 4;
      for (int row = wv; row < NTOK; row += nwv) {
        float* xr = kp->out + (size_t)row * 1024;
        f32x4 v[4]; float s = 0.f;
#pragma unroll
        for (int i = 0; i < 4; ++i) { v[i] = ld_agent_f32x4(xr + i * 256 + lane * 4); s += v[i][0] * v[i][0] + v[i][1] * v[i][1] + v[i][2] * v[i][2] + v[i][3] * v[i][3]; }
        s += __shfl_xor(s, 1); s += __shfl_xor(s, 2); s += __shfl_xor(s, 4); s += __shfl_xor(s, 8); s += __shfl_xor(s, 16); s += __shfl_xor(s, 32);
        const float r = rsqrtf(s * (1.0f / 1024.0f) + EPS);
#pragma unroll
        for (int i = 0; i < 4; ++i) { const f32x4 g = *(const f32x4*)(kp->g_final + i * 256 + lane * 4); *(f32x4*)(xr + i * 256 + lane * 4) = v[i] * r * g; }
      }
    } break;
    default: break;
  }
}

constexpr int NPHASE = 19;
constexpr size_t WS_BAR = WS_END + 65536;

__device__ __forceinline__ void xcd_grid_barrier(unsigned* st) {
  __syncthreads();
  if (threadIdx.x == 0) {
    __threadfence();
    const unsigned nb = gridDim.x;
    const unsigned ng = (nb & 7u) == 0u ? 8u : 1u, grp = ng == 8u ? (blockIdx.x & 7u) : 0u, per = nb / ng;
    const unsigned gen = __hip_atomic_load(st + 32 * 9, __ATOMIC_RELAXED, __HIP_MEMORY_SCOPE_AGENT);
    if (__hip_atomic_fetch_add(st + 32 * grp, 1u, __ATOMIC_RELAXED, __HIP_MEMORY_SCOPE_AGENT) == per - 1u) {
      __hip_atomic_store(st + 32 * grp, 0u, __ATOMIC_RELAXED, __HIP_MEMORY_SCOPE_AGENT);
      if (__hip_atomic_fetch_add(st + 32 * 8, 1u, __ATOMIC_RELEASE, __HIP_MEMORY_SCOPE_AGENT) == ng - 1u) {
        __hip_atomic_store(st + 32 * 8, 0u, __ATOMIC_RELAXED, __HIP_MEMORY_SCOPE_AGENT);
        __hip_atomic_fetch_add(st + 32 * 9, 1u, __ATOMIC_RELEASE, __HIP_MEMORY_SCOPE_AGENT);
      }
    }
    while (__hip_atomic_load(st + 32 * 9, __ATOMIC_RELAXED, __HIP_MEMORY_SCOPE_AGENT) == gen) __builtin_amdgcn_s_sleep(1);
    __threadfence();
  }
  __syncthreads();
}

template <bool COOP>
__global__ void __launch_bounds__(256, 2) mega(Params p) {
  __shared__ __attribute__((aligned(16))) unsigned char smem[SMEM_BYTES];
  if constexpr (COOP) {
    cg::grid_group grid = cg::this_grid();
#define STEP(PH) { KParams kp = (KParams)__builtin_amdgcn_kernarg_segment_ptr(); asm volatile("" : "+s"(kp)); run_phase(PH, kp, smem); if (PH + 1 < NPHASE) { if (PH == 0) grid.sync(); else xcd_grid_barrier((unsigned*)(kp->ws + WS_BAR)); } }
    STEP(0) STEP(1) STEP(2) STEP(3) STEP(4) STEP(5) STEP(6) STEP(7) STEP(8) STEP(9)
    STEP(10) STEP(11) STEP(12) STEP(13) STEP(14) STEP(15) STEP(16) STEP(17) STEP(18)
#undef STEP
  } else {
    for (int ph = p.phase_lo; ph < p.phase_hi; ++ph) {
      KParams kp = (KParams)__builtin_amdgcn_kernarg_segment_ptr();
      asm volatile("" : "+s"(kp));
      run_phase(ph, kp, smem);
    }
  }
}

extern "C" void kernel_launch(void* const* d_in, const int* in_sizes, int n_in, void* d_out, int out_size, void* d_ws, size_t ws_size, hipStream_t stream) {
  static int grid = 0;
  if (grid == 0) {
    if (n_in != 21 || ws_size < WS_BAR + 2048) { fprintf(stderr, "kernel_launch: n_in %d ws %zu (need %zu)\n", n_in, ws_size, (size_t)WS_END); grid = -1; return; }
    int dev = 0, cus = 0, per_cu = 0;
    hipGetDevice(&dev);
    hipDeviceGetAttribute(&cus, hipDeviceAttributeMultiprocessorCount, dev);
#if MULTI_LAUNCH
    hipOccupancyMaxActiveBlocksPerMultiprocessor(&per_cu, (const void*)mega<false>, 256, 0);
#else
    hipOccupancyMaxActiveBlocksPerMultiprocessor(&per_cu, (const void*)mega<true>, 256, 0);
#endif
    if (per_cu < 1) per_cu = 1;
    if (per_cu > 2) per_cu = 2;
    grid = cus * per_cu;
  }
  if (grid < 0) return;
  Params p{};
  p.x_prompt = (const float*)d_in[0]; p.x_sample = (const float*)d_in[1]; p.mem_prompt = (const float*)d_in[2]; p.mem_sample = (const float*)d_in[3];
  p.g_mix = (const float*)d_in[4]; p.w_in_ab = (const float*)d_in[5]; p.g_qn = (const float*)d_in[6]; p.g_kn = (const float*)d_in[7]; p.w_out_ab = (const float*)d_in[8];
  p.w_in_c = (const float*)d_in[9]; p.rpb_c = (const float*)d_in[10]; p.w_out_c = (const float*)d_in[11]; p.g_xattn = (const float*)d_in[12]; p.g_mem = (const float*)d_in[13];
  p.wq_x = (const float*)d_in[14]; p.wkv_x = (const float*)d_in[15]; p.wo_x = (const float*)d_in[16]; p.g_ffn = (const float*)d_in[17]; p.w_gu = (const float*)d_in[18]; p.w_down = (const float*)d_in[19];
  p.g_final = (const float*)d_in[20];
  p.out = (float*)d_out; p.ws = (unsigned char*)d_ws;
#if MULTI_LAUNCH
  for (int ph = 0; ph < NPHASE; ++ph) {
    p.phase_lo = ph; p.phase_hi = ph + 1;
    hipLaunchKernelGGL(mega<false>, dim3(grid), dim3(256), 0, stream, p);
  }
#else
  p.phase_lo = 0; p.phase_hi = NPHASE;
  void* args[] = {&p};
  hipMemsetAsync((unsigned char*)d_ws + WS_BAR, 0, 2048, stream);
  hipError_t e = hipLaunchCooperativeKernel((const void*)mega<true>, dim3(grid), dim3(256), args, 0, stream);
  if (e != hipSuccess) fprintf(stderr, "cooperative launch failed: %s (grid %d)\n", hipGetErrorString(e), grid);
#endif
}
#ifdef DBG_RES
template <int PH> __global__ void __launch_bounds__(256, 2) mega_one(Params p) {
  __shared__ __attribute__((aligned(16))) unsigned char smem[SMEM_BYTES];
  run_phase(PH, (KParams)__builtin_amdgcn_kernarg_segment_ptr(), smem);
}
template __global__ void mega_one<0>(Params); template __global__ void mega_one<1>(Params); template __global__ void mega_one<2>(Params);
template __global__ void mega_one<3>(Params); template __global__ void mega_one<4>(Params); template __global__ void mega_one<5>(Params);
template __global__ void mega_one<6>(Params); template __global__ void mega_one<8>(Params); template __global__ void mega_one<11>(Params);
template __global__ void mega_one<18>(Params);
#endif
```

```cpp
#include <hip/hip_runtime.h>
#include <hip/hip_cooperative_groups.h>
#include <cstdint>
#include <cstdio>
namespace cg = cooperative_groups;

#ifndef MULTI_LAUNCH
#define MULTI_LAUNCH 0
#endif

typedef unsigned short bf16_t;
typedef short bf16x8 __attribute__((ext_vector_type(8)));
typedef short s16x4 __attribute__((ext_vector_type(4)));
typedef short v4i16_t __attribute__((ext_vector_type(4)));
typedef float f32x4 __attribute__((ext_vector_type(4)));
typedef float f32x2_t __attribute__((ext_vector_type(2)));
typedef __bf16 bf16x2_t __attribute__((ext_vector_type(2)));
typedef unsigned u32x4 __attribute__((ext_vector_type(4)));
typedef unsigned u32x2 __attribute__((ext_vector_type(2)));

#define LOG2E 1.4426950408889634f
constexpr int NTOK = 65536;
constexpr int NPROMPT = 32768;
constexpr int ZW = 3072;
constexpr int DFF = 2816;
constexpr float EPS = 1e-6f;

constexpr size_t WS_WT_IN_AB = 0;
constexpr size_t WS_WT_OUT_AB = WS_WT_IN_AB + (size_t)3072 * 1024 * 2;
constexpr size_t WS_WT_IN_C = WS_WT_OUT_AB + (size_t)1024 * 768 * 2;
constexpr size_t WS_WT_OUT_C = WS_WT_IN_C + (size_t)3072 * 1024 * 2;
constexpr size_t WS_WT_Q = WS_WT_OUT_C + (size_t)1024 * 1024 * 2;
constexpr size_t WS_WT_KV = WS_WT_Q + (size_t)2 * 1024 * 1024 * 2;
constexpr size_t WS_WT_O = WS_WT_KV + (size_t)2 * 2048 * 1024 * 2;
constexpr size_t WS_WT_GU = WS_WT_O + (size_t)2 * 1024 * 1024 * 2;
constexpr size_t WS_WT_DOWN = WS_WT_GU + (size_t)2 * 5632 * 1024 * 2;
constexpr size_t WS_KVMEM = WS_WT_DOWN + (size_t)2 * 1024 * 2816 * 2;
constexpr size_t WS_LSE = WS_KVMEM + (size_t)2 * 4608 * 2048 * 2;
constexpr size_t WS_ROPE = WS_LSE + (size_t)3 * 65536 * 4 * 4;
constexpr size_t WS_Z = WS_ROPE + (size_t)256 * 16 * 8;
constexpr size_t WS_END = WS_Z + (size_t)NTOK * ZW * 2;

constexpr int SMEM_BYTES = 2 * (128 + 256) * 40 * 2 + 512;

struct Params {
  const float* x_prompt; const float* x_sample; const float* mem_prompt; const float* mem_sample;
  const float* g_mix; const float* w_in_ab; const float* g_qn; const float* g_kn; const float* w_out_ab;
  const float* w_in_c; const float* rpb_c; const float* w_out_c; const float* g_xattn; const float* g_mem;
  const float* wq_x; const float* wkv_x; const float* wo_x; const float* g_ffn; const float* w_gu; const float* w_down;
  const float* g_final;
  float* out; unsigned char* ws;
  int phase_lo, phase_hi;
};

__device__ __forceinline__ int get_tid() { int t = threadIdx.x; asm volatile("" : "+v"(t)); return t; }
__device__ __forceinline__ unsigned cvtpk(float lo, float hi) { f32x2_t v = {lo, hi}; bf16x2_t b = __builtin_convertvector(v, bf16x2_t); return __builtin_bit_cast(unsigned, b); }
__device__ __forceinline__ float bf2f(unsigned short h) { return __uint_as_float(((unsigned)h) << 16); }
__device__ __forceinline__ s16x4 tr_read(const bf16_t* p) {
  return __builtin_bit_cast(s16x4, __builtin_amdgcn_ds_read_tr16_b64_v4i16((__attribute__((address_space(3))) v4i16_t*)p));
}
__device__ __forceinline__ const float* xin_row(const float* xp, const float* xs, int row) {
  return row < NPROMPT ? xp + (size_t)row * 1024 : xs + (size_t)(row - NPROMPT) * 1024;
}
__device__ __forceinline__ const float* mem_row(const float* mp, const float* ms, int row) {
  return row < 4096 ? mp + (size_t)row * 1024 : ms + (size_t)(row - 4096) * 1024;
}


__device__ __forceinline__ void ld16_sc1(u32x4& v, const void* p) { asm volatile("global_load_dwordx4 %0, %1, off sc1" : "=v"(v) : "v"(p) : "memory"); }
__device__ __forceinline__ void ld16_sc1(f32x4& v, const float* p) { asm volatile("global_load_dwordx4 %0, %1, off sc1" : "=v"(v) : "v"(p) : "memory"); }
__device__ __forceinline__ u32x4 ld_agent_u32x4(const void* p) {
  const unsigned long long a = __hip_atomic_load((const unsigned long long*)p, __ATOMIC_RELAXED, __HIP_MEMORY_SCOPE_AGENT);
  const unsigned long long b = __hip_atomic_load((const unsigned long long*)p + 1, __ATOMIC_RELAXED, __HIP_MEMORY_SCOPE_AGENT);
  return (u32x4){(unsigned)a, (unsigned)(a >> 32), (unsigned)b, (unsigned)(b >> 32)};
}
__device__ __forceinline__ float ld_agent_f32(const float* p) { return __uint_as_float(__hip_atomic_load((const unsigned*)p, __ATOMIC_RELAXED, __HIP_MEMORY_SCOPE_AGENT)); }
__device__ __forceinline__ f32x4 ld_agent_f32x4(const float* p) {
  const unsigned long long a = __hip_atomic_load((const unsigned long long*)p, __ATOMIC_RELAXED, __HIP_MEMORY_SCOPE_AGENT);
  const unsigned long long b = __hip_atomic_load((const unsigned long long*)p + 1, __ATOMIC_RELAXED, __HIP_MEMORY_SCOPE_AGENT);
  f32x4 v; v[0] = __uint_as_float((unsigned)a); v[1] = __uint_as_float((unsigned)(a >> 32)); v[2] = __uint_as_float((unsigned)b); v[3] = __uint_as_float((unsigned)(b >> 32)); return v;
}
__device__ __forceinline__ void tile_map(int t, int NT, int gdim, int& mt, int& nt) {
  if ((gdim & 7) == 0) {
    const int i = t / gdim, b = t - i * gdim; const int lt = (b >> 3) + (gdim >> 3) * i;
    const int mg = lt / (8 * NT), r = lt - mg * 8 * NT, c = r >> 6, r2 = r & 63;
    nt = 8 * c + (r2 >> 3); mt = (b & 7) + 8 * (8 * mg + (r2 & 7)); }
  else { mt = t / NT; nt = t - mt * NT; }
}
constexpr int GLD = 40;
constexpr int G_STAGE = (128 + 256) * GLD;
template <bool AF32, class Epi>
__device__ __forceinline__ void gemm_tile(unsigned char* smem, const void* Ap, int lda, const bf16_t* WT, int N, int K, const Epi& epi, int m0, int n0) {
  const int tid = get_tid(), lane = tid & 63;
  const int wid = __builtin_amdgcn_readfirstlane(tid >> 6);
  const int wr = wid >> 1, wc = wid & 1, l15 = lane & 15, quad = lane >> 4;
  bf16_t* sbase = (bf16_t*)smem; float* sR = (float*)(smem + 2 * G_STAGE * 2);
  f32x4 acc[4][8];
#pragma unroll
  for (int m = 0; m < 4; ++m)
#pragma unroll
    for (int n = 0; n < 8; ++n) acc[m][n] = (f32x4){0.f, 0.f, 0.f, 0.f};
  float ss[4];
#pragma unroll
  for (int i = 0; i < 4; ++i) ss[i] = 0.f;
  f32x4 ra[4]; u32x4 rab[2]; u32x4 rb[4];
  const int nk = K >> 5;
  const float* Af = (const float*)Ap + (size_t)(tid >> 3) * lda + (tid & 7) * 4;
  const bf16_t* Ab = (const bf16_t*)Ap + (size_t)(tid >> 2) * lda + (tid & 3) * 8;
  const bf16_t* Bp = WT + (size_t)n0 * 32 + tid * 8;
  const size_t bstep = (size_t)N * 32;
  const int awf = (tid >> 3) * GLD + (tid & 7) * 4;
  const int awb = (tid >> 2) * GLD + (tid & 3) * 8;
#define G_LOAD(kt_) do { \
    if constexpr (AF32) { _Pragma("unroll") for (int i = 0; i < 4; ++i) ld16_sc1(ra[i], Af + (size_t)i * 32 * lda + (kt_) * 32); } \
    else { _Pragma("unroll") for (int i = 0; i < 2; ++i) ld16_sc1(rab[i], Ab + (size_t)i * 64 * lda + (kt_) * 32); } \
    _Pragma("unroll") for (int i = 0; i < 4; ++i) ld16_sc1(rb[i], Bp + (size_t)(kt_) * bstep + i * 2048); } while (0)
#define G_STORE(st_) do { bf16_t* sa_ = sbase + (st_) * G_STAGE; bf16_t* sb_ = sa_ + 128 * GLD; \
    if constexpr (AF32) { asm volatile("s_waitcnt vmcnt(0)" : "+v"(ra[0]), "+v"(ra[1]), "+v"(ra[2]), "+v"(ra[3]), "+v"(rb[0]), "+v"(rb[1]), "+v"(rb[2]), "+v"(rb[3]) :: "memory"); \
      _Pragma("unroll") for (int i = 0; i < 4; ++i) { const f32x4 v = ra[i]; \
        ss[i] += v[0] * v[0] + v[1] * v[1] + v[2] * v[2] + v[3] * v[3]; \
        u32x2 w; w.x = cvtpk(v[0], v[1]); w.y = cvtpk(v[2], v[3]); *(u32x2*)(sa_ + awf + i * 32 * GLD) = w; } } \
    else { asm volatile("s_waitcnt vmcnt(0)" : "+v"(rab[0]), "+v"(rab[1]), "+v"(rb[0]), "+v"(rb[1]), "+v"(rb[2]), "+v"(rb[3]) :: "memory"); \
      _Pragma("unroll") for (int i = 0; i < 2; ++i) *(u32x4*)(sa_ + awb + i * 64 * GLD) = rab[i]; } \
    _Pragma("unroll") for (int i = 0; i < 4; ++i) *(u32x4*)(sb_ + awb + i * 64 * GLD) = rb[i]; } while (0)
  G_LOAD(0);
  G_STORE(0);
  if (nk > 1) G_LOAD(1);
  __syncthreads();
  for (int kt = 0; kt < nk; ++kt) {
    const int cur = kt & 1;
    if (kt + 1 < nk) G_STORE(cur ^ 1);
    if (kt + 2 < nk) G_LOAD(kt + 2);
    const bf16_t* a_s = sbase + cur * G_STAGE + (wr * 64 + l15) * GLD + quad * 8;
    const bf16_t* b_s = sbase + cur * G_STAGE + 128 * GLD + (wc * 128 + l15) * GLD + quad * 8;
    __builtin_amdgcn_s_setprio(1);
    bf16x8 af[4];
#pragma unroll
    for (int m = 0; m < 4; ++m) af[m] = *(const bf16x8*)(a_s + m * 16 * GLD);
#pragma unroll
    for (int nh = 0; nh < 4; ++nh) {
      bf16x8 bfr[2];
#pragma unroll
      for (int n2 = 0; n2 < 2; ++n2) bfr[n2] = *(const bf16x8*)(b_s + (nh * 2 + n2) * 16 * GLD);
#pragma unroll
      for (int m = 0; m < 4; ++m)
#pragma unroll
        for (int n2 = 0; n2 < 2; ++n2) acc[m][nh * 2 + n2] = __builtin_amdgcn_mfma_f32_16x16x32_bf16(bfr[n2], af[m], acc[m][nh * 2 + n2], 0, 0, 0);
    }
    __builtin_amdgcn_s_setprio(0);
    __syncthreads();
  }
#undef G_LOAD
#undef G_STORE
  if constexpr (AF32) {
    const float invK = 1.0f / (float)K;
#pragma unroll
    for (int i = 0; i < 4; ++i) {
      float s = ss[i];
      s += __shfl_xor(s, 1); s += __shfl_xor(s, 2); s += __shfl_xor(s, 4);
      if ((tid & 7) == 0) sR[(tid >> 3) + 32 * i] = rsqrtf(s * invK + EPS);
    }
    __syncthreads();
  }
  epi(acc, m0, wr * 64, n0 + wc * 128, l15, quad, sR);
}

template <bool RS> struct EpiStore {
  bf16_t* C; int ldc;
  __device__ __forceinline__ void operator()(f32x4 (&acc)[4][8], int m0, int rl0, int cb, int l15, int quad, const float* sR) const {
#pragma unroll
    for (int m = 0; m < 4; ++m) {
      const int rl = rl0 + 16 * m + l15; const float rs = RS ? sR[rl] : 1.f;
      bf16_t* rp = C + (size_t)(m0 + rl) * ldc + cb + 4 * quad;
#pragma unroll
      for (int n = 0; n < 8; ++n) { const f32x4 v = acc[m][n] * rs; u32x2 w; w.x = cvtpk(v[0], v[1]); w.y = cvtpk(v[2], v[3]); *(u32x2*)(rp + 16 * n) = w; }
    }
  }
};
struct EpiInAB {
  bf16_t* Z; const float* gq; const float* gk; const float2* rope;
  __device__ __forceinline__ void operator()(f32x4 (&acc)[4][8], int m0, int rl0, int cb0, int l15, int quad, const float* sR) const {
#pragma unroll
    for (int hh = 0; hh < 2; ++hh) {
      const int cb = cb0 + 64 * hh;
      if (cb >= 640) {
#pragma unroll
        for (int m = 0; m < 4; ++m) {
          const int rl = rl0 + 16 * m + l15; const float rs = sR[rl];
          bf16_t* rp = Z + (size_t)(m0 + rl) * ZW + cb + 4 * quad;
#pragma unroll
          for (int n = 0; n < 4; ++n) { const f32x4 v = acc[m][4 * hh + n] * rs; u32x2 w; w.x = cvtpk(v[0], v[1]); w.y = cvtpk(v[2], v[3]); *(u32x2*)(rp + 16 * n) = w; }
        }
      } else {
        const float* g = cb < 512 ? gq : gk;
        const float qs = cb < 512 ? 0.125f * LOG2E : 1.0f;
        f32x4 gv[4];
#pragma unroll
        for (int n = 0; n < 4; ++n) gv[n] = *(const f32x4*)(g + 16 * n + 4 * quad) * qs;
#pragma unroll
        for (int m = 0; m < 4; ++m) {
          const int rl = rl0 + 16 * m + l15; const int row = m0 + rl; const float rs = sR[rl];
          f32x4 z[4]; float s2 = 0.f;
#pragma unroll
          for (int n = 0; n < 4; ++n) { z[n] = acc[m][4 * hh + n] * rs; s2 += z[n][0] * z[n][0] + z[n][1] * z[n][1] + z[n][2] * z[n][2] + z[n][3] * z[n][3]; }
          s2 += __shfl_xor(s2, 16); s2 += __shfl_xor(s2, 32);
          const float r = rsqrtf(s2 * (1.0f / 64.0f) + EPS);
          const int pos = row < NPROMPT ? (row & 2047) : (row & 16383);
          const int gr = pos >> 6, gc = pos & 63;
          bf16_t* rp = Z + (size_t)row * ZW + cb + 4 * quad;
#pragma unroll
          for (int n = 0; n < 4; ++n) {
            const int ap = (n < 2) ? gr : gc;
            const f32x4 zn = z[n] * r * gv[n];
            float2 c0, c1; { const unsigned long long w0 = __hip_atomic_load((const unsigned long long*)(rope + ap * 16 + ((8 * n + 2 * quad) & 15)), __ATOMIC_RELAXED, __HIP_MEMORY_SCOPE_AGENT), w1 = __hip_atomic_load((const unsigned long long*)(rope + ap * 16 + ((8 * n + 2 * quad + 1) & 15)), __ATOMIC_RELAXED, __HIP_MEMORY_SCOPE_AGENT); c0.x = __uint_as_float((unsigned)w0); c0.y = __uint_as_float((unsigned)(w0 >> 32)); c1.x = __uint_as_float((unsigned)w1); c1.y = __uint_as_float((unsigned)(w1 >> 32)); }
            const float o0 = zn[0] * c0.x - zn[1] * c0.y, o1 = zn[0] * c0.y + zn[1] * c0.x;
            const float o2 = zn[2] * c1.x - zn[3] * c1.y, o3 = zn[2] * c1.y + zn[3] * c1.x;
            u32x2 w; w.x = cvtpk(o0, o1); w.y = cvtpk(o2, o3); *(u32x2*)(rp + 16 * n) = w;
          }
        }
      }
    }
  }
};
struct EpiResid {
  const float* src_tile; float* dst;
  __device__ __forceinline__ void operator()(f32x4 (&acc)[4][8], int m0, int rl0, int cb, int l15, int quad, const float* sR) const {
#pragma unroll
    for (int m = 0; m < 4; ++m) {
      const int rl = rl0 + 16 * m + l15;
      const float* sp = src_tile + (size_t)rl * 1024 + cb + 4 * quad; float* dp = dst + (size_t)(m0 + rl) * 1024 + cb + 4 * quad;
      f32x4 x[8];
#pragma unroll
      for (int n = 0; n < 8; ++n) ld16_sc1(x[n], sp + 16 * n);
      asm volatile("s_waitcnt vmcnt(0)" : "+v"(x[0]), "+v"(x[1]), "+v"(x[2]), "+v"(x[3]), "+v"(x[4]), "+v"(x[5]), "+v"(x[6]), "+v"(x[7]) :: "memory");
#pragma unroll
      for (int n = 0; n < 8; ++n) *(f32x4*)(dp + 16 * n) = x[n] + acc[m][n];
    }
  }
};
struct EpiSwiGLU {
  bf16_t* H;
  __device__ __forceinline__ void operator()(f32x4 (&acc)[4][8], int m0, int rl0, int cb, int l15, int quad, const float* sR) const {
    const int hc0 = (cb >> 8) * 128 + ((cb >> 7) & 1) * 64 + 4 * quad;
#pragma unroll
    for (int m = 0; m < 4; ++m) {
      const int rl = rl0 + 16 * m + l15; const float rs = sR[rl];
      bf16_t* rp = H + (size_t)(m0 + rl) * DFF + hc0;
#pragma unroll
      for (int pp = 0; pp < 4; ++pp) {
        const f32x4 g = acc[m][2 * pp] * rs, u = acc[m][2 * pp + 1] * rs; float h[4];
#pragma unroll
        for (int j = 0; j < 4; ++j) h[j] = g[j] * __builtin_amdgcn_rcpf(1.0f + __builtin_amdgcn_exp2f(-LOG2E * g[j])) * u[j];
        u32x2 w; w.x = cvtpk(h[0], h[1]); w.y = cvtpk(h[2], h[3]); *(u32x2*)(rp + 16 * pp) = w;
      }
    }
  }
};

template <int DH, int KT, int NQT, bool PF, class Ctx>
__device__ __forceinline__ void attn_item(unsigned char* smem, const Ctx& c) {
  constexpr int LDK = DH + 8, CH = DH / 8, NCH = KT * CH / 256, NKS = DH / 32, NK4 = KT / 16, NKK = KT / 32, NDT = DH / 16;
  bf16_t* sK = (bf16_t*)smem; bf16_t* sV = sK + KT * LDK;
  const int tid = get_tid(), lane = tid & 63;
  const int wid = __builtin_amdgcn_readfirstlane(tid >> 6);
  const int l15 = lane & 15, quad = lane >> 4;
  bf16x8 qf[NQT][NKS];
#pragma unroll
  for (int qt = 0; qt < NQT; ++qt) {
    const bf16_t* qp = c.qptr(wid, qt * 16 + l15);
#pragma unroll
    for (int ks = 0; ks < NKS; ++ks) qf[qt][ks] = __builtin_bit_cast(bf16x8, ld_agent_u32x4(qp + ks * 32 + quad * 8));
  }
  f32x4 o[NQT][NDT];
  float mrow[NQT], lrow[NQT];
#pragma unroll
  for (int qt = 0; qt < NQT; ++qt) {
    mrow[qt] = -1e30f; lrow[qt] = 0.f;
#pragma unroll
    for (int dt = 0; dt < NDT; ++dt) o[qt][dt] = (f32x4){0.f, 0.f, 0.f, 0.f};
  }
  const int nt = c.ntiles();
  u32x4 rk[NCH], rv[NCH];
  if constexpr (PF) {
#pragma unroll
    for (int i = 0; i < NCH; ++i) {
      const int ci = tid + 256 * i, row = ci / CH, ch = ci % CH;
      ld16_sc1(rk[i], c.kptr(0, row) + ch * 8); ld16_sc1(rv[i], c.vptr(0, row) + ch * 8);
    }
  }
  for (int t = 0; t < nt; ++t) {
    __syncthreads();
    if constexpr (PF) {
      static_assert(!PF || NCH == 2 || NCH == 4, "wait lists below are written for two or four chunks per matrix");
      if constexpr (NCH == 2) asm volatile("s_waitcnt vmcnt(0)" : "+v"(rk[0]), "+v"(rk[NCH - 1]), "+v"(rv[0]), "+v"(rv[NCH - 1]) :: "memory");
      else asm volatile("s_waitcnt vmcnt(0)" : "+v"(rk[0]), "+v"(rk[1]), "+v"(rk[NCH - 2]), "+v"(rk[NCH - 1]), "+v"(rv[0]), "+v"(rv[1]), "+v"(rv[NCH - 2]), "+v"(rv[NCH - 1]) :: "memory");
#pragma unroll
      for (int i = 0; i < NCH; ++i) {
        const int ci = tid + 256 * i, row = ci / CH, ch = ci % CH;
        *(u32x4*)(sK + row * LDK + ch * 8) = rk[i]; *(u32x4*)(sV + row * LDK + ch * 8) = rv[i];
      }
    } else {
#pragma unroll
      for (int i = 0; i < NCH; ++i) {
        const int ci = tid + 256 * i, row = ci / CH, ch = ci % CH;
        *(u32x4*)(sK + row * LDK + ch * 8) = ld_agent_u32x4(c.kptr(t, row) + ch * 8);
      }
#pragma unroll
      for (int i = 0; i < NCH; ++i) {
        const int ci = tid + 256 * i, row = ci / CH, ch = ci % CH;
        *(u32x4*)(sV + row * LDK + ch * 8) = ld_agent_u32x4(c.vptr(t, row) + ch * 8);
      }
    }
    __syncthreads();
    if constexpr (PF) {
      if (t + 1 < nt) {
#pragma unroll
        for (int i = 0; i < NCH; ++i) {
          const int ci = tid + 256 * i, row = ci / CH, ch = ci % CH;
          ld16_sc1(rk[i], c.kptr(t + 1, row) + ch * 8); ld16_sc1(rv[i], c.vptr(t + 1, row) + ch * 8);
        }
      }
    }
    if (c.active(t, wid)) {
      constexpr int QG = NQT < 2 ? NQT : 2;
      bf16x8 pfa[NQT][NKK];
#pragma unroll
      for (int g = 0; g < NQT; g += QG) {
        f32x4 s[QG][NK4];
#pragma unroll
        for (int q = 0; q < QG; ++q)
#pragma unroll
          for (int k4 = 0; k4 < NK4; ++k4) s[q][k4] = (f32x4){0.f, 0.f, 0.f, 0.f};
#pragma unroll
        for (int k4 = 0; k4 < NK4; ++k4)
#pragma unroll
          for (int ks = 0; ks < NKS; ++ks) {
            const bf16x8 kf = *(const bf16x8*)(sK + (16 * k4 + l15) * LDK + ks * 32 + quad * 8);
#pragma unroll
            for (int q = 0; q < QG; ++q) s[q][k4] = __builtin_amdgcn_mfma_f32_16x16x32_bf16(kf, qf[g + q][ks], s[q][k4], 0, 0, 0);
          }
#pragma unroll
        for (int q = 0; q < QG; ++q) {
          const int qt = g + q;
          float mx = -1e30f;
#pragma unroll
          for (int k4 = 0; k4 < NK4; ++k4)
#pragma unroll
            for (int j = 0; j < 4; ++j) { const float v = c.score(t, wid, qt * 16 + l15, 16 * k4 + 4 * quad + j, s[q][k4][j]); s[q][k4][j] = v; mx = fmaxf(mx, v); }
          mx = fmaxf(mx, __shfl_xor(mx, 16)); mx = fmaxf(mx, __shfl_xor(mx, 32));
          const float mnew = fmaxf(mrow[qt], mx);
          if (__any(mnew > mrow[qt])) {
            const float alpha = __builtin_amdgcn_exp2f(mrow[qt] - mnew);
            mrow[qt] = mnew;
            lrow[qt] *= alpha;
#pragma unroll
            for (int dt = 0; dt < NDT; ++dt) o[qt][dt] *= alpha;
          }
          float psum = 0.f;
#pragma unroll
          for (int k4 = 0; k4 < NK4; ++k4)
#pragma unroll
            for (int j = 0; j < 4; ++j) { const float pv = __builtin_amdgcn_exp2f(s[q][k4][j] - mnew); s[q][k4][j] = pv; psum += pv; }
          lrow[qt] += psum;
#pragma unroll
          for (int kk = 0; kk < NKK; ++kk) {
            u32x4 w;
            w.x = cvtpk(s[q][2 * kk][0], s[q][2 * kk][1]); w.y = cvtpk(s[q][2 * kk][2], s[q][2 * kk][3]);
            w.z = cvtpk(s[q][2 * kk + 1][0], s[q][2 * kk + 1][1]); w.w = cvtpk(s[q][2 * kk + 1][2], s[q][2 * kk + 1][3]);
            pfa[qt][kk] = __builtin_bit_cast(bf16x8, w);
          }
        }
      }
#pragma unroll
      for (int kk = 0; kk < NKK; ++kk) {
        const bf16_t* vb = sV + (32 * kk + 4 * quad + (l15 >> 2)) * LDK + 4 * (l15 & 3);
#pragma unroll
        for (int dt = 0; dt < NDT; ++dt) {
          const s16x4 lo = tr_read(vb + 16 * dt);
          const s16x4 hi = tr_read(vb + 16 * LDK + 16 * dt);
          const bf16x8 vf = (bf16x8){lo[0], lo[1], lo[2], lo[3], hi[0], hi[1], hi[2], hi[3]};
#pragma unroll
          for (int qt = 0; qt < NQT; ++qt) o[qt][dt] = __builtin_amdgcn_mfma_f32_16x16x32_bf16(vf, pfa[qt][kk], o[qt][dt], 0, 0, 0);
        }
      }
    }
  }
#pragma unroll
  for (int qt = 0; qt < NQT; ++qt) {
    float l = lrow[qt];
    l += __shfl_xor(l, 16); l += __shfl_xor(l, 32);
    const float inv = 1.0f / l;
    bf16_t* op = c.optr(wid, qt * 16 + l15) + 4 * quad;
#pragma unroll
    for (int dt = 0; dt < NDT; ++dt) { const f32x4 v = o[qt][dt] * inv; u32x2 w; w.x = cvtpk(v[0], v[1]); w.y = cvtpk(v[2], v[3]); *(u32x2*)(op + 16 * dt) = w; }
    if (quad == 0) c.store_lse(wid, qt * 16 + l15, mrow[qt] + __builtin_amdgcn_logf(l));
  }
}

struct CtxA {
  bf16_t* qbase; const bf16_t* kbase; int nt;
  __device__ __forceinline__ const bf16_t* qptr(int w, int ql) const { return qbase + (size_t)(64 * w + ql) * ZW; }
  __device__ __forceinline__ bf16_t* optr(int w, int ql) const { return qbase + (size_t)(64 * w + ql) * ZW; }
  __device__ __forceinline__ const bf16_t* kptr(int t, int r) const { return kbase + (size_t)(64 * t + r) * ZW; }
  __device__ __forceinline__ const bf16_t* vptr(int t, int r) const { return kbase + (size_t)(64 * t + r) * ZW + 128; }
  __device__ __forceinline__ int ntiles() const { return nt; }
  __device__ __forceinline__ bool active(int, int) const { return true; }
  __device__ __forceinline__ float score(int, int, int, int, float s) const { return s; }
  __device__ __forceinline__ void store_lse(int, int, float) const {}
};
struct CtxB {
  bf16_t* zs; float* lse; int d, r, L, i0, qcol, kcol, vcol; float slope_l2;
  __device__ __forceinline__ const bf16_t* qptr(int w, int ql) const { return zs + (size_t)((i0 + 32 * w + ql) * d + r) * ZW + qcol; }
  __device__ __forceinline__ bf16_t* optr(int w, int ql) const { return zs + (size_t)((i0 + 32 * w + ql) * d + r) * ZW + qcol; }
  __device__ __forceinline__ int kidx(int t, int row) const { int i = i0 - 64 + 64 * t + row; i = i < 0 ? 0 : i; return i > L - 1 ? L - 1 : i; }
  __device__ __forceinline__ const bf16_t* kptr(int t, int row) const { return zs + (size_t)(kidx(t, row) * d + r) * ZW + kcol; }
  __device__ __forceinline__ const bf16_t* vptr(int t, int row) const { return zs + (size_t)(kidx(t, row) * d + r) * ZW + vcol; }
  __device__ __forceinline__ int ntiles() const { return 4; }
  __device__ __forceinline__ bool active(int t, int w) const { return w < 2 ? (t < 3) : (t >= 1); }
  __device__ __forceinline__ float score(int t, int w, int ql, int kl, float s) const {
    const int qi = i0 + 32 * w + ql, ki = i0 - 64 + 64 * t + kl; int rel = ki - qi; rel = rel < 0 ? -rel : rel;
    const bool valid = (rel <= 64) && (ki >= 0) && (ki < L);
    return valid ? s * (0.125f * LOG2E) - slope_l2 * (float)rel : -1e30f;
  }
  __device__ __forceinline__ void store_lse(int w, int ql, float v) const { lse[i0 + 32 * w + ql] = v; }
};
struct CtxC {
  bf16_t* zs; const float* rpb; int R, r0, rb, hc;
  __device__ __forceinline__ const bf16_t* qptr(int w, int ql) const { return zs + (size_t)((r0 + w) * 64 + ql) * ZW + hc; }
  __device__ __forceinline__ bf16_t* optr(int w, int ql) const { return zs + (size_t)((r0 + w) * 64 + ql) * ZW + hc; }
  __device__ __forceinline__ int krow(int t) const { const int kr = rb + t; return kr > R - 1 ? R - 1 : kr; }
  __device__ __forceinline__ const bf16_t* kptr(int t, int row) const { return zs + (size_t)(krow(t) * 64 + row) * ZW + 1024 + hc; }
  __device__ __forceinline__ const bf16_t* vptr(int t, int row) const { return zs + (size_t)(krow(t) * 64 + row) * ZW + 2048 + hc; }
  __device__ __forceinline__ int ntiles() const { return 11; }
  __device__ __forceinline__ int rstart(int r) const { int rs = r - 4; rs = rs < 0 ? 0 : rs; return rs > R - 8 ? R - 8 : rs; }
  __device__ __forceinline__ bool active(int t, int w) const { const int r = r0 + w, rs = rstart(r), kr = rb + t; return kr >= rs && kr < rs + 8; }
  __device__ __forceinline__ float score(int t, int w, int ql, int kl, float s) const {
    const int r = r0 + w, cq = ql, kr = rb + t;
    int cs = cq - 8; cs = cs < 0 ? 0 : cs; cs = cs > 48 ? 48 : cs;
    const bool valid = (kl >= cs) && (kl < cs + 16);
    const int idx = valid ? (kr - r + 7) * 31 + (kl - cq + 15) : 0;
    const float b = rpb[idx];
    return valid ? (s * 0.125f + b) * LOG2E : -1e30f;
  }
  __device__ __forceinline__ void store_lse(int, int, float) const {}
};
struct CtxX {
  bf16_t* qbase; const bf16_t* kv;
  __device__ __forceinline__ const bf16_t* qptr(int w, int ql) const { return qbase + (size_t)(16 * w + ql) * 1024; }
  __device__ __forceinline__ bf16_t* optr(int w, int ql) const { return qbase + (size_t)(16 * w + ql) * 1024; }
  __device__ __forceinline__ const bf16_t* kptr(int t, int row) const { return kv + (size_t)(32 * t + row) * 2048; }
  __device__ __forceinline__ const bf16_t* vptr(int t, int row) const { return kv + (size_t)(32 * t + row) * 2048 + 1024; }
  __device__ __forceinline__ int ntiles() const { return 8; }
  __device__ __forceinline__ bool active(int, int) const { return true; }
  __device__ __forceinline__ float score(int, int, int, int, float s) const { return s * (0.0625f * LOG2E); }
  __device__ __forceinline__ void store_lse(int, int, float) const {}
};

__device__ __forceinline__ void wt_tile(unsigned char* smem, const float* src, int K, int N, const float* gain, bf16_t* dst, int perm, int t) {
  float* tl = (float*)smem;
  const int nkt = K >> 6; const int rt = t / nkt, kt = t - rt * nkt; const int R0 = rt * 64, k0 = kt * 64;
  const int tid = get_tid(); const int rr = tid & 63;
  const int R = R0 + rr; int sc = R;
  if (perm) { const int T = R >> 8, within = R & 255, wc = within >> 7, n = (within & 127) >> 4, i = within & 15; sc = (n & 1) * DFF + 128 * T + 64 * wc + 16 * (n >> 1) + i; }
  __syncthreads();
#pragma unroll 4
  for (int i = 0; i < 16; ++i) {
    const int kk = (tid >> 6) + 4 * i;
    float v = src[(size_t)(k0 + kk) * N + sc];
    if (gain) v *= gain[k0 + kk];
    tl[kk * 65 + rr] = v;
  }
  __syncthreads();
  const int r2 = tid >> 2, kq = tid & 3;
  u32x4 w0, w1;
  w0.x = cvtpk(tl[(16 * kq + 0) * 65 + r2], tl[(16 * kq + 1) * 65 + r2]); w0.y = cvtpk(tl[(16 * kq + 2) * 65 + r2], tl[(16 * kq + 3) * 65 + r2]);
  w0.z = cvtpk(tl[(16 * kq + 4) * 65 + r2], tl[(16 * kq + 5) * 65 + r2]); w0.w = cvtpk(tl[(16 * kq + 6) * 65 + r2], tl[(16 * kq + 7) * 65 + r2]);
  w1.x = cvtpk(tl[(16 * kq + 8) * 65 + r2], tl[(16 * kq + 9) * 65 + r2]); w1.y = cvtpk(tl[(16 * kq + 10) * 65 + r2], tl[(16 * kq + 11) * 65 + r2]);
  w1.z = cvtpk(tl[(16 * kq + 12) * 65 + r2], tl[(16 * kq + 13) * 65 + r2]); w1.w = cvtpk(tl[(16 * kq + 14) * 65 + r2], tl[(16 * kq + 15) * 65 + r2]);
  bf16_t* dp = dst + ((size_t)((k0 + 16 * kq) >> 5) * N + (R0 + r2)) * 32 + ((16 * kq) & 31);
  *(u32x4*)dp = w0; *(u32x4*)(dp + 8) = w1;
}
__device__ __forceinline__ void wt_matrix(unsigned char* smem, const float* src, int K, int N, const float* gain, bf16_t* dst, int perm) {
  const int ntile = (K >> 6) * (N >> 6);
  for (int t = blockIdx.x; t < ntile; t += gridDim.x) wt_tile(smem, src, K, N, gain, dst, perm, t);
}

__device__ __forceinline__ void tile_seq(int tt, int& seqbase, int& qb, int& S) {
  if (tt < 256) { seqbase = (tt >> 4) * 2048; qb = tt & 15; S = 2048; }
  else { const int u = tt - 256; seqbase = NPROMPT + (u >> 7) * 16384; qb = u & 127; S = 16384; }
}

typedef const __attribute__((address_space(4))) Params* KParams;
__device__ __forceinline__ void run_phase(int ph, KParams kp, unsigned char* smem) {
  unsigned char* ws = kp->ws;
  bf16_t* Z = (bf16_t*)(ws + WS_Z);
  const int tid = get_tid();
  const int L = ph >= 10 ? 1 : 0;
  switch (ph) {
    case 0: {
      wt_matrix(smem, kp->w_in_ab, 1024, 3072, kp->g_mix, (bf16_t*)(ws + WS_WT_IN_AB), 0);
      wt_matrix(smem, kp->w_out_ab, 768, 1024, nullptr, (bf16_t*)(ws + WS_WT_OUT_AB), 0);
      wt_matrix(smem, kp->w_in_c, 1024, 3072, kp->g_mix + 1024, (bf16_t*)(ws + WS_WT_IN_C), 0);
      wt_matrix(smem, kp->w_out_c, 1024, 1024, nullptr, (bf16_t*)(ws + WS_WT_OUT_C), 0);
      for (int l = 0; l < 2; ++l) {
        wt_matrix(smem, kp->wq_x + (size_t)l * 1024 * 1024, 1024, 1024, kp->g_xattn + l * 1024, (bf16_t*)(ws + WS_WT_Q) + (size_t)l * 1024 * 1024, 0);
        wt_matrix(smem, kp->wkv_x + (size_t)l * 1024 * 2048, 1024, 2048, kp->g_mem + l * 1024, (bf16_t*)(ws + WS_WT_KV) + (size_t)l * 2048 * 1024, 0);
        wt_matrix(smem, kp->wo_x + (size_t)l * 1024 * 1024, 1024, 1024, nullptr, (bf16_t*)(ws + WS_WT_O) + (size_t)l * 1024 * 1024, 0);
        wt_matrix(smem, kp->w_gu + (size_t)l * 1024 * 5632, 1024, 5632, kp->g_ffn + l * 1024, (bf16_t*)(ws + WS_WT_GU) + (size_t)l * 5632 * 1024, 1);
        wt_matrix(smem, kp->w_down + (size_t)l * DFF * 1024, DFF, 1024, nullptr, (bf16_t*)(ws + WS_WT_DOWN) + (size_t)l * 1024 * DFF, 0);
      }
      const int gi = blockIdx.x * 256 + tid;
      if (gi < 4096) {
        const int pos = gi >> 4, f = gi & 15;
        const float inv_freq = exp2f(-(float)f * 0.83048202372184058696f);
        const float ang = (float)pos * inv_freq;
        float2 cs; cs.x = cosf(ang); cs.y = sinf(ang);
        ((float2*)(ws + WS_ROPE))[gi] = cs;
      }
    } break;
    case 1: {
      const int n_ab = 512 * 12, n_kv = 36 * 8;
      for (int t = blockIdx.x; t < n_ab + 2 * n_kv; t += gridDim.x) {
        if (t < n_ab) {
          int mt, nt; tile_map(t, 12, gridDim.x, mt, nt);
          EpiInAB e{Z, kp->g_qn, kp->g_kn, (const float2*)(ws + WS_ROPE)};
          gemm_tile<true>(smem, xin_row(kp->x_prompt, kp->x_sample, mt * 128), 1024, (const bf16_t*)(ws + WS_WT_IN_AB), 3072, 1024, e, mt * 128, nt * 256);
        } else {
          int u = t - n_ab; const int l = u / n_kv; u -= l * n_kv; const int mt = u >> 3, nt = u & 7;
          EpiStore<true> e{(bf16_t*)(ws + WS_KVMEM) + (size_t)l * 4608 * 2048, 2048};
          gemm_tile<true>(smem, mem_row(kp->mem_prompt, kp->mem_sample, mt * 128), 1024, (const bf16_t*)(ws + WS_WT_KV) + (size_t)l * 2048 * 1024, 2048, 1024, e, mt * 128, nt * 256);
        }
      }
    } break;
    case 2: {
      for (int it = blockIdx.x; it < 2048 + 6144; it += gridDim.x) {
        if (it < 2048) {
          int seqbase, qi, h, nt;
          if (gridDim.x == 512) {
            const int bid = blockIdx.x, i = it >> 9, xcd = bid & 7, l = (bid >> 3) + 64 * (i & 1);
            if (it < 1024) { const int g = xcd >> 1, id = l * 2 + (xcd & 1); qi = id >> 2; h = (g & 1) * 4 + (id & 3); seqbase = NPROMPT + (g >> 1) * 16384; nt = 256; }
            else { const int grp = xcd + 8 * (l >> 5), id = l & 31; qi = id >> 2; h = (grp & 1) * 4 + (id & 3); seqbase = (grp >> 1) * 2048; nt = 32; }
          } else if (it < 1024) { const int s = it >> 9, rem = it & 511; qi = rem >> 3; h = rem & 7; seqbase = NPROMPT + s * 16384; nt = 256; }
          else { const int a = it - 1024; const int s = a >> 6, rem = a & 63; qi = rem >> 3; h = rem & 7; seqbase = s * 2048; nt = 32; }
          CtxA c{Z + (size_t)(seqbase + 256 * qi) * ZW + h * 64, Z + (size_t)seqbase * ZW + 512 + (h >> 2) * 64, nt};
          attn_item<64, 64, 4, true>(smem, c);
        } else {
          const int b = it - 2048; const int h = b & 3, g = (b >> 2) % 3, tt = b / 12;
          int seqbase, qb, S; tile_seq(tt, seqbase, qb, S);
          const int d = g == 0 ? 1 : (g == 1 ? 4 : 16);
          const int Ls = S / d, nb = Ls >> 7; const int r = qb / nb, mblk = qb - r * nb;
          const float slope = exp2f(-8.0f * (float)(4 * g + h + 1) / 12.0f);
          CtxB c{Z + (size_t)seqbase * ZW, (float*)(ws + WS_LSE) + (size_t)(g * 4 + h) * NTOK + seqbase + r * Ls, d, r, Ls, mblk * 128,
                 768 + ((0 * 3 + g) * 4 + h) * 64, 768 + ((1 * 3 + g) * 4 + h) * 64, 768 + ((2 * 3 + g) * 4 + h) * 64, slope * (float)d * LOG2E};
          attn_item<64, 64, 2, true>(smem, c);
        }
      }
    } break;
    case 3: {
      const float* lse = (const float*)(ws + WS_LSE);
      for (int i = blockIdx.x * 256 + tid; i < NTOK * 32; i += gridDim.x * 256) {
        const int T = i >> 5, h = (i >> 3) & 3, c8 = i & 7;
        int sb, pos, lg;
        if (T < NPROMPT) { sb = T & ~2047; pos = T & 2047; lg = 11; } else { sb = NPROMPT + ((T - NPROMPT) & ~16383); pos = (T - NPROMPT) & 16383; lg = 14; }
        const float l0 = ld_agent_f32(lse + (size_t)(0 * 4 + h) * NTOK + sb + pos);
        const float l1 = ld_agent_f32(lse + (size_t)(1 * 4 + h) * NTOK + sb + ((pos & 3) << (lg - 2)) + (pos >> 2));
        const float l2 = ld_agent_f32(lse + (size_t)(2 * 4 + h) * NTOK + sb + ((pos & 15) << (lg - 4)) + (pos >> 4));
        const float mx = fmaxf(l0, fmaxf(l1, l2));
        float w0 = __builtin_amdgcn_exp2f(l0 - mx), w1 = __builtin_amdgcn_exp2f(l1 - mx), w2 = __builtin_amdgcn_exp2f(l2 - mx);
        const float inv = 1.0f / (w0 + w1 + w2); w0 *= inv; w1 *= inv; w2 *= inv;
        const bf16_t* zr = Z + (size_t)T * ZW;
        const u32x4 a = ld_agent_u32x4(zr + 768 + (0 * 4 + h) * 64 + c8 * 8), b = ld_agent_u32x4(zr + 768 + (1 * 4 + h) * 64 + c8 * 8), cc = ld_agent_u32x4(zr + 768 + (2 * 4 + h) * 64 + c8 * 8);
        u32x4 o;
#pragma unroll
        for (int k = 0; k < 4; ++k) {
          const float lo = w0 * bf2f((unsigned short)(a[k] & 0xffff)) + w1 * bf2f((unsigned short)(b[k] & 0xffff)) + w2 * bf2f((unsigned short)(cc[k] & 0xffff));
          const float hi = w0 * bf2f((unsigned short)(a[k] >> 16)) + w1 * bf2f((unsigned short)(b[k] >> 16)) + w2 * bf2f((unsigned short)(cc[k] >> 16));
          o[k] = cvtpk(lo, hi);
        }
        *(u32x4*)(Z + (size_t)T * ZW + 512 + h * 64 + c8 * 8) = o;
      }
    } break;
    case 4: case 7: case 9: case 12: case 15: case 17: {
      const bf16_t* A; int lda, K; const bf16_t* Bt;
      if (ph == 4) { A = Z; lda = ZW; K = 768; Bt = (const bf16_t*)(ws + WS_WT_OUT_AB); }
      else if (ph == 12) { A = Z; lda = ZW; K = 1024; Bt = (const bf16_t*)(ws + WS_WT_OUT_C); }
      else if (ph == 7 || ph == 15) { A = Z; lda = 1024; K = 1024; Bt = (const bf16_t*)(ws + WS_WT_O) + (size_t)L * 1024 * 1024; }
      else { A = Z; lda = DFF; K = DFF; Bt = (const bf16_t*)(ws + WS_WT_DOWN) + (size_t)L * 1024 * DFF; }
      for (int t = blockIdx.x; t < 512 * 4; t += gridDim.x) {
        int mt, nt; tile_map(t, 4, gridDim.x, mt, nt);
        EpiResid e{ph == 4 ? xin_row(kp->x_prompt, kp->x_sample, mt * 128) : kp->out + (size_t)mt * 128 * 1024, kp->out};
        gemm_tile<false>(smem, A + (size_t)mt * 128 * lda, lda, Bt, 1024, K, e, mt * 128, nt * 256);
      }
    } break;
    case 5: case 10: case 13: {
      const bf16_t* Bt; int NT, ldc;
      if (ph == 10) { Bt = (const bf16_t*)(ws + WS_WT_IN_C); NT = 12; ldc = ZW; }
      else { Bt = (const bf16_t*)(ws + WS_WT_Q) + (size_t)L * 1024 * 1024; NT = 4; ldc = 1024; }
      for (int t = blockIdx.x; t < 512 * NT; t += gridDim.x) {
        int mt, nt; tile_map(t, NT, gridDim.x, mt, nt);
        EpiStore<true> e{Z, ldc};
        gemm_tile<true>(smem, kp->out + (size_t)mt * 128 * 1024, 1024, Bt, NT * 256, 1024, e, mt * 128, nt * 256);
      }
    } break;
    case 6: case 14: {
      const bf16_t* kvm = (const bf16_t*)(ws + WS_KVMEM) + (size_t)L * 4608 * 2048;
      for (int it = blockIdx.x; it < 4096; it += gridDim.x) {
        int idx = it; if (gridDim.x == 512) idx = (blockIdx.x & 7) * 512 + (blockIdx.x >> 3) + 64 * (it >> 9);
        const int h = idx & 3, tile = idx >> 2, T0 = tile * 64;
        const int bidx = T0 < NPROMPT ? (T0 >> 11) : 16 + ((T0 - NPROMPT) >> 14);
        CtxX c{Z + (size_t)T0 * 1024 + h * 256, kvm + (size_t)bidx * 256 * 2048 + h * 256};
        attn_item<256, 32, 1, true>(smem, c);
      }
    } break;
    case 8: case 16: {
      const bf16_t* Bt = (const bf16_t*)(ws + WS_WT_GU) + (size_t)L * 5632 * 1024;
      for (int t = blockIdx.x; t < 512 * 22; t += gridDim.x) {
        int mt, nt; tile_map(t, 22, gridDim.x, mt, nt);
        EpiSwiGLU e{Z};
        gemm_tile<true>(smem, kp->out + (size_t)mt * 128 * 1024, 1024, Bt, 5632, 1024, e, mt * 128, nt * 256);
      }
    } break;
    case 11: {
      float* srpb = (float*)(smem + 2 * 64 * 72 * 2);
      for (int it = blockIdx.x; it < 4096; it += gridDim.x) {
        int h = it & 15, t4 = it >> 4;
        if (gridDim.x == 512) { const int l = (blockIdx.x >> 3) + 64 * (it >> 9); h = 2 * (blockIdx.x & 7) + (l & 1); t4 = l >> 1; }
        int seqbase, rq, R;
        if (t4 < 128) { seqbase = (t4 >> 3) * 2048; rq = t4 & 7; R = 32; } else { const int u = t4 - 128; seqbase = NPROMPT + (u >> 6) * 16384; rq = u & 63; R = 256; }
        const int r0 = 4 * rq;
        int rb = r0 - 4; rb = rb < 0 ? 0 : rb; rb = rb > R - 8 ? R - 8 : rb;
        __syncthreads();
        for (int i = tid; i < 15 * 31; i += 256) srpb[i] = kp->rpb_c[h * 15 * 31 + i];
        CtxC c{Z + (size_t)seqbase * ZW, srpb, R, r0, rb, h * 64};
        attn_item<64, 64, 4, true>(smem, c);
      }
    } break;
    case 18: {
      const int lane = tid & 63, wv = blockIdx.x * 4 + (tid >> 6), nwv = gridDim.x * 4;
      for (int row = wv; row < NTOK; row += nwv) {
        float* xr = kp->out + (size_t)row * 1024;
        f32x4 v[4]; float s = 0.f;
#pragma unroll
        for (int i = 0; i < 4; ++i) { v[i] = ld_agent_f32x4(xr + i * 256 + lane * 4); s += v[i][0] * v[i][0] + v[i][1] * v[i][1] + v[i][2] * v[i][2] + v[i][3] * v[i][3]; }
        s += __shfl_xor(s, 1); s += __shfl_xor(s, 2); s += __shfl_xor(s, 4); s += __shfl_xor(s, 8); s += __shfl_xor(s, 16); s += __shfl_xor(s, 32);
        const float r = rsqrtf(s * (1.0f / 1024.0f) + EPS);
#pragma unroll
        for (int i = 0; i < 4; ++i) { const f32x4 g = *(const f32x4*)(kp->g_final + i * 256 + lane * 4); *(f32x4*)(xr + i * 256 + lane * 4) = v[i] * r * g; }
      }
    } break;
    default: break;
  }
}

constexpr int NPHASE = 19;
constexpr size_t WS_BAR = WS_END + 65536;

__device__ __forceinline__ void xcd_grid_barrier(unsigned* st) {
  __syncthreads();
  if (threadIdx.x == 0) {
    __threadfence();
    const unsigned nb = gridDim.x;
    const unsigned ng = (nb & 7u) == 0u ? 8u : 1u, grp = ng == 8u ? (blockIdx.x & 7u) : 0u, per = nb / ng;
    const unsigned gen = __hip_atomic_load(st + 32 * 9, __ATOMIC_RELAXED, __HIP_MEMORY_SCOPE_AGENT);
    if (__hip_atomic_fetch_add(st + 32 * grp, 1u, __ATOMIC_RELAXED, __HIP_MEMORY_SCOPE_AGENT) == per - 1u) {
      __hip_atomic_store(st + 32 * grp, 0u, __ATOMIC_RELAXED, __HIP_MEMORY_SCOPE_AGENT);
      if (__hip_atomic_fetch_add(st + 32 * 8, 1u, __ATOMIC_RELEASE, __HIP_MEMORY_SCOPE_AGENT) == ng - 1u) {
        __hip_atomic_store(st + 32 * 8, 0u, __ATOMIC_RELAXED, __HIP_MEMORY_SCOPE_AGENT);
        __hip_atomic_fetch_add(st + 32 * 9, 1u, __ATOMIC_RELEASE, __HIP_MEMORY_SCOPE_AGENT);
      }
    }
    while (__hip_atomic_load(st + 32 * 9, __ATOMIC_RELAXED, __HIP_MEMORY_SCOPE_AGENT) == gen) __builtin_amdgcn_s_sleep(1);
    __threadfence();
  }
  __syncthreads();
}

template <bool COOP>
__global__ void __launch_bounds__(256, 2) mega(Params p) {
  __shared__ __attribute__((aligned(16))) unsigned char smem[SMEM_BYTES];
  if constexpr (COOP) {
    cg::grid_group grid = cg::this_grid();
#define STEP(PH) { KParams kp = (KParams)__builtin_amdgcn_kernarg_segment_ptr(); asm volatile("" : "+s"(kp)); run_phase(PH, kp, smem); if (PH + 1 < NPHASE) { if (PH == 0) grid.sync(); else xcd_grid_barrier((unsigned*)(kp->ws + WS_BAR)); } }
    STEP(0) STEP(1) STEP(2) STEP(3) STEP(4) STEP(5) STEP(6) STEP(7) STEP(8) STEP(9)
    STEP(10) STEP(11) STEP(12) STEP(13) STEP(14) STEP(15) STEP(16) STEP(17) STEP(18)
#undef STEP
  } else {
    for (int ph = p.phase_lo; ph < p.phase_hi; ++ph) {
      KParams kp = (KParams)__builtin_amdgcn_kernarg_segment_ptr();
      asm volatile("" : "+s"(kp));
      run_phase(ph, kp, smem);
    }
  }
}

extern "C" void kernel_launch(void* const* d_in, const int* in_sizes, int n_in, void* d_out, int out_size, void* d_ws, size_t ws_size, hipStream_t stream) {
  static int grid = 0;
  if (grid == 0) {
    if (n_in != 21 || ws_size < WS_BAR + 2048) { fprintf(stderr, "kernel_launch: n_in %d ws %zu (need %zu)\n", n_in, ws_size, (size_t)WS_END); grid = -1; return; }
    int dev = 0, cus = 0, per_cu = 0;
    hipGetDevice(&dev);
    hipDeviceGetAttribute(&cus, hipDeviceAttributeMultiprocessorCount, dev);
#if MULTI_LAUNCH
    hipOccupancyMaxActiveBlocksPerMultiprocessor(&per_cu, (const void*)mega<false>, 256, 0);
#else
    hipOccupancyMaxActiveBlocksPerMultiprocessor(&per_cu, (const void*)mega<true>, 256, 0);
#endif
    if (per_cu < 1) per_cu = 1;
    if (per_cu > 2) per_cu = 2;
    grid = cus * per_cu;
  }
  if (grid < 0) return;
  Params p{};
  p.x_prompt = (const float*)d_in[0]; p.x_sample = (const float*)d_in[1]; p.mem_prompt = (const float*)d_in[2]; p.mem_sample = (const float*)d_in[3];
  p.g_mix = (const float*)d_in[4]; p.w_in_ab = (const float*)d_in[5]; p.g_qn = (const float*)d_in[6]; p.g_kn = (const float*)d_in[7]; p.w_out_ab = (const float*)d_in[8];
  p.w_in_c = (const float*)d_in[9]; p.rpb_c = (const float*)d_in[10]; p.w_out_c = (const float*)d_in[11]; p.g_xattn = (const float*)d_in[12]; p.g_mem = (const float*)d_in[13];
  p.wq_x = (const float*)d_in[14]; p.wkv_x = (const float*)d_in[15]; p.wo_x = (const float*)d_in[16]; p.g_ffn = (const float*)d_in[17]; p.w_gu = (const float*)d_in[18]; p.w_down = (const float*)d_in[19];
  p.g_final = (const float*)d_in[20];
  p.out = (float*)d_out; p.ws = (unsigned char*)d_ws;
#if MULTI_LAUNCH
  for (int ph = 0; ph < NPHASE; ++ph) {
    p.phase_lo = ph; p.phase_hi = ph + 1;
    hipLaunchKernelGGL(mega<false>, dim3(grid), dim3(256), 0, stream, p);
  }
#else
  p.phase_lo = 0; p.phase_hi = NPHASE;
  void* args[] = {&p};
  hipMemsetAsync((unsigned char*)d_ws + WS_BAR, 0, 2048, stream);
  hipError_t e = hipLaunchCooperativeKernel((const void*)mega<true>, dim3(grid), dim3(256), args, 0, stream);
  if (e != hipSuccess) fprintf(stderr, "cooperative launch failed: %s (grid %d)\n", hipGetErrorString(e), grid);
#endif
}
#ifdef DBG_RES
template <int PH> __global__ void __launch_bounds__(256, 2) mega_one(Params p) {
  __shared__ __attribute__((aligned(16))) unsigned char smem[SMEM_BYTES];
  run_phase(PH, (KParams)__builtin_amdgcn_kernarg_segment_ptr(), smem);
}
template __global__ void mega_one<0>(Params); template __global__ void mega_one<1>(Params); template __global__ void mega_one<2>(Params);
template __global__ void mega_one<3>(Params); template __global__ void mega_one<4>(Params); template __global__ void mega_one<5>(Params);
template __global__ void mega_one<6>(Params); template __global__ void mega_one<8>(Params); template __global__ void mega_one<11>(Params);
template __global__ void mega_one<18>(Params);
#endif
```
